# Optimizing an MI355X kernel written in HIP

```python
import math
import jax
import jax.numpy as jnp
from jax import lax
import numpy as np

D_MODEL = 2048
BATCH = 8
SEQ = 2048
DEPTH = 4

RMS_EPS = 1e-6
NEG_INF = -1e30
N_BRANCH = 3
SSM_WIDTH = D_MODEL // 4
SSM_GROUP = 16
SSM_GROUPS = SSM_WIDTH // SSM_GROUP
SSM_STATE = 64
DT_MIN = 1e-3
DT_MAX = 1e-1
HEAD_DIM = 64
DSWA_PATTERNS = ((128, 1), (512, 4), (2048, 16))
ATTN_WIDTH = D_MODEL // 4
HEADS_PER_PATTERN = ATTN_WIDTH // HEAD_DIM
N_ATTN_HEADS = HEADS_PER_PATTERN * len(DSWA_PATTERNS)
QKV_WIDTH = N_ATTN_HEADS * HEAD_DIM
CONV_WIDTH = D_MODEL // 4
CONV_K = 3
D_FF = 256 * ((8 * D_MODEL // 3 + 255) // 256)
FFN_CONV_K = 3
OFF_Q = SSM_WIDTH
OFF_K = OFF_Q + QKV_WIDTH
OFF_V = OFF_K + QKV_WIDTH
OFF_CONV = OFF_V + QKV_WIDTH
OFF_GATE = OFF_CONV + 3 * CONV_WIDTH
N_IN = OFF_GATE + N_BRANCH * D_MODEL

kernel_name = 'hybrid_ssm_dilated_attn_conv_trunk'


def alibi_slopes(n_heads):
    return np.array([2.0 ** (-8.0 * (h + 1) / n_heads) for h in range(n_heads)], dtype=np.float32)


def rms_norm(x, g):
    x32 = x.astype(jnp.float32)
    y = x32 * lax.rsqrt(jnp.mean(x32 * x32, axis=-1, keepdims=True) + RMS_EPS)
    return y.astype(x.dtype) * g


def causal_dwconv(z, w):
    k_width = w.shape[0]
    seq = z.shape[1]
    zp = jnp.pad(z, ((0, 0), (k_width - 1, 0), (0, 0)))
    return sum(w[k] * zp[:, k_width - 1 - k:k_width - 1 - k + seq] for k in range(k_width))


def s5_mixer(u, log_dt, a_re, a_im, b_re, b_im, c_re, c_im, d_skip, w_glu, b_glu):
    f32 = jnp.float32
    bsz, seq, _ = u.shape
    u32 = u.astype(f32)
    ug = u32.reshape(bsz, seq, SSM_GROUPS, SSM_GROUP)
    dt = jnp.exp(log_dt.astype(f32))[:, None]
    ar, ai = a_re.astype(f32), a_im.astype(f32)
    mag = jnp.exp(ar * dt)
    lr, li = mag * jnp.cos(ai * dt), mag * jnp.sin(ai * dt)
    den = ar * ar + ai * ai
    fr = ((lr - 1.0) * ar + li * ai) / den
    fi = (li * ar - (lr - 1.0) * ai) / den
    br, bi = b_re.astype(f32), b_im.astype(f32)
    bbr = fr[..., None] * br - fi[..., None] * bi
    bbi = fr[..., None] * bi + fi[..., None] * br
    xr = jnp.einsum('blgc,gnc->blgn', ug, bbr)
    xi = jnp.einsum('blgc,gnc->blgn', ug, bbi)
    lam_r = jnp.broadcast_to(lr, xr.shape)
    lam_i = jnp.broadcast_to(li, xr.shape)

    def combine(e1, e2):
        a1r, a1i, b1r, b1i = e1
        a2r, a2i, b2r, b2i = e2
        return (a2r * a1r - a2i * a1i,
                a2r * a1i + a2i * a1r,
                a2r * b1r - a2i * b1i + b2r,
                a2r * b1i + a2i * b1r + b2i)

    _, _, hr, hi = lax.associative_scan(combine, (lam_r, lam_i, xr, xi), axis=1)
    y = (jnp.einsum('blgn,gcn->blgc', hr, c_re.astype(f32))
         - jnp.einsum('blgn,gcn->blgc', hi, c_im.astype(f32)))
    y = y.reshape(bsz, seq, SSM_WIDTH) + d_skip.astype(f32) * u32
    g = jax.nn.gelu(y).astype(u.dtype)
    return g * jax.nn.sigmoid(g @ w_glu + b_glu)


def dilated_window_attention(q, k, v, slopes, window, dilation):
    f32 = jnp.float32
    bsz, seq, n_h, e = q.shape
    w_steps = window // dilation
    qb_len = w_steps
    unit = dilation * qb_len
    seq_p = -(-seq // unit) * unit
    pad = seq_p - seq
    m_len = seq_p // dilation
    nb = m_len // qb_len

    def to_blocks(t):
        t = jnp.pad(t, ((0, 0), (0, pad), (0, 0), (0, 0)))
        t = t.reshape(bsz, m_len, dilation, n_h, e).transpose(0, 2, 1, 3, 4)
        return t.reshape(bsz, dilation, nb, qb_len, n_h, e)

    def with_prev(t):
        prev = jnp.pad(t[:, :, :-1], ((0, 0), (0, 0), (1, 0), (0, 0), (0, 0), (0, 0)))
        return jnp.concatenate([prev, t], axis=3)

    qb = to_blocks(q)
    kk = with_prev(to_blocks(k))
    vv = with_prev(to_blocks(v))
    s = jnp.einsum('brnqhe,brnkhe->brnhqk', qb, kk).astype(f32) * (e ** -0.5)
    qi = jnp.arange(qb_len)[:, None]
    kj = jnp.arange(2 * qb_len)[None, :]
    dist = qb_len + qi - kj
    blk = jnp.arange(nb)[:, None, None]
    valid = (dist >= 0) & (dist <= w_steps) & ((blk > 0) | (kj >= qb_len))
    bias = -slopes[:, None, None] * (dist * dilation).astype(f32)
    s = jnp.where(valid[:, None], s + bias, NEG_INF)
    m = jnp.max(s, axis=-1, keepdims=True)
    p = jnp.exp(s - m)
    l = jnp.sum(p, axis=-1, keepdims=True)
    o = jnp.einsum('brnhqk,brnkhe->brnqhe', p / l, vv.astype(f32))
    lse = (m + jnp.log(l))[..., 0]
    o = o.reshape(bsz, dilation, m_len, n_h, e).transpose(0, 2, 1, 3, 4).reshape(bsz, seq_p, n_h, e)
    lse = lse.transpose(0, 1, 2, 4, 3).reshape(bsz, dilation, m_len, n_h)
    lse = lse.transpose(0, 2, 1, 3).reshape(bsz, seq_p, n_h)
    return o[:, :seq], lse[:, :seq]


def dilated_attention_mixer(q, k, v):
    bsz, seq = q.shape[0], q.shape[1]
    slopes = jnp.asarray(alibi_slopes(N_ATTN_HEADS))
    outs, lses = [], []
    for g, (window, dilation) in enumerate(DSWA_PATTERNS):
        hs = slice(g * HEADS_PER_PATTERN, (g + 1) * HEADS_PER_PATTERN)
        o, lse = dilated_window_attention(q[:, :, hs], k[:, :, hs], v[:, :, hs], slopes[hs], window, dilation)
        outs.append(o)
        lses.append(lse)
    alpha = jax.nn.softmax(jnp.stack(lses, axis=0), axis=0)
    o = jnp.sum(alpha[..., None] * jnp.stack(outs, axis=0), axis=0)
    return o.reshape(bsz, seq, ATTN_WIDTH).astype(q.dtype)


def hybrid_mixer(h, w_in, ssm_log_dt, ssm_a_re, ssm_a_im, ssm_b_re, ssm_b_im, ssm_c_re, ssm_c_im,
                 ssm_d, w_glu, b_glu, conv_mix_w, w_ssm_out, w_attn_out, w_conv_out, b_gate, w_o):
    bsz, seq, _ = h.shape
    proj = h @ w_in
    u = proj[..., :OFF_Q]
    q = proj[..., OFF_Q:OFF_K].reshape(bsz, seq, N_ATTN_HEADS, HEAD_DIM)
    k = proj[..., OFF_K:OFF_V].reshape(bsz, seq, N_ATTN_HEADS, HEAD_DIM)
    v = proj[..., OFF_V:OFF_CONV].reshape(bsz, seq, N_ATTN_HEADS, HEAD_DIM)
    conv_b, conv_c, conv_h = jnp.split(proj[..., OFF_CONV:OFF_GATE], 3, axis=-1)
    gates = jax.nn.sigmoid(proj[..., OFF_GATE:] + b_gate).reshape(bsz, seq, N_BRANCH, D_MODEL)
    y_ssm = s5_mixer(u, ssm_log_dt, ssm_a_re, ssm_a_im, ssm_b_re, ssm_b_im, ssm_c_re, ssm_c_im,
                     ssm_d, w_glu, b_glu) @ w_ssm_out
    y_attn = dilated_attention_mixer(q, k, v) @ w_attn_out
    y_conv = (conv_b * causal_dwconv(conv_c * conv_h, conv_mix_w)) @ w_conv_out
    merged = gates[:, :, 0] * y_ssm + gates[:, :, 1] * y_attn + gates[:, :, 2] * y_conv
    return merged @ w_o


def conv_ffn(h, w_up, ffn_conv_w, w_down):
    up = causal_dwconv(h @ w_up, ffn_conv_w)
    a, b = jnp.split(up, 2, axis=-1)
    return (jax.nn.silu(a) * b) @ w_down


def setup_inputs(seed: int = 0) -> dict:
    key = jax.random.key(seed)
    ks = jax.random.split(key, 32)
    f32 = jnp.float32

    def nrm(k, shape, scale):
        return scale * jax.random.normal(k, shape, f32)

    nl = DEPTH
    n_idx = jnp.arange(SSM_STATE, dtype=f32)
    return {
        'x': nrm(ks[0], (BATCH, SEQ, D_MODEL), 1.0),
        'c': nrm(ks[1], (BATCH, D_MODEL), 1.0),
        'w_mod': nrm(ks[2], (nl, D_MODEL, 6 * D_MODEL), 0.5 * D_MODEL ** -0.5),
        'b_mod': nrm(ks[3], (nl, 6 * D_MODEL), 0.01),
        'g_pre_mix': 1.0 + nrm(ks[4], (nl, D_MODEL), 0.02),
        'g_post_mix': 1.0 + nrm(ks[5], (nl, D_MODEL), 0.02),
        'g_pre_ffn': 1.0 + nrm(ks[6], (nl, D_MODEL), 0.02),
        'g_post_ffn': 1.0 + nrm(ks[7], (nl, D_MODEL), 0.02),
        'w_in': nrm(ks[8], (nl, D_MODEL, N_IN), D_MODEL ** -0.5),
        'ssm_log_dt': jax.random.uniform(ks[9], (nl, SSM_GROUPS), f32, math.log(DT_MIN), math.log(DT_MAX)),
        'ssm_a_re': -0.5 + nrm(ks[10], (nl, SSM_GROUPS, SSM_STATE), 0.01),
        'ssm_a_im': jnp.pi * n_idx + nrm(ks[11], (nl, SSM_GROUPS, SSM_STATE), 0.01),
        'ssm_b_re': nrm(ks[12], (nl, SSM_GROUPS, SSM_STATE, SSM_GROUP), (2 * SSM_GROUP) ** -0.5),
        'ssm_b_im': nrm(ks[13], (nl, SSM_GROUPS, SSM_STATE, SSM_GROUP), (2 * SSM_GROUP) ** -0.5),
        'ssm_c_re': nrm(ks[14], (nl, SSM_GROUPS, SSM_GROUP, SSM_STATE), 0.5),
        'ssm_c_im': nrm(ks[15], (nl, SSM_GROUPS, SSM_GROUP, SSM_STATE), 0.5),
        'ssm_d': nrm(ks[16], (nl, SSM_WIDTH), 1.0),
        'w_glu': nrm(ks[17], (nl, SSM_WIDTH, SSM_WIDTH), SSM_WIDTH ** -0.5),
        'b_glu': nrm(ks[18], (nl, SSM_WIDTH), 0.01),
        'conv_mix_w': nrm(ks[19], (nl, CONV_K, CONV_WIDTH), CONV_K ** -0.5),
        'w_ssm_out': nrm(ks[20], (nl, SSM_WIDTH, D_MODEL), SSM_WIDTH ** -0.5),
        'w_attn_out': nrm(ks[21], (nl, ATTN_WIDTH, D_MODEL), ATTN_WIDTH ** -0.5),
        'w_conv_out': nrm(ks[22], (nl, CONV_WIDTH, D_MODEL), CONV_WIDTH ** -0.5),
        'b_gate': nrm(ks[23], (nl, N_BRANCH * D_MODEL), 0.01),
        'w_o': nrm(ks[24], (nl, D_MODEL, D_MODEL), D_MODEL ** -0.5),
        'w_up': nrm(ks[25], (nl, D_MODEL, 2 * D_FF), D_MODEL ** -0.5),
        'ffn_conv_w': nrm(ks[26], (nl, FFN_CONV_K, 2 * D_FF), FFN_CONV_K ** -0.5),
        'w_down': nrm(ks[27], (nl, D_FF, D_MODEL), D_FF ** -0.5),
    }


def reference(x, c, w_mod, b_mod, g_pre_mix, g_post_mix, g_pre_ffn, g_post_ffn, w_in,
              ssm_log_dt, ssm_a_re, ssm_a_im, ssm_b_re, ssm_b_im, ssm_c_re, ssm_c_im, ssm_d,
              w_glu, b_glu, conv_mix_w, w_ssm_out, w_attn_out, w_conv_out, b_gate, w_o,
              w_up, ffn_conv_w, w_down):
    cond = jax.nn.silu(c)
    for l in range(DEPTH):
        mod = cond @ w_mod[l] + b_mod[l]
        sh1, sc1, gt1, sh2, sc2, gt2 = jnp.split(mod, 6, axis=-1)
        h = rms_norm(x, g_pre_mix[l]) * (1.0 + sc1[:, None]) + sh1[:, None]
        y = hybrid_mixer(h, w_in[l], ssm_log_dt[l], ssm_a_re[l], ssm_a_im[l], ssm_b_re[l], ssm_b_im[l],
                         ssm_c_re[l], ssm_c_im[l], ssm_d[l], w_glu[l], b_glu[l], conv_mix_w[l],
                         w_ssm_out[l], w_attn_out[l], w_conv_out[l], b_gate[l], w_o[l])
        x = x + gt1[:, None] * rms_norm(y, g_post_mix[l])
        h = rms_norm(x, g_pre_ffn[l]) * (1.0 + sc2[:, None]) + sh2[:, None]
        y = conv_ffn(h, w_up[l], ffn_conv_w[l], w_down[l])
        x = x + gt2[:, None] * rms_norm(y, g_post_ffn[l])
    return x
```

```cpp
#include <hip/hip_runtime.h>
#include <cstdio>
#include <cstdint>
namespace pg8 {
#define PG8_LAS __attribute__((address_space(3)))
typedef unsigned short bf16_t;
typedef short bf16x8 __attribute__((ext_vector_type(8)));
typedef float f32x4 __attribute__((ext_vector_type(4)));
typedef unsigned u32x4 __attribute__((ext_vector_type(4)));
constexpr int BM = 256, BK = 64, HALF = 128, HTB = HALF * BK * 2  , STAGE_BYTES = 8 * HTB, NXCD = 8, WGM = 8;

__host__ __device__ __forceinline__ int lds_byte(int r, int c) { const int st = (r >> 4) * 2 + (c >> 5), rr = r & 15, cc = c & 31, ob = rr * 64 + cc * 2; return st * 1024 + (ob ^ (((ob >> 9) & 1) << 5)); }
__host__ __device__ __forceinline__ void stage_rc(int b, int& R, int& C) { const int st = b / 1024, sb = b % 1024, swz = sb ^ (((sb >> 9) & 1) << 5); R = (st >> 1) * 16 + swz / 64; C = (st & 1) * 32 + (swz % 64) / 2; }
__host__ __device__ __forceinline__ int perm32(int rho) { const int n = rho >> 4, i = rho & 15; return 8 * (i >> 2) + 4 * n + (i & 3); }

struct Unit { int pm, pn; };
struct Gemm { const bf16_t* A; const bf16_t* Bt; int M, N, K; };

struct StaticOrder {
    int nM, nN, nwg, G, c;
    __host__ __device__ void init(int M, int N, int G_, int c_) { nM = M / BM; nN = N / BM; nwg = nM * nN; G = G_; c = c_; }
    __host__ __device__ bool next(int i, Unit& u) const {
        const long L = (long)i * G + c; if (L >= nwg) return false;
        int wgid = (int)L; { const int q = nwg / NXCD, r = nwg % NXCD, xcd = wgid % NXCD, off = wgid / NXCD; wgid = (xcd < r ? xcd * (q + 1) : r * (q + 1) + (xcd - r) * q) + off; }
        const int nig = WGM * nN, gid = wgid / nig, fm = gid * WGM, gsz = (nM - fm) < WGM ? (nM - fm) : WGM;
        u.pm = fm + ((wgid % nig) % gsz); u.pn = (wgid % nig) / gsz; return true;
    }
    __device__ __forceinline__ void a_ready(const Unit&) const {}
    __device__ __forceinline__ void done(const Unit&) const {}
};

typedef float cvt_f32x2 __attribute__((ext_vector_type(2))); typedef __bf16 cvt_bf16x2 __attribute__((ext_vector_type(2)));
__device__ __forceinline__ unsigned cvt_pk_bf16(float lo, float hi) { cvt_f32x2 v = {lo, hi}; cvt_bf16x2 b = __builtin_convertvector(v, cvt_bf16x2); return __builtin_bit_cast(unsigned, b); }
__device__ __forceinline__ float sigm(float x) { return __builtin_amdgcn_rcpf(1.0f + __expf(-x)); }
__device__ __forceinline__ float bflo(unsigned w) { return __uint_as_float(w << 16); }
__device__ __forceinline__ float bfhi(unsigned w) { return __uint_as_float(w & 0xffff0000u); }
__device__ __forceinline__ u32x4 pack8(const f32x4& v0, const f32x4& v1) { u32x4 w; w.x = cvt_pk_bf16(v0[0], v0[1]); w.y = cvt_pk_bf16(v0[2], v0[3]); w.z = cvt_pk_bf16(v1[0], v1[1]); w.w = cvt_pk_bf16(v1[2], v1[3]); return w; }
struct EpiStore {
    static constexpr bool PERM = true, AFTER_DRAIN = false;
    bf16_t* O; int ldc;
    __device__ __forceinline__ void operator()(const f32x4 (&acc)[2][2][4][2], const Unit& u, int wr, int wc, int fr, int fq) const {
        const int row0 = u.pm * BM + wr * 64 + fr, col0 = u.pn * BM + wc * 32 + 8 * fq;
#pragma unroll
        for (int ai = 0; ai < 2; ++ai)
#pragma unroll
            for (int m = 0; m < 4; ++m) { bf16_t* rowp = O + (size_t)(row0 + ai * HALF + m * 16) * ldc + col0;
#pragma unroll
                for (int bj = 0; bj < 2; ++bj) *(u32x4*)(rowp + bj * HALF) = pack8(acc[ai][bj][m][0], acc[ai][bj][m][1]); }
    }
};
struct EpiIn {
    static constexpr bool PERM = true, AFTER_DRAIN = false;
    bf16_t* O; int ldc; const float* bgate; int gate_tile0;
    __device__ __forceinline__ void operator()(const f32x4 (&acc)[2][2][4][2], const Unit& u, int wr, int wc, int fr, int fq) const {
        const int row0 = u.pm * BM + wr * 64 + fr, col0 = u.pn * BM + wc * 32 + 8 * fq;
        if (u.pn >= gate_tile0) {
            const float* bp = bgate + (col0 - gate_tile0 * BM);
            f32x4 bv[2][2];
#pragma unroll
            for (int bj = 0; bj < 2; ++bj)
#pragma unroll
                for (int n = 0; n < 2; ++n) bv[bj][n] = *(const f32x4*)(bp + bj * HALF + 4 * n);
#pragma unroll
            for (int ai = 0; ai < 2; ++ai)
#pragma unroll
                for (int m = 0; m < 4; ++m) { bf16_t* rowp = O + (size_t)(row0 + ai * HALF + m * 16) * ldc + col0;
#pragma unroll
                    for (int bj = 0; bj < 2; ++bj) { f32x4 v0 = acc[ai][bj][m][0] + bv[bj][0], v1 = acc[ai][bj][m][1] + bv[bj][1];
#pragma unroll
                        for (int j = 0; j < 4; ++j) { v0[j] = sigm(v0[j]); v1[j] = sigm(v1[j]); }
                        *(u32x4*)(rowp + bj * HALF) = pack8(v0, v1); } }
        } else {
#pragma unroll
            for (int ai = 0; ai < 2; ++ai)
#pragma unroll
                for (int m = 0; m < 4; ++m) { bf16_t* rowp = O + (size_t)(row0 + ai * HALF + m * 16) * ldc + col0;
#pragma unroll
                    for (int bj = 0; bj < 2; ++bj) *(u32x4*)(rowp + bj * HALF) = pack8(acc[ai][bj][m][0], acc[ai][bj][m][1]); }
        }
    }
};
struct EpiGlu {
    static constexpr bool PERM = true, AFTER_DRAIN = false;
    const bf16_t* G; bf16_t* O; int ldc; const float* bias;
    __device__ __forceinline__ void operator()(const f32x4 (&acc)[2][2][4][2], const Unit& u, int wr, int wc, int fr, int fq) const {
        const int row0 = u.pm * BM + wr * 64 + fr, col0 = u.pn * BM + wc * 32 + 8 * fq;
        f32x4 bv[2][2];
#pragma unroll
        for (int bj = 0; bj < 2; ++bj)
#pragma unroll
            for (int n = 0; n < 2; ++n) bv[bj][n] = *(const f32x4*)(bias + col0 + bj * HALF + 4 * n);
#pragma unroll
        for (int ai = 0; ai < 2; ++ai)
#pragma unroll
            for (int m = 0; m < 4; ++m) { const size_t off = (size_t)(row0 + ai * HALF + m * 16) * ldc + col0;
#pragma unroll
                for (int bj = 0; bj < 2; ++bj) { const u32x4 gw = *(const u32x4*)(G + off + bj * HALF);
                    f32x4 v0 = acc[ai][bj][m][0] + bv[bj][0], v1 = acc[ai][bj][m][1] + bv[bj][1];
                    v0[0] = bflo(gw.x) * sigm(v0[0]); v0[1] = bfhi(gw.x) * sigm(v0[1]); v0[2] = bflo(gw.y) * sigm(v0[2]); v0[3] = bfhi(gw.y) * sigm(v0[3]);
                    v1[0] = bflo(gw.z) * sigm(v1[0]); v1[1] = bfhi(gw.z) * sigm(v1[1]); v1[2] = bflo(gw.w) * sigm(v1[2]); v1[3] = bfhi(gw.w) * sigm(v1[3]);
                    *(u32x4*)(O + off + bj * HALF) = pack8(v0, v1); } }
    }
};
struct EpiBr {
    static constexpr bool PERM = true, AFTER_DRAIN = false;
    const bf16_t* gates; int ldg; bf16_t* Mg; bf16_t* Mg2; int ldm;
    __device__ __forceinline__ void operator()(const f32x4 (&acc)[2][2][4][2], const Unit& u, int wr, int wc, int fr, int fq) const {
        const int br = u.pm >> 6, pm = u.pm & 63, pn = u.pn & 7;
        const int row0 = pm * BM + wr * 64 + fr, col0 = pn * BM + wc * 32 + 8 * fq;
        bf16_t* dst = (br == 2) ? Mg2 : Mg;
#pragma unroll
        for (int ai = 0; ai < 2; ++ai)
#pragma unroll
            for (int m = 0; m < 4; ++m) { const int row = row0 + ai * HALF + m * 16; const bf16_t* gp = gates + (size_t)row * ldg + br * ldm + col0; const size_t mo = (size_t)row * ldm + col0;
#pragma unroll
                for (int bj = 0; bj < 2; ++bj) { const u32x4 gw = *(const u32x4*)(gp + bj * HALF);
                    f32x4 v0 = acc[ai][bj][m][0], v1 = acc[ai][bj][m][1];
                    v0[0] *= bflo(gw.x); v0[1] *= bfhi(gw.x); v0[2] *= bflo(gw.y); v0[3] *= bfhi(gw.y); v1[0] *= bflo(gw.z); v1[1] *= bfhi(gw.z); v1[2] *= bflo(gw.w); v1[3] *= bfhi(gw.w);
                    if (br == 0) { const u32x4 ow = *(const u32x4*)(Mg + mo + bj * HALF), pw = *(const u32x4*)(Mg2 + mo + bj * HALF);
                        v0[0] += bflo(ow.x) + bflo(pw.x); v0[1] += bfhi(ow.x) + bfhi(pw.x); v0[2] += bflo(ow.y) + bflo(pw.y); v0[3] += bfhi(ow.y) + bfhi(pw.y);
                        v1[0] += bflo(ow.z) + bflo(pw.z); v1[1] += bfhi(ow.z) + bfhi(pw.z); v1[2] += bflo(ow.w) + bflo(pw.w); v1[3] += bfhi(ow.w) + bfhi(pw.w); }
                    *(u32x4*)(dst + mo + bj * HALF) = pack8(v0, v1); } }
    }
};
struct BrPairOrder {
    StaticOrder so;
    __host__ __device__ void init(int M, int N, int G_, int c_) { so.init(M, N, G_, c_); }
    __host__ __device__ bool next(int i, Unit& u) const { Unit t; if (!so.next(i >> 1, t)) return false; const int br = 1 + (i & 1); u.pm = t.pm + 64 * br; u.pn = t.pn + 8 * br; return true; }
    __device__ __forceinline__ void a_ready(const Unit&) const {}
    __device__ __forceinline__ void done(const Unit&) const {}
};
template <class Epi, class Sched, bool ALIGN_EPI = false, bool SP2 = false>
__device__ __forceinline__ void gemm_phase(PG8_LAS unsigned char* lds, const Gemm g, const Sched& S, const Epi& E) {
    int tid = threadIdx.x; asm volatile("" : "+v"(tid)); const int wid = __builtin_amdgcn_readfirstlane(tid >> 6), lane = tid & 63, wr = wid >> 2, wc = wid & 3, fr = lane & 15, fq = lane >> 4;
    const int K = g.K, nt = K / BK;
    unsigned voffA[2], voffB[2];
#pragma unroll
    for (int i = 0; i < 2; ++i) { int R, C; stage_rc(tid * 16 + i * 8192, R, C); const int Rb = Epi::PERM ? ((R & ~31) + perm32(R & 31)) : R;
        voffA[i] = (unsigned)(R * K + C) * 2u; voffB[i] = (unsigned)(Rb * K + C) * 2u; }
    const size_t kstep = (size_t)(BK * 2);
    const size_t hstep = (size_t)HALF * K * 2;
    const size_t tstep = 2 * hstep;
    const unsigned ldsw = (unsigned)wid * 1024u;
    const int aoff = lds_byte(wr * 64 + fr, fq * 8), boff = lds_byte(wc * 32 + fr, fq * 8);
#define PG8_SA(b, h) (((b) * 2 + (h)) * HTB)
#define PG8_SB(b, h) ((4 + (b) * 2 + (h)) * HTB)
#define PG8_STAGE(bufoff, gbase, voff) do { _Pragma("unroll") for (int _i = 0; _i < 2; ++_i) \
        __builtin_amdgcn_global_load_lds((const unsigned*)((const char*)(gbase) + (voff)[_i]), (PG8_LAS unsigned*)(lds + (bufoff) + ldsw + _i * 8192), 16, 0, 0); } while (0)
#define PG8_LDA(dst, b, h) do { _Pragma("unroll") for (int m = 0; m < 4; ++m) _Pragma("unroll") for (int k = 0; k < 2; ++k) dst[m][k] = *(const PG8_LAS bf16x8*)(lds + PG8_SA(b, h) + aoff + m * 2048 + k * 1024); } while (0)
#define PG8_LDB(dst, b, h) do { _Pragma("unroll") for (int n = 0; n < 2; ++n) _Pragma("unroll") for (int k = 0; k < 2; ++k) dst[n][k] = *(const PG8_LAS bf16x8*)(lds + PG8_SB(b, h) + boff + n * 2048 + k * 1024); } while (0)
#define PG8_MMA(ai, bj, At, Bt) do { __builtin_amdgcn_s_setprio(1); _Pragma("unroll") for (int m = 0; m < 4; ++m) _Pragma("unroll") for (int n = 0; n < 2; ++n) _Pragma("unroll") for (int k = 0; k < 2; ++k) \
        acc[ai][bj][m][n] = __builtin_amdgcn_mfma_f32_16x16x32_bf16(Bt[n][k], At[m][k], acc[ai][bj][m][n], 0, 0, 0); __builtin_amdgcn_s_setprio(0); } while (0)
#define PG8_WAIT_V(n) asm volatile("s_waitcnt vmcnt(" #n ")" ::: "memory")
#define PG8_WAIT_L(n) asm volatile("s_waitcnt lgkmcnt(" #n ")" ::: "memory")
#define PG8_BAR __builtin_amdgcn_s_barrier()
#define PG8_SCHED __builtin_amdgcn_sched_barrier(0)
    Unit cur, nxt; int ui = 0;
    if (!S.next(0, cur)) return;
    f32x4 acc[2][2][4][2];
#pragma unroll
    for (int a = 0; a < 2; ++a)
#pragma unroll
        for (int b = 0; b < 2; ++b)
#pragma unroll
            for (int m = 0; m < 4; ++m)
#pragma unroll
                for (int n = 0; n < 2; ++n) acc[a][b][m][n] = (f32x4){0.f, 0.f, 0.f, 0.f};
    bf16x8 At[4][2], B0[2][2], B1[2][2];
    const char* cA = (const char*)g.A + (size_t)cur.pm * tstep; const char* cB = (const char*)g.Bt + (size_t)cur.pn * tstep;
    S.a_ready(cur);
    if constexpr (SP2) {
        PG8_STAGE(PG8_SB(0, 0), cB, voffB); PG8_STAGE(PG8_SB(0, 1), cB + hstep, voffB); PG8_STAGE(PG8_SA(0, 0), cA, voffA); PG8_STAGE(PG8_SA(0, 1), cA + hstep, voffA);
        if (wr == 1) PG8_BAR;
        PG8_WAIT_V(2); PG8_BAR;
        PG8_STAGE(PG8_SB(1, 0), cB + kstep, voffB); PG8_STAGE(PG8_SA(1, 0), cA + kstep, voffA); PG8_STAGE(PG8_SB(1, 1), cB + hstep + kstep, voffB);
        PG8_WAIT_V(6); PG8_BAR;
    } else {
        PG8_STAGE(PG8_SB(0, 0), cB, voffB); PG8_STAGE(PG8_SA(0, 0), cA, voffA); PG8_STAGE(PG8_SB(0, 1), cB + hstep, voffB); PG8_STAGE(PG8_SA(0, 1), cA + hstep, voffA);
        if (wr == 1) PG8_BAR;
        PG8_WAIT_V(4); PG8_BAR;
        PG8_STAGE(PG8_SB(1, 0), cB + kstep, voffB); PG8_STAGE(PG8_SA(1, 0), cA + kstep, voffA); PG8_STAGE(PG8_SB(1, 1), cB + hstep + kstep, voffB);
        PG8_WAIT_V(6); PG8_BAR;
    }
    for (;;) {
        const bool has_next = S.next(ui + 1, nxt);
        const char* nA = has_next ? (const char*)g.A + (size_t)nxt.pm * tstep : cA; const char* nB = has_next ? (const char*)g.Bt + (size_t)nxt.pn * tstep : cB;
        for (int t = 0; t < nt; t += 2) {
            const bool last = (t == nt - 2);
            const char* a1 = cA + (size_t)(t + 1) * kstep;
            const char* a2 = last ? nA : cA + (size_t)(t + 2) * kstep; const char* b2 = last ? nB : cB + (size_t)(t + 2) * kstep;
            const char* a3 = a2 + kstep; const char* b3 = b2 + kstep;
            if (last && has_next) S.a_ready(nxt);
            if constexpr (SP2) {
            PG8_LDB(B0, 0, 0); PG8_LDB(B1, 0, 1); PG8_SCHED; PG8_LDA(At, 0, 0); PG8_STAGE(PG8_SA(1, 1), a1 + hstep, voffA);
            PG8_WAIT_V(8); PG8_WAIT_L(0); PG8_BAR; PG8_MMA(0, 0, At, B0); PG8_MMA(0, 1, At, B1); PG8_BAR; PG8_SCHED;
            PG8_LDA(At, 0, 1); PG8_STAGE(PG8_SB(0, 0), b2, voffB); PG8_STAGE(PG8_SB(0, 1), b2 + hstep, voffB); PG8_STAGE(PG8_SA(0, 0), a2, voffA);
            PG8_WAIT_V(8); PG8_WAIT_L(0); PG8_BAR; PG8_MMA(1, 0, At, B0); PG8_MMA(1, 1, At, B1); PG8_BAR; PG8_SCHED;
            PG8_LDB(B0, 1, 0); PG8_LDB(B1, 1, 1); PG8_SCHED; PG8_LDA(At, 1, 0); PG8_STAGE(PG8_SA(0, 1), a2 + hstep, voffA);
            PG8_WAIT_V(8); PG8_WAIT_L(0); PG8_BAR; PG8_MMA(0, 0, At, B0); PG8_MMA(0, 1, At, B1); PG8_BAR; PG8_SCHED;
            PG8_LDA(At, 1, 1); PG8_STAGE(PG8_SB(1, 0), b3, voffB); PG8_STAGE(PG8_SB(1, 1), b3 + hstep, voffB); PG8_STAGE(PG8_SA(1, 0), a3, voffA);
            PG8_WAIT_V(8); PG8_WAIT_L(0); PG8_BAR; PG8_MMA(1, 0, At, B0); PG8_MMA(1, 1, At, B1); PG8_BAR; PG8_SCHED;
            } else {
            PG8_LDB(B0, 0, 0); PG8_SCHED; PG8_LDA(At, 0, 0); PG8_STAGE(PG8_SA(1, 1), a1 + hstep, voffA);
            PG8_WAIT_L(8); PG8_BAR; PG8_WAIT_L(0); PG8_MMA(0, 0, At, B0); PG8_BAR; PG8_SCHED;
            PG8_LDB(B1, 0, 1); PG8_STAGE(PG8_SB(0, 0), b2, voffB);
            PG8_BAR; PG8_WAIT_L(0); PG8_MMA(0, 1, At, B1); PG8_BAR;
            PG8_LDA(At, 0, 1); PG8_STAGE(PG8_SA(0, 0), a2, voffA);
            PG8_BAR; PG8_WAIT_L(0); PG8_MMA(1, 0, At, B0); PG8_BAR; PG8_SCHED;
            PG8_STAGE(PG8_SB(0, 1), b2 + hstep, voffB);
            PG8_WAIT_V(6); PG8_BAR; PG8_MMA(1, 1, At, B1); PG8_BAR;
            PG8_LDB(B0, 1, 0); PG8_SCHED; PG8_LDA(At, 1, 0); PG8_STAGE(PG8_SA(0, 1), a2 + hstep, voffA);
            PG8_WAIT_L(8); PG8_BAR; PG8_WAIT_L(0); PG8_MMA(0, 0, At, B0); PG8_BAR; PG8_SCHED;
            PG8_LDB(B1, 1, 1); PG8_STAGE(PG8_SB(1, 0), b3, voffB);
            PG8_BAR; PG8_WAIT_L(0); PG8_MMA(0, 1, At, B1); PG8_BAR;
            PG8_LDA(At, 1, 1); PG8_STAGE(PG8_SA(1, 0), a3, voffA);
            PG8_BAR; PG8_WAIT_L(0); PG8_MMA(1, 0, At, B0); PG8_BAR; PG8_SCHED;
            PG8_STAGE(PG8_SB(1, 1), b3 + hstep, voffB);
            PG8_WAIT_V(6); PG8_BAR; PG8_MMA(1, 1, At, B1); PG8_BAR;
            }
        }
        if constexpr (ALIGN_EPI) { if (wr == 0) PG8_BAR; }
        if constexpr (!Epi::AFTER_DRAIN) { E(acc, cur, wr, wc, fr, fq); S.done(cur); }
        if (!has_next) break;
#pragma unroll
        for (int a = 0; a < 2; ++a)
#pragma unroll
            for (int b = 0; b < 2; ++b)
#pragma unroll
                for (int m = 0; m < 4; ++m)
#pragma unroll
                    for (int n = 0; n < 2; ++n) acc[a][b][m][n] = (f32x4){0.f, 0.f, 0.f, 0.f};
        cur = nxt; cA = nA; cB = nB; ++ui;
        if constexpr (ALIGN_EPI) { if (wr == 1) PG8_BAR; }
    }
    PG8_WAIT_V(0);
    if constexpr (!ALIGN_EPI) { if (wr == 0) PG8_BAR; }
    PG8_BAR;
    if constexpr (Epi::AFTER_DRAIN) { E.fused(acc, cur, wr, wc, fr, fq, lds, wid, lane); S.done(cur); }
#undef PG8_SA
#undef PG8_SB
#undef PG8_STAGE
#undef PG8_LDA
#undef PG8_LDB
#undef PG8_MMA
#undef PG8_WAIT_V
#undef PG8_WAIT_L
#undef PG8_BAR
#undef PG8_SCHED
}
}
constexpr int NWAVES = 8;
constexpr int DM = 2048, BATCH = 8, SEQ = 2048, DEPTH = 4, M = BATCH * SEQ;
constexpr int SSMW = 512, NGRP = 32, NST = 64, HD = 64;
constexpr int OFF_Q = 512, OFF_K = 2048, OFF_V = 3584, OFF_CB = 5120, OFF_CC = 5632, OFF_CH = 6144, OFF_GATE = 6656, N_IN = 12800;
constexpr int DFF = 5632, NUP = 2 * DFF;
constexpr int NMOD = 6 * DM;
constexpr float RMS_EPS = 1e-6f;
enum { I_X = 0, I_C, I_WMOD, I_BMOD, I_GPRE_MIX, I_GPOST_MIX, I_GPRE_FFN, I_GPOST_FFN, I_WIN, I_LOGDT, I_ARE, I_AIM, I_BRE, I_BIM, I_CRE, I_CIM, I_SSMD, I_WGLU, I_BGLU,
       I_CONVW, I_WSSM, I_WATT, I_WCNV, I_BGATE, I_WO, I_WUP, I_FCONVW, I_WDOWN, N_INPUTS };
constexpr size_t MiB = 1u << 20;
constexpr size_t WS_CTL = 0, CTL_ZERO_BYTES = 1 * MiB;
constexpr size_t WS_MOD = 1 * MiB;
constexpr size_t WS_W = 4 * MiB;
constexpr size_t WB_IN = 0, WB_GLU = WB_IN + (size_t)N_IN * DM * 2, WB_BR = WB_GLU + (size_t)SSMW * SSMW * 2, WB_O = WB_BR + (size_t)3 * DM * SSMW * 2,
                 WB_UP = WB_O + (size_t)DM * DM * 2, WB_DN = WB_UP + (size_t)NUP * DM * 2, WB_LAYER = WB_DN + (size_t)DM * DFF * 2;
static_assert(WB_LAYER == (size_t)(50 * MiB + MiB / 2 + 6 * MiB + 8 * MiB + 44 * MiB + 22 * MiB), "weights per layer");
constexpr size_t WS_H = 528 * MiB;
constexpr size_t WS_PROJ = 592 * MiB;
constexpr size_t WS_ACT = 992 * MiB;
constexpr size_t WS_G = 1168 * MiB;
constexpr size_t WS_A3 = 1184 * MiB;
constexpr size_t WS_MG = 1232 * MiB;
constexpr size_t WS_Y = 1296 * MiB;
constexpr size_t WS_END = 1360 * MiB;
static_assert(WS_W + DEPTH * WB_LAYER <= WS_H && WS_PROJ + (size_t)M * N_IN * 2 <= WS_ACT && WS_ACT + (size_t)M * DFF * 2 <= WS_G, "ws map");
constexpr int CW_BAR = 4096;
constexpr int RING_BYTES = 131072, MISC_OFF = 143360, LDS_BYTES = 147456;

#define GAS __attribute__((address_space(1)))
#define LAS __attribute__((address_space(3)))
typedef unsigned short bf16;
typedef unsigned v4u __attribute__((ext_vector_type(4)));
typedef unsigned v2u __attribute__((ext_vector_type(2)));
typedef float f32x4 __attribute__((ext_vector_type(4)));
typedef short bf16x8 __attribute__((ext_vector_type(8)));
typedef short s16x4 __attribute__((ext_vector_type(4)));
#define LDS_WAIT() asm volatile("s_waitcnt lgkmcnt(0)" ::: "memory")
#define VM_WAIT() asm volatile("s_waitcnt vmcnt(0)" ::: "memory")
__device__ __forceinline__ unsigned f2bf(float f) { unsigned u = __builtin_bit_cast(unsigned, f); return (u + 0x7fffu + ((u >> 16) & 1u)) >> 16; }
__device__ __forceinline__ unsigned pk2(float lo, float hi) { return pg8::cvt_pk_bf16(lo, hi); }
__device__ __forceinline__ float bflo(unsigned w) { return __uint_as_float(w << 16); }
__device__ __forceinline__ float bfhi(unsigned w) { return __uint_as_float(w & 0xffff0000u); }
__device__ __forceinline__ void unpack8(const v4u w, float (&f)[8]) { f[0] = bflo(w.x); f[1] = bfhi(w.x); f[2] = bflo(w.y); f[3] = bfhi(w.y); f[4] = bflo(w.z); f[5] = bfhi(w.z); f[6] = bflo(w.w); f[7] = bfhi(w.w); }
__device__ __forceinline__ v4u pack8f(const float (&f)[8]) { v4u w; w.x = pk2(f[0], f[1]); w.y = pk2(f[2], f[3]); w.z = pk2(f[4], f[5]); w.w = pk2(f[6], f[7]); return w; }
__device__ __forceinline__ float wave_sum(float v) {
#pragma unroll
    for (int o = 1; o < 64; o <<= 1) v += __shfl_xor(v, o);
    return v;
}
#define XB_TMO      128
#define XB_XCNT(j)  (256  + 64 * (j))
#define XB_XSUB(j)  (1280 + 64 * (j))
#define XB_XGEN(j)  (2304 + 64 * (j))
#define XB_TOP      3328
#define XB_TOPGEN   3392
#define XCD_BAR_WORDS 3456
#define XB_SPIN_CAP (1u << 18)

__device__ __forceinline__ unsigned xb_ld(unsigned* p)              { return __hip_atomic_load(p, __ATOMIC_RELAXED, __HIP_MEMORY_SCOPE_AGENT); }
__device__ __forceinline__ unsigned xb_add(unsigned* p, unsigned v) { return __hip_atomic_fetch_add(p, v, __ATOMIC_RELAXED, __HIP_MEMORY_SCOPE_AGENT); }
__device__ __forceinline__ unsigned xb_xcc_id() { return (unsigned)__builtin_amdgcn_s_getreg((3 << 11) | 20) & 0xFu; }
#define XB_SPIN(cond, bar) do { unsigned _sp = 0; while (cond) { __builtin_amdgcn_s_sleep(1); \
    if ((++_sp & 255u) == 0u) { if (xb_ld(&(bar)[XB_TMO])) break; if (_sp > XB_SPIN_CAP) { atomicAdd(&(bar)[XB_TMO], 1u); break; } } } } while (0)

struct XcdBarrier {
    unsigned* bar; unsigned x;
    volatile LAS unsigned* st;
};

__device__ __forceinline__ XcdBarrier xcd_barrier_post(unsigned* bar, volatile LAS unsigned* st) {
    XcdBarrier b; b.bar = bar; b.x = xb_xcc_id(); b.st = st;
    if (threadIdx.x == 0) (void)xb_add(&bar[XB_XCNT(b.x)], 1u);
    return b;
}
__device__ __forceinline__ void xcd_barrier_complete(unsigned* bar, unsigned x, unsigned& nloc, unsigned& nx) {
    const unsigned G = gridDim.x * gridDim.y * gridDim.z;
    unsigned sum, cnt, mine, sp = 0u;
    for (;;) {
        sum = 0u; cnt = 0u; mine = 0u;
#pragma unroll
        for (unsigned j = 0; j < 16; ++j) { const unsigned c = xb_ld(&bar[XB_XCNT(j)]); sum += c; cnt += (c > 0u) ? 1u : 0u; mine = (j == x) ? c : mine; }
        if (sum == G) break;
        __builtin_amdgcn_s_sleep(1);
        if ((++sp & 255u) == 0u) { if (xb_ld(&bar[XB_TMO])) break; if (sp > XB_SPIN_CAP) { atomicAdd(&bar[XB_TMO], 1u); break; } }
    }
    nloc = mine > 0u ? mine : 1u; nx = cnt > 0u ? cnt : 1u;
}

__device__ __forceinline__ void xcd_barrier(const XcdBarrier& b) {
    asm volatile("s_waitcnt vmcnt(0)" ::: "memory");
    __syncthreads();
    if (threadIdx.x == 0) {
        unsigned* bar = b.bar;
        __builtin_amdgcn_s_waitcnt(0);
        unsigned nloc = b.st[0], nx = b.st[1];
        if (nloc == 0u) { xcd_barrier_complete(bar, b.x, nloc, nx); b.st[0] = nloc; b.st[1] = nx; }
        const unsigned old = xb_add(&bar[XB_XSUB(b.x)], 1u);
        const unsigned gen = old / nloc;
        if (old + 1u == (gen + 1u) * nloc) {
            __builtin_amdgcn_fence(__ATOMIC_RELEASE, "agent");
            asm volatile("s_waitcnt vmcnt(0)" ::: "memory");
            const unsigned og = xb_add(&bar[XB_TOP], 1u);
            const unsigned tg = og / nx;
            if (og + 1u == (tg + 1u) * nx) xb_add(&bar[XB_TOPGEN], 1u);
            else XB_SPIN(xb_ld(&bar[XB_TOPGEN]) == tg, bar);
            __builtin_amdgcn_fence(__ATOMIC_ACQUIRE, "agent");
            xb_add(&bar[XB_XGEN(b.x)], 1u);
            asm volatile("s_waitcnt vmcnt(0)" ::: "memory");
        } else {
            XB_SPIN(xb_ld(&bar[XB_XGEN(b.x)]) == gen, bar);
            __builtin_amdgcn_fence(__ATOMIC_ACQUIRE, "agent");
            asm volatile("s_waitcnt vmcnt(0)" ::: "memory");
        }
    }
    __syncthreads();
}
__device__ __forceinline__ void p0_transpose_item(const float* W, int K, int N, bf16* WT, int row_off, LAS float* scr, int item, int lane) {
    const int nblk = N / 32, kb = item / nblk, nb = item % nblk, k0 = 64 * kb, n0 = 32 * nb;
#pragma unroll 8
    for (int i = 0; i < 32; ++i) { const int kk = 2 * i + (lane >> 5); scr[kk * 33 + (lane & 31)] = W[(size_t)(k0 + kk) * N + n0 + (lane & 31)]; }
    LDS_WAIT(); asm volatile("" ::: "memory");
    const int c = lane & 7;
#pragma unroll
    for (int j = 0; j < 4; ++j) { const int n = (lane >> 3) + 8 * j; const LAS float* s = scr + (8 * c) * 33 + n;
        v4u o; o.x = pk2(s[0 * 33], s[1 * 33]); o.y = pk2(s[2 * 33], s[3 * 33]); o.z = pk2(s[4 * 33], s[5 * 33]); o.w = pk2(s[6 * 33], s[7 * 33]);
        *(GAS v4u*)(WT + (size_t)(row_off + n0 + n) * K + k0 + 8 * c) = o; }
    LDS_WAIT(); asm volatile("" ::: "memory");
}
constexpr int TI_IN = (DM / 64) * (N_IN / 32), TI_GLU = (SSMW / 64) * (SSMW / 32), TI_BR = (SSMW / 64) * (DM / 32), TI_O = (DM / 64) * (DM / 32), TI_UP = (DM / 64) * (NUP / 32), TI_DN = (DFF / 64) * (DM / 32);
constexpr int TI_LAYER = TI_IN + TI_GLU + 3 * TI_BR + TI_O + TI_UP + TI_DN, TI_ALL = DEPTH * TI_LAYER;
__device__ __forceinline__ void p0_transpose_any(const float* const* in, unsigned char* ws, LAS float* scr, int it, int lane) {
    const int l = it / TI_LAYER; int r = it % TI_LAYER;
    unsigned char* wl = ws + WS_W + (size_t)l * WB_LAYER;
    if (r < TI_IN) { p0_transpose_item(in[I_WIN] + (size_t)l * DM * N_IN, DM, N_IN, (bf16*)(wl + WB_IN), 0, scr, r, lane); return; } r -= TI_IN;
    if (r < TI_GLU) { p0_transpose_item(in[I_WGLU] + (size_t)l * SSMW * SSMW, SSMW, SSMW, (bf16*)(wl + WB_GLU), 0, scr, r, lane); return; } r -= TI_GLU;
    if (r < TI_BR) { p0_transpose_item(in[I_WSSM] + (size_t)l * SSMW * DM, SSMW, DM, (bf16*)(wl + WB_BR), 0, scr, r, lane); return; } r -= TI_BR;
    if (r < TI_BR) { p0_transpose_item(in[I_WATT] + (size_t)l * SSMW * DM, SSMW, DM, (bf16*)(wl + WB_BR), DM, scr, r, lane); return; } r -= TI_BR;
    if (r < TI_BR) { p0_transpose_item(in[I_WCNV] + (size_t)l * SSMW * DM, SSMW, DM, (bf16*)(wl + WB_BR), 2 * DM, scr, r, lane); return; } r -= TI_BR;
    if (r < TI_O) { p0_transpose_item(in[I_WO] + (size_t)l * DM * DM, DM, DM, (bf16*)(wl + WB_O), 0, scr, r, lane); return; } r -= TI_O;
    if (r < TI_UP) { p0_transpose_item(in[I_WUP] + (size_t)l * DM * NUP, DM, NUP, (bf16*)(wl + WB_UP), 0, scr, r, lane); return; } r -= TI_UP;
    p0_transpose_item(in[I_WDOWN] + (size_t)l * DFF * DM, DFF, DM, (bf16*)(wl + WB_DN), 0, scr, r, lane);
}
__device__ __forceinline__ void p0_mod_item(const float* const* in, float* mod, const LAS float* condL, int item, int lane) {
    const int l = item / (NMOD / 64), j = (item % (NMOD / 64)) * 64 + lane;
    const float* wp = in[I_WMOD] + (size_t)l * DM * NMOD + j;
    float acc[8];
#pragma unroll
    for (int b = 0; b < 8; ++b) acc[b] = 0.f;
#pragma unroll 8
    for (int k = 0; k < DM; ++k) { const float w = wp[(size_t)k * NMOD]; const f32x4 c0 = *(const LAS f32x4*)(condL + k * 8), c1 = *(const LAS f32x4*)(condL + k * 8 + 4);
        acc[0] += w * c0[0]; acc[1] += w * c0[1]; acc[2] += w * c0[2]; acc[3] += w * c0[3]; acc[4] += w * c1[0]; acc[5] += w * c1[1]; acc[6] += w * c1[2]; acc[7] += w * c1[3]; }
    const float bm = in[I_BMOD][l * NMOD + j];
#pragma unroll
    for (int b = 0; b < 8; ++b) mod[(size_t)(l * BATCH + b) * NMOD + j] = acc[b] + bm;
}
constexpr int MOD_ITEMS = DEPTH * (NMOD / 64);
__device__ __forceinline__ void p0_prologue(const float* const* in, unsigned char* ws, LAS unsigned char* lds, int tid, int wave, int lane, int vcu, int G) {
    LAS float* condL = (LAS float*)lds;
    LAS float* scr = (LAS float*)(lds + 65536 + wave * 8448);
    for (int idx = tid; idx < BATCH * DM; idx += NWAVES * 64) { const int b = idx & 7, k = idx >> 3; const float cv = in[I_C][b * DM + k]; condL[idx] = cv / (1.0f + __expf(-cv)); }
    __syncthreads();
    const int gw2 = wave * G + vcu, NGW = G * NWAVES;
    const int nmodw = MOD_ITEMS < NGW ? MOD_ITEMS : NGW;
    constexpr int TPM = 25;
    if (gw2 < nmodw) {
        for (int q = gw2; q < MOD_ITEMS; q += nmodw) p0_mod_item(in, (float*)(ws + WS_MOD), condL, q, lane);
        for (int it = gw2 * TPM; it < (gw2 + 1) * TPM && it < TI_ALL; ++it) p0_transpose_any(in, ws, scr, it, lane);
    }
    const int rest0 = nmodw * TPM < TI_ALL ? nmodw * TPM : TI_ALL;
    if (NGW > nmodw) { if (gw2 >= nmodw) for (int it = rest0 + (gw2 - nmodw); it < TI_ALL; it += NGW - nmodw) p0_transpose_any(in, ws, scr, it, lane); }
    else { for (int it = rest0 + gw2; it < TI_ALL; it += NGW) p0_transpose_any(in, ws, scr, it, lane); }
}

template <bool POST, bool PRE>
__device__ __forceinline__ void norm_rows(const float* xi, float* xo, const bf16* y, const float* gpost, const float* gt, const float* gpre, const float* sc, const float* sh, bf16* h, int gw, int NGW, int lane) {
    constexpr int RPW = 8;
    for (int m0 = gw * RPW; m0 < M; m0 += NGW * RPW) {
        const int b = m0 / SEQ;
        for (int m = m0; m < m0 + RPW; ++m) {
            float xv[4][8];
#pragma unroll
            for (int j = 0; j < 4; ++j) { const int col = 8 * (lane + 64 * j); const f32x4 a = *(const GAS f32x4*)(xi + (size_t)m * DM + col), c = *(const GAS f32x4*)(xi + (size_t)m * DM + col + 4);
                xv[j][0] = a[0]; xv[j][1] = a[1]; xv[j][2] = a[2]; xv[j][3] = a[3]; xv[j][4] = c[0]; xv[j][5] = c[1]; xv[j][6] = c[2]; xv[j][7] = c[3]; }
            if (POST) {
                float yv[4][8]; float ss = 0.f;
#pragma unroll
                for (int j = 0; j < 4; ++j) { const int col = 8 * (lane + 64 * j); const v4u w = *(const GAS v4u*)(y + (size_t)m * DM + col); unpack8(w, yv[j]);
#pragma unroll
                    for (int e = 0; e < 8; ++e) ss += yv[j][e] * yv[j][e]; }
                const float rs = rsqrtf(wave_sum(ss) * (1.0f / DM) + RMS_EPS);
#pragma unroll
                for (int j = 0; j < 4; ++j) { const int col = 8 * (lane + 64 * j);
                    const f32x4 g0 = *(const GAS f32x4*)(gpost + col), g1 = *(const GAS f32x4*)(gpost + col + 4), t0 = *(const GAS f32x4*)(gt + (size_t)b * NMOD + col), t1 = *(const GAS f32x4*)(gt + (size_t)b * NMOD + col + 4);
#pragma unroll
                    for (int e = 0; e < 4; ++e) { xv[j][e] += t0[e] * (yv[j][e] * rs * g0[e]); xv[j][e + 4] += t1[e] * (yv[j][e + 4] * rs * g1[e]); }
                    *(GAS f32x4*)(xo + (size_t)m * DM + col) = (f32x4){xv[j][0], xv[j][1], xv[j][2], xv[j][3]}; *(GAS f32x4*)(xo + (size_t)m * DM + col + 4) = (f32x4){xv[j][4], xv[j][5], xv[j][6], xv[j][7]}; }
            }
            if (PRE) {
                float ss = 0.f;
#pragma unroll
                for (int j = 0; j < 4; ++j)
#pragma unroll
                    for (int e = 0; e < 8; ++e) ss += xv[j][e] * xv[j][e];
                const float rs = rsqrtf(wave_sum(ss) * (1.0f / DM) + RMS_EPS);
#pragma unroll
                for (int j = 0; j < 4; ++j) { const int col = 8 * (lane + 64 * j); float o[8];
                    const f32x4 g0 = *(const GAS f32x4*)(gpre + col), g1 = *(const GAS f32x4*)(gpre + col + 4), s0 = *(const GAS f32x4*)(sc + (size_t)b * NMOD + col), s1 = *(const GAS f32x4*)(sc + (size_t)b * NMOD + col + 4),
                                h0 = *(const GAS f32x4*)(sh + (size_t)b * NMOD + col), h1 = *(const GAS f32x4*)(sh + (size_t)b * NMOD + col + 4);
#pragma unroll
                    for (int e = 0; e < 4; ++e) { o[e] = xv[j][e] * rs * g0[e] * (1.0f + s0[e]) + h0[e]; o[e + 4] = xv[j][e + 4] * rs * g1[e] * (1.0f + s1[e]) + h1[e]; }
                    *(GAS v4u*)(h + (size_t)m * DM + col) = pack8f(o); }
            }
        }
    }
}
__device__ __forceinline__ void ffn_act_phase(const bf16* up, bf16* act, const float* cw  , int gw, int NGW, int lane) {
    constexpr int NCH = DFF / 512, NRUN = M / 64;
    for (int it = gw; it < NCH * NRUN; it += NGW) {
        const int run = it / NCH, ch = it % NCH, m0 = run * 64, col = ch * 512 + lane * 8;
        float wa[3][8], wb[3][8];
#pragma unroll
        for (int k = 0; k < 3; ++k) { const f32x4 a0 = *(const GAS f32x4*)(cw + k * NUP + col), a1 = *(const GAS f32x4*)(cw + k * NUP + col + 4), b0 = *(const GAS f32x4*)(cw + k * NUP + DFF + col), b1 = *(const GAS f32x4*)(cw + k * NUP + DFF + col + 4);
#pragma unroll
            for (int e = 0; e < 4; ++e) { wa[k][e] = a0[e]; wa[k][e + 4] = a1[e]; wb[k][e] = b0[e]; wb[k][e + 4] = b1[e]; } }
        float a1[8], a2[8], b1[8], b2[8];
        if ((m0 % SEQ) == 0) {
#pragma unroll
            for (int e = 0; e < 8; ++e) { a1[e] = 0.f; a2[e] = 0.f; b1[e] = 0.f; b2[e] = 0.f; }
        } else {
            unpack8(*(const GAS v4u*)(up + (size_t)(m0 - 1) * NUP + col), a1); unpack8(*(const GAS v4u*)(up + (size_t)(m0 - 2) * NUP + col), a2);
            unpack8(*(const GAS v4u*)(up + (size_t)(m0 - 1) * NUP + DFF + col), b1); unpack8(*(const GAS v4u*)(up + (size_t)(m0 - 2) * NUP + DFF + col), b2);
        }
#pragma unroll 4
        for (int t = 0; t < 64; ++t) {
            float a0[8], b0[8], o[8];
            unpack8(*(const GAS v4u*)(up + (size_t)(m0 + t) * NUP + col), a0); unpack8(*(const GAS v4u*)(up + (size_t)(m0 + t) * NUP + DFF + col), b0);
#pragma unroll
            for (int e = 0; e < 8; ++e) { const float ca = wa[0][e] * a0[e] + wa[1][e] * a1[e] + wa[2][e] * a2[e], cb = wb[0][e] * b0[e] + wb[1][e] * b1[e] + wb[2][e] * b2[e];
                o[e] = ca * __builtin_amdgcn_rcpf(1.0f + __expf(-ca)) * cb; a2[e] = a1[e]; a1[e] = a0[e]; b2[e] = b1[e]; b1[e] = b0[e]; }
            *(GAS v4u*)(act + (size_t)(m0 + t) * DFF + col) = pack8f(o);
        }
    }
}
__device__ __forceinline__ void conv_mix_items(const bf16* proj, bf16* outc, const float* cw  , int first, int step, int lane) {
    for (int run = first; run < M / 64; run += step) {
        const int m0 = run * 64, col = lane * 8;
        float w[3][8];
#pragma unroll
        for (int k = 0; k < 3; ++k) { const f32x4 a0 = *(const GAS f32x4*)(cw + k * 512 + col), a1 = *(const GAS f32x4*)(cw + k * 512 + col + 4);
#pragma unroll
            for (int e = 0; e < 4; ++e) { w[k][e] = a0[e]; w[k][e + 4] = a1[e]; } }
        float z1[8], z2[8];
        if ((m0 % SEQ) == 0) {
#pragma unroll
            for (int e = 0; e < 8; ++e) { z1[e] = 0.f; z2[e] = 0.f; }
        } else {
            float p[8], q[8];
            unpack8(*(const GAS v4u*)(proj + (size_t)(m0 - 1) * N_IN + OFF_CC + col), p); unpack8(*(const GAS v4u*)(proj + (size_t)(m0 - 1) * N_IN + OFF_CH + col), q);
#pragma unroll
            for (int e = 0; e < 8; ++e) z1[e] = p[e] * q[e];
            unpack8(*(const GAS v4u*)(proj + (size_t)(m0 - 2) * N_IN + OFF_CC + col), p); unpack8(*(const GAS v4u*)(proj + (size_t)(m0 - 2) * N_IN + OFF_CH + col), q);
#pragma unroll
            for (int e = 0; e < 8; ++e) z2[e] = p[e] * q[e];
        }
#pragma unroll 4
        for (int t = 0; t < 64; ++t) {
            float p[8], q[8], bb[8], o[8];
            const bf16* rp = proj + (size_t)(m0 + t) * N_IN;
            unpack8(*(const GAS v4u*)(rp + OFF_CC + col), p); unpack8(*(const GAS v4u*)(rp + OFF_CH + col), q); unpack8(*(const GAS v4u*)(rp + OFF_CB + col), bb);
#pragma unroll
            for (int e = 0; e < 8; ++e) { const float z0 = p[e] * q[e]; o[e] = bb[e] * (w[0][e] * z0 + w[1][e] * z1[e] + w[2][e] * z2[e]); z2[e] = z1[e]; z1[e] = z0; }
            *(GAS v4u*)(outc + (size_t)(m0 + t) * 512 + col) = pack8f(o);
        }
    }
}
constexpr int SSM_UF = 0, SSM_HS = 32768, SSM_E = 32768 + 8 * 4608, SSM_LDS_END = SSM_E + 4096;
constexpr int ATT_VLDS = 81920;
static_assert(SSM_LDS_END <= ATT_VLDS && ATT_VLDS + 8 * 4608 <= RING_BYTES, "mixer LDS map");
__device__ __forceinline__ float gelu_tanh(float y) { const float z = 0.7978845608028654f * (y + 0.044715f * y * y * y); const float e = __expf(2.0f * z); const float th = 1.0f - 2.0f * __builtin_amdgcn_rcpf(1.0f + e); return 0.5f * y * (1.0f + th); }
__device__ __forceinline__ void ssm_stage_u(const bf16* proj, LAS float* Uf, int b, int g, int T0, int lane) {
#pragma unroll
    for (int i = 0; i < 2; ++i) { const int piece = lane + 64 * i, tt = piece >> 1, half = piece & 1;
        const v4u w = *(const GAS v4u*)(proj + (size_t)(b * SEQ + T0 + tt) * N_IN + g * 16 + half * 8); float f[8]; unpack8(w, f);
        *(LAS f32x4*)(Uf + tt * 16 + half * 8) = (f32x4){f[0], f[1], f[2], f[3]}; *(LAS f32x4*)(Uf + tt * 16 + half * 8 + 4) = (f32x4){f[4], f[5], f[6], f[7]}; }
    LDS_WAIT();
}
__device__ __forceinline__ void ssm_unit(const float* const* in, int l, int b, int g, const bf16* proj, bf16* gbuf, LAS unsigned char* lds, int wave, int lane) {
    const int n = lane, lg = l * NGRP + g, gn = lg * NST + n;
    const float dt = expf(in[I_LOGDT][lg]);
    const float ar = in[I_ARE][gn], ai = in[I_AIM][gn];
    const float mag = expf(ar * dt), ang = ai * dt;
    const float kq2 = rintf(ang * 0.15915494309189535f); float red = fmaf(-kq2, 6.2831854820251465f, ang); red = fmaf(-kq2, -1.7484555e-7f, red);
    const float lr = mag * cosf(red), li = mag * sinf(red);
    const float den = ar * ar + ai * ai, fre = ((lr - 1.0f) * ar + li * ai) / den, fim = (li * ar - (lr - 1.0f) * ai) / den;
    float bbr[16], bbi[16];
    { const float* bre = in[I_BRE] + (size_t)gn * 16; const float* bim = in[I_BIM] + (size_t)gn * 16;
#pragma unroll
      for (int q = 0; q < 4; ++q) { const f32x4 r4 = *(const GAS f32x4*)(bre + 4 * q), i4 = *(const GAS f32x4*)(bim + 4 * q);
#pragma unroll
          for (int e = 0; e < 4; ++e) { bbr[4 * q + e] = fre * r4[e] - fim * i4[e]; bbi[4 * q + e] = fre * i4[e] + fim * r4[e]; } } }
    const int cc = lane & 15, kq = lane >> 4;
    bf16x8 Cf[4];
#pragma unroll
    for (int kb = 0; kb < 4; ++kb) { const float* src = (kb < 2 ? in[I_CRE] : in[I_CIM]) + (size_t)(lg * 16 + cc) * NST + (kb & 1) * 32 + 8 * kq; const float sg = kb < 2 ? 1.0f : -1.0f;
        const f32x4 a = *(const GAS f32x4*)src, c4 = *(const GAS f32x4*)(src + 4);
        const unsigned w0 = pk2(sg * a[0], sg * a[1]), w1 = pk2(sg * a[2], sg * a[3]), w2 = pk2(sg * c4[0], sg * c4[1]), w3 = pk2(sg * c4[2], sg * c4[3]);
        Cf[kb] = __builtin_bit_cast(bf16x8, (v4u){w0, w1, w2, w3}); }
    const float dsk = in[I_SSMD][l * SSMW + g * 16 + cc];
    LAS float* Uf = (LAS float*)(lds + SSM_UF + wave * 4096);
    LAS bf16* Hs = (LAS bf16*)(lds + SSM_HS + wave * 4608);
    LAS float* E = (LAS float*)(lds + SSM_E);
    float hr = 0.f, hi = 0.f;
    for (int s = 0; s < 4; ++s) {
        ssm_stage_u(proj, Uf, b, g, 256 * wave + 64 * s, lane);
        for (int tt = 0; tt < 64; ++tt) {
            const f32x4 u0 = *(const LAS f32x4*)(Uf + tt * 16), u1 = *(const LAS f32x4*)(Uf + tt * 16 + 4), u2 = *(const LAS f32x4*)(Uf + tt * 16 + 8), u3 = *(const LAS f32x4*)(Uf + tt * 16 + 12);
            float xr = 0.f, xi = 0.f;
#pragma unroll
            for (int e = 0; e < 4; ++e) { xr += bbr[e] * u0[e]; xi += bbi[e] * u0[e]; xr += bbr[4 + e] * u1[e]; xi += bbi[4 + e] * u1[e]; xr += bbr[8 + e] * u2[e]; xi += bbi[8 + e] * u2[e]; xr += bbr[12 + e] * u3[e]; xi += bbi[12 + e] * u3[e]; }
            const float nr = lr * hr - li * hi + xr, ni = lr * hi + li * hr + xi; hr = nr; hi = ni;
        }
        asm volatile("" ::: "memory");
    }
    E[(wave * 64 + n) * 2] = hr; E[(wave * 64 + n) * 2 + 1] = hi;
    float pr = lr, pi = li;
#pragma unroll
    for (int q = 0; q < 8; ++q) { const float t = pr * pr - pi * pi; pi = 2.0f * pr * pi; pr = t; }
    __syncthreads();
    hr = 0.f; hi = 0.f;
    for (int j = 0; j < wave; ++j) { const float er = E[(j * 64 + n) * 2], ei = E[(j * 64 + n) * 2 + 1]; const float nr = pr * hr - pi * hi + er, ni = pr * hi + pi * hr + ei; hr = nr; hi = ni; }
    for (int s = 0; s < 4; ++s) {
        const int T0 = 256 * wave + 64 * s;
        ssm_stage_u(proj, Uf, b, g, T0, lane);
        for (int bt = 0; bt < 4; ++bt) {
#pragma unroll 4
            for (int t16 = 0; t16 < 16; ++t16) { const int tt = bt * 16 + t16;
                const f32x4 u0 = *(const LAS f32x4*)(Uf + tt * 16), u1 = *(const LAS f32x4*)(Uf + tt * 16 + 4), u2 = *(const LAS f32x4*)(Uf + tt * 16 + 8), u3 = *(const LAS f32x4*)(Uf + tt * 16 + 12);
                float xr = 0.f, xi = 0.f;
#pragma unroll
                for (int e = 0; e < 4; ++e) { xr += bbr[e] * u0[e]; xi += bbi[e] * u0[e]; xr += bbr[4 + e] * u1[e]; xi += bbi[4 + e] * u1[e]; xr += bbr[8 + e] * u2[e]; xi += bbi[8 + e] * u2[e]; xr += bbr[12 + e] * u3[e]; xi += bbi[12 + e] * u3[e]; }
                const float nr = lr * hr - li * hi + xr, ni = lr * hi + li * hr + xi; hr = nr; hi = ni;
                Hs[t16 * 136 + n] = (bf16)f2bf(hr); Hs[t16 * 136 + 64 + n] = (bf16)f2bf(hi); }
            LDS_WAIT();
            f32x4 Y = (f32x4){0.f, 0.f, 0.f, 0.f};
#pragma unroll
            for (int kb = 0; kb < 4; ++kb) { const bf16x8 a = *(const LAS bf16x8*)(Hs + cc * 136 + kb * 32 + kq * 8); Y = __builtin_amdgcn_mfma_f32_16x16x32_bf16(a, Cf[kb], Y, 0, 0, 0); }
#pragma unroll
            for (int i = 0; i < 4; ++i) { const int tt = bt * 16 + 4 * kq + i; const float uval = Uf[tt * 16 + cc]; const float yv = gelu_tanh(Y[i] + dsk * uval);
                gbuf[(size_t)(b * SEQ + T0 + tt) * SSMW + g * 16 + cc] = (bf16)f2bf(yv); }
            LDS_WAIT(); asm volatile("" ::: "memory");
        }
    }
}

__device__ __forceinline__ s16x4 vtr(const LAS unsigned char* p) { return __builtin_bit_cast(s16x4, __builtin_amdgcn_ds_read_tr16_b64_v4i16((LAS s16x4*)p)); }
__device__ __forceinline__ void attn_tile(const bf16* proj, bf16* aout, LAS unsigned char* vlds, int b, int h, int r, int i0, int lane) {
    const int col = lane & 15, grp = lane >> 4;
    const size_t rowb = (size_t)b * SEQ;
    const int tq = r + 16 * (i0 + col);
    const bf16* qrow = proj + (rowb + tq) * N_IN + OFF_Q + h * 64 + grp * 8;
    bf16x8 Qf[3][2];
#pragma unroll
    for (int g = 0; g < 3; ++g)
#pragma unroll
        for (int dh = 0; dh < 2; ++dh) Qf[g][dh] = *(const GAS bf16x8*)(qrow + g * 512 + dh * 32);
    f32x4 acc[4];
#pragma unroll
    for (int d = 0; d < 4; ++d) acc[d] = (f32x4){0.f, 0.f, 0.f, 0.f};
    float mrun = -1e30f, lrun = 0.f;
    const float L2E = 1.4426950408889634f;
    const int tq4 = (lane & 15) >> 2, tp4 = lane & 3;
    const LAS unsigned char* vrd = vlds + (4 * grp + tq4) * 144 + tp4 * 8;
#pragma unroll
    for (int g = 0; g < 3; ++g) {
        const int sh = 2 * g, dil = 1 << sh, rg = r & (dil - 1);
        const int qp = (tq - rg) >> sh;
        const int kstart = (g == 0) ? (16 * i0 - 128) : (g == 1 ? 4 * i0 - 128 : i0 - 144), ntile = (g == 0) ? 12 : (g == 1 ? 6 : 5);
        const float c_qk = 0.125f * L2E, c_b = exp2f(-(float)(g * 8 + h + 1) * (1.0f / 3.0f)) * (float)dil * L2E;
        const bf16* kbase = proj + rowb * N_IN + OFF_K + g * 512 + h * 64 + grp * 8;
        const bf16* vbase = proj + rowb * N_IN + OFF_V + g * 512 + h * 64;
        for (int ti = 0; ti < ntile; ++ti) {
            const int kt0 = kstart + 32 * ti;
            if (kt0 + 32 <= 0) continue;
            f32x4 S[2];
#pragma unroll
            for (int half = 0; half < 2; ++half) { int kp = kt0 + 16 * half + col; kp = kp < 0 ? 0 : kp; const int tok = rg + (kp << sh);
                const bf16* kr = kbase + (size_t)tok * N_IN; const bf16x8 k0 = *(const GAS bf16x8*)kr, k1 = *(const GAS bf16x8*)(kr + 32);
                S[half] = __builtin_amdgcn_mfma_f32_16x16x32_bf16(k0, Qf[g][0], (f32x4){0.f, 0.f, 0.f, 0.f}, 0, 0, 0);
                S[half] = __builtin_amdgcn_mfma_f32_16x16x32_bf16(k1, Qf[g][1], S[half], 0, 0, 0); }
#pragma unroll
            for (int i = 0; i < 4; ++i) { const int chunk = lane + 64 * i, row = chunk >> 3, c16 = chunk & 7; int kp = kt0 + row; kp = kp < 0 ? 0 : kp; const int tok = rg + (kp << sh);
                const v4u v = *(const GAS v4u*)(vbase + (size_t)tok * N_IN + c16 * 8); *(LAS v4u*)(vlds + row * 144 + c16 * 16) = v; }
            float sc[8]; float mx = -1e30f;
#pragma unroll
            for (int half = 0; half < 2; ++half)
#pragma unroll
                for (int i = 0; i < 4; ++i) { const int kp = kt0 + 16 * half + 4 * grp + i, dist = qp - kp; const bool valid = (dist >= 0) && (dist <= 128) && (kp >= 0);
                    const float s = valid ? (S[half][i] * c_qk - c_b * (float)dist) : -1e30f; sc[half * 4 + i] = s; mx = fmaxf(mx, s); }
            mx = fmaxf(mx, __shfl_xor(mx, 16)); mx = fmaxf(mx, __shfl_xor(mx, 32));
            const float mnew = fmaxf(mrun, mx), alpha = __builtin_amdgcn_exp2f(mrun - mnew);
            float p[8], psum = 0.f;
#pragma unroll
            for (int j = 0; j < 8; ++j) { p[j] = (sc[j] > -1e29f) ? __builtin_amdgcn_exp2f(sc[j] - mnew) : 0.f; psum += p[j]; }
            psum += __shfl_xor(psum, 16); psum += __shfl_xor(psum, 32);
            lrun = lrun * alpha + psum; mrun = mnew;
#pragma unroll
            for (int d = 0; d < 4; ++d) acc[d] = acc[d] * alpha;
            const bf16x8 Pf = __builtin_bit_cast(bf16x8, (v4u){pk2(p[0], p[1]), pk2(p[2], p[3]), pk2(p[4], p[5]), pk2(p[6], p[7])});
            LDS_WAIT();
#pragma unroll
            for (int d = 0; d < 4; ++d) { const s16x4 lo = vtr(vrd + d * 32), hi = vtr(vrd + 16 * 144 + d * 32);
                const bf16x8 Vf = (bf16x8){lo[0], lo[1], lo[2], lo[3], hi[0], hi[1], hi[2], hi[3]};
                acc[d] = __builtin_amdgcn_mfma_f32_16x16x32_bf16(Vf, Pf, acc[d], 0, 0, 0); }
            LDS_WAIT(); asm volatile("" ::: "memory");
        }
    }
    const float inv = 1.0f / lrun;
    bf16* orow = aout + (rowb + tq) * SSMW + h * 64 + 4 * grp;
#pragma unroll
    for (int d = 0; d < 4; ++d) { v2u w; w.x = pk2(acc[d][0] * inv, acc[d][1] * inv); w.y = pk2(acc[d][2] * inv, acc[d][3] * inv); *(GAS v2u*)(orow + d * 16) = w; }
}
#ifndef MK_PER_PHASE
#define MK_PER_PHASE 0
#endif
__device__ __forceinline__ int launder(int v) { asm volatile("" : "+v"(v)); return v; }
#define PH_LOCALS const int tid = launder((int)threadIdx.x), lane = tid & 63, wave = __builtin_amdgcn_readfirstlane(tid >> 6), gw = vcu * NWAVES + wave; (void)tid; (void)lane; (void)wave; (void)gw;
constexpr int PH_PER_LAYER = 11, N_PHASES = 1 + DEPTH * PH_PER_LAYER;
struct Args { const float* in[N_INPUTS]; float* out; unsigned char* ws; int ph_lo, ph_hi; };
static_assert(sizeof(Args) == N_INPUTS * 8 + 8 + 8 + 8, "Args has no padding");
__global__ void __launch_bounds__(NWAVES * 64, 2) trunk_fwd(Args args) {
    extern __shared__ __attribute__((aligned(16))) unsigned char lds_raw[];
    LAS unsigned char* lds = (LAS unsigned char*)lds_raw;
    volatile LAS unsigned* MISC = (volatile LAS unsigned*)(lds + MISC_OFF);
    const int G = gridDim.x, bx = blockIdx.x, vcu = (G % 8 == 0) ? (bx % 8) * (G / 8) + bx / 8 : bx;
    const int NGW = G * NWAVES;
    unsigned char* ws = args.ws;
    const float* const* in = args.in;
    for (int u = threadIdx.x; u < (LDS_BYTES - MISC_OFF) / 4; u += NWAVES * 64) MISC[u] = 0u;
    __syncthreads();
    unsigned* barw = (unsigned*)(ws + WS_CTL) + CW_BAR;
    XcdBarrier bar; bar.bar = barw; bar.x = 0; bar.st = nullptr;
    if (!MK_PER_PHASE) bar = xcd_barrier_post(barw, MISC + 8);
    const int lo = args.ph_lo, hi = args.ph_hi;
#ifndef PH_MASK
#define PH_MASK 0xFFFF
#endif
#define EN(k) (((PH_MASK) >> (k)) & 1)
#define PH_IN(id) (lo <= (id) && (id) < hi)
#define PH_SEAM(id) do { if ((id) + 1 < hi) { if (!MK_PER_PHASE) xcd_barrier(bar); } } while (0)
    float* mod = (float*)(ws + WS_MOD);
    bf16* Hb = (bf16*)(ws + WS_H); bf16* PJ = (bf16*)(ws + WS_PROJ); bf16* UP = (bf16*)(ws + WS_PROJ); bf16* ACT = (bf16*)(ws + WS_ACT);
    bf16* GB = (bf16*)(ws + WS_G); bf16* A3 = (bf16*)(ws + WS_A3); bf16* MG = (bf16*)(ws + WS_MG); bf16* YB = (bf16*)(ws + WS_Y);
    float* xout = args.out;

    if (EN(0) && PH_IN(0)) { PH_LOCALS; p0_prologue(in, ws, lds, tid, wave, lane, vcu, G); PH_SEAM(0); }

    for (int l = 0; l < DEPTH; ++l) {
        const int pb = 1 + l * PH_PER_LAYER;
        const unsigned char* wl = ws + WS_W + (size_t)l * WB_LAYER;
        const float* modl = mod + (size_t)l * BATCH * NMOD;
        const float* xcur = (l == 0) ? in[I_X] : xout;
        if (l == 0 && PH_IN(pb + 0) && EN(1)) { PH_LOCALS;
            norm_rows<false, true>(in[I_X], nullptr, nullptr, nullptr, nullptr, in[I_GPRE_MIX] + l * DM, modl + DM, modl, Hb, gw, NGW, lane);
            PH_SEAM(pb + 0);
        }
        if (PH_IN(pb + 1) && EN(2)) { PH_LOCALS;
            pg8::Gemm g{Hb, (const bf16*)(wl + WB_IN), M, N_IN, DM}; pg8::StaticOrder S; S.init(M, N_IN, G, bx);
            pg8::EpiIn E{PJ, N_IN, in[I_BGATE] + (size_t)l * 3 * DM, OFF_GATE / 256};
            pg8::gemm_phase<pg8::EpiIn, pg8::StaticOrder, true, true>(lds, g, S, E);
            PH_SEAM(pb + 1);
        }
        if (PH_IN(pb + 2) && EN(3)) { PH_LOCALS;
            for (int uidx = vcu; uidx < BATCH * NGRP; uidx += G) { ssm_unit(in, l, uidx / NGRP, uidx % NGRP, PJ, GB, lds, wave, lane); __syncthreads(); }
            { LAS unsigned char* vl = lds + ATT_VLDS + wave * 4608; int k = 0;
              for (int T = gw; T < BATCH * 8 * 16 * 8; T += NGW, ++k) { const int it = ((T & 7) + 2 * k) & 7, r = (T >> 3) & 15, bh = T >> 7;
                  attn_tile(PJ, A3 + (size_t)M * SSMW, vl, bh >> 3, bh & 7, r, 16 * it, lane); } }
            conv_mix_items(PJ, A3 + (size_t)2 * M * SSMW, in[I_CONVW] + (size_t)l * 3 * SSMW, gw, NGW, lane);
            PH_SEAM(pb + 2);
        }
        if (PH_IN(pb + 3) && EN(4)) { PH_LOCALS;
            { pg8::Gemm g{GB, (const bf16*)(wl + WB_GLU), M, SSMW, SSMW}; pg8::StaticOrder S; S.init(M, SSMW, G, bx);
              pg8::EpiGlu E{GB, A3, SSMW, in[I_BGLU] + (size_t)l * SSMW};
              pg8::gemm_phase<pg8::EpiGlu, pg8::StaticOrder, true, true>(lds, g, S, E); }
            { pg8::Gemm g{A3, (const bf16*)(wl + WB_BR), M, DM, SSMW}; pg8::BrPairOrder S; S.init(M, DM, G, bx);
              pg8::EpiBr E{PJ + OFF_GATE, N_IN, MG, YB, DM};
              pg8::gemm_phase<pg8::EpiBr, pg8::BrPairOrder, true, true>(lds, g, S, E); }
            PH_SEAM(pb + 3);
        }
        if (PH_IN(pb + 4) && EN(5)) { PH_LOCALS;
            pg8::Gemm g{A3, (const bf16*)(wl + WB_BR), M, DM, SSMW}; pg8::StaticOrder S; S.init(M, DM, G, bx);
            pg8::EpiBr E{PJ + OFF_GATE, N_IN, MG, YB, DM};
            pg8::gemm_phase<pg8::EpiBr, pg8::StaticOrder, true, true>(lds, g, S, E);
            PH_SEAM(pb + 4);
        }
        if (PH_IN(pb + 5) && EN(6)) { PH_LOCALS;
            pg8::Gemm g{MG, (const bf16*)(wl + WB_O), M, DM, DM}; pg8::StaticOrder S; S.init(M, DM, G, bx);
            pg8::EpiStore E{YB, DM};
            pg8::gemm_phase<pg8::EpiStore, pg8::StaticOrder, true, true>(lds, g, S, E);
            PH_SEAM(pb + 5);
        }
        if (PH_IN(pb + 6) && EN(7)) { PH_LOCALS;
            norm_rows<true, true>(xcur, xout, YB, in[I_GPOST_MIX] + l * DM, modl + 2 * DM, in[I_GPRE_FFN] + l * DM, modl + 4 * DM, modl + 3 * DM, Hb, gw, NGW, lane);
            PH_SEAM(pb + 6);
        }
        if (PH_IN(pb + 7) && EN(8)) { PH_LOCALS;
            pg8::Gemm g{Hb, (const bf16*)(wl + WB_UP), M, NUP, DM}; pg8::StaticOrder S; S.init(M, NUP, G, bx);
            pg8::EpiStore E{UP, NUP};
            pg8::gemm_phase<pg8::EpiStore, pg8::StaticOrder, true, true>(lds, g, S, E);
            PH_SEAM(pb + 7);
        }
        if (PH_IN(pb + 8) && EN(9)) { PH_LOCALS; ffn_act_phase(UP, ACT, in[I_FCONVW] + (size_t)l * 3 * NUP, gw, NGW, lane); PH_SEAM(pb + 8); }
        if (PH_IN(pb + 9) && EN(10)) { PH_LOCALS;
            pg8::Gemm g{ACT, (const bf16*)(wl + WB_DN), M, DM, DFF}; pg8::StaticOrder S; S.init(M, DM, G, bx);
            pg8::EpiStore E{YB, DM};
            pg8::gemm_phase<pg8::EpiStore, pg8::StaticOrder, true, true>(lds, g, S, E);
            PH_SEAM(pb + 9);
        }
        if (PH_IN(pb + 10) && EN(11)) { PH_LOCALS;
            if (l + 1 < DEPTH) norm_rows<true, true>(xout, xout, YB, in[I_GPOST_FFN] + l * DM, modl + 5 * DM, in[I_GPRE_MIX] + (l + 1) * DM, modl + BATCH * NMOD + DM, modl + BATCH * NMOD, Hb, gw, NGW, lane);
            else norm_rows<true, false>(xout, xout, YB, in[I_GPOST_FFN] + l * DM, modl + 5 * DM, nullptr, nullptr, nullptr, nullptr, gw, NGW, lane);
            PH_SEAM(pb + 10);
        }
    }
#undef PH_IN
#undef PH_SEAM
}


#ifndef DBG_STOP
#define DBG_STOP -1
#endif
#ifndef DBG_BUF
#define DBG_BUF 0
#endif
__global__ void __launch_bounds__(256) dbg_dump(const bf16* src, int ld, int col0, int ncol, int outc0, float* out) {
    for (size_t i = (size_t)blockIdx.x * 256 + threadIdx.x; i < (size_t)M * ncol; i += (size_t)gridDim.x * 256) { const size_t m = i / ncol; const int c = (int)(i % ncol);
        out[m * DM + outc0 + c] = __uint_as_float(((unsigned)src[m * ld + col0 + c]) << 16); }
}
extern "C" void kernel_launch(void* const* d_in, const int* in_sizes, int n_in, void* d_out, int out_size, void* d_ws, size_t ws_size, hipStream_t stream) {
    static int grid = 0;
    if (grid == 0) {
        if (n_in != N_INPUTS || in_sizes[0] != M * DM || out_size != M * DM || ws_size < WS_END) { fprintf(stderr, "kernel_launch: unexpected shapes (n_in %d, in0 %d, out %d, ws %zu < %zu); nothing launched\n", n_in, n_in > 0 ? in_sizes[0] : -1, out_size, ws_size, (size_t)WS_END); grid = -1; return; }
        int dev = 0, cus = 0, per_cu = 0;
        if (hipGetDevice(&dev) != hipSuccess || hipDeviceGetAttribute(&cus, hipDeviceAttributeMultiprocessorCount, dev) != hipSuccess) { fprintf(stderr, "kernel_launch: device query failed\n"); grid = -1; return; }
        if (hipFuncSetAttribute((const void*)trunk_fwd, hipFuncAttributeMaxDynamicSharedMemorySize, LDS_BYTES) != hipSuccess) { fprintf(stderr, "kernel_launch: hipFuncSetAttribute failed\n"); grid = -1; return; }
        if (hipOccupancyMaxActiveBlocksPerMultiprocessor(&per_cu, (const void*)trunk_fwd, NWAVES * 64, LDS_BYTES) != hipSuccess || per_cu < 1) { fprintf(stderr, "kernel_launch: occupancy query reports %d blocks per CU\n", per_cu); }
        (void)hipGetLastError();
        grid = cus;
    }
    if (grid < 0) return;
    if (hipMemsetAsync((char*)d_ws + WS_CTL, 0, CTL_ZERO_BYTES, stream) != hipSuccess) { fprintf(stderr, "kernel_launch: memset failed\n"); return; }
    Args a{};
    for (int i = 0; i < N_INPUTS; ++i) a.in[i] = (const float*)d_in[i];
    a.out = (float*)d_out; a.ws = (unsigned char*)d_ws;
#if MK_PER_PHASE
    for (int p = 0; p < N_PHASES; ++p) {
        if (p > 0 && ((p - 1) % PH_PER_LAYER) == 0 && p != 1) continue;
        a.ph_lo = p; a.ph_hi = p + 1;
        hipLaunchKernelGGL(trunk_fwd, dim3(grid), dim3(NWAVES * 64), LDS_BYTES, stream, a);
        if (p == DBG_STOP) {
            unsigned char* w = (unsigned char*)d_ws; float* o = (float*)d_out;
            if (DBG_BUF == 0) hipLaunchKernelGGL(dbg_dump, dim3(2048), dim3(256), 0, stream, (const bf16*)(w + WS_H), DM, 0, DM, 0, o);
            if (DBG_BUF == 1) hipLaunchKernelGGL(dbg_dump, dim3(2048), dim3(256), 0, stream, (const bf16*)(w + WS_PROJ), N_IN, 0, DM, 0, o);
            if (DBG_BUF == 2) hipLaunchKernelGGL(dbg_dump, dim3(2048), dim3(256), 0, stream, (const bf16*)(w + WS_PROJ), N_IN, N_IN - DM, DM, 0, o);
            if (DBG_BUF == 3) { hipLaunchKernelGGL(dbg_dump, dim3(2048), dim3(256), 0, stream, (const bf16*)(w + WS_G), SSMW, 0, SSMW, 0, o);
                                hipLaunchKernelGGL(dbg_dump, dim3(2048), dim3(256), 0, stream, (const bf16*)(w + WS_A3), SSMW, 0, SSMW, 512, o);
                                hipLaunchKernelGGL(dbg_dump, dim3(2048), dim3(256), 0, stream, (const bf16*)(w + WS_A3) + (size_t)M * SSMW, SSMW, 0, SSMW, 1024, o);
                                hipLaunchKernelGGL(dbg_dump, dim3(2048), dim3(256), 0, stream, (const bf16*)(w + WS_A3) + (size_t)2 * M * SSMW, SSMW, 0, SSMW, 1536, o); }
            if (DBG_BUF == 4) hipLaunchKernelGGL(dbg_dump, dim3(2048), dim3(256), 0, stream, (const bf16*)(w + WS_MG), DM, 0, DM, 0, o);
            if (DBG_BUF == 5) hipLaunchKernelGGL(dbg_dump, dim3(2048), dim3(256), 0, stream, (const bf16*)(w + WS_Y), DM, 0, DM, 0, o);
            if (DBG_BUF == 6) hipLaunchKernelGGL(dbg_dump, dim3(2048), dim3(256), 0, stream, (const bf16*)(w + WS_ACT), DFF, 0, DM, 0, o);
            break;
        }
    }
#else
    a.ph_lo = 0; a.ph_hi = N_PHASES;
    hipLaunchKernelGGL(trunk_fwd, dim3(grid), dim3(NWAVES * 64), LDS_BYTES, stream, a);
#endif
    const hipError_t le = hipPeekAtLastError();
    if (le != hipSuccess) fprintf(stderr, "kernel_launch: launch failed: %s\n", hipGetErrorName(le));
}
```

```cpp
#include <hip/hip_runtime.h>
#include <cstdio>
#include <cstdint>
namespace pg8 {
#define PG8_LAS __attribute__((address_space(3)))
typedef unsigned short bf16_t;
typedef short bf16x8 __attribute__((ext_vector_type(8)));
typedef float f32x4 __attribute__((ext_vector_type(4)));
typedef unsigned u32x4 __attribute__((ext_vector_type(4)));
constexpr int BM = 256, BK = 64, HALF = 128, HTB = HALF * BK * 2  , STAGE_BYTES = 8 * HTB, NXCD = 8, WGM = 8;

__host__ __device__ __forceinline__ int lds_byte(int r, int c) { const int st = (r >> 4) * 2 + (c >> 5), rr = r & 15, cc = c & 31, ob = rr * 64 + cc * 2; return st * 1024 + (ob ^ (((ob >> 9) & 1) << 5)); }
__host__ __device__ __forceinline__ void stage_rc(int b, int& R, int& C) { const int st = b / 1024, sb = b % 1024, swz = sb ^ (((sb >> 9) & 1) << 5); R = (st >> 1) * 16 + swz / 64; C = (st & 1) * 32 + (swz % 64) / 2; }
__host__ __device__ __forceinline__ int perm32(int rho) { const int n = rho >> 4, i = rho & 15; return 8 * (i >> 2) + 4 * n + (i & 3); }

struct Unit { int pm, pn; };
struct Gemm { const bf16_t* A; const bf16_t* Bt; int M, N, K; };

struct StaticOrder {
    int nM, nN, nwg, G, c;
    __host__ __device__ void init(int M, int N, int G_, int c_) { nM = M / BM; nN = N / BM; nwg = nM * nN; G = G_; c = c_; }
    __host__ __device__ bool next(int i, Unit& u) const {
        const long L = (long)i * G + c; if (L >= nwg) return false;
        int wgid = (int)L; { const int q = nwg / NXCD, r = nwg % NXCD, xcd = wgid % NXCD, off = wgid / NXCD; wgid = (xcd < r ? xcd * (q + 1) : r * (q + 1) + (xcd - r) * q) + off; }
        const int nig = WGM * nN, gid = wgid / nig, fm = gid * WGM, gsz = (nM - fm) < WGM ? (nM - fm) : WGM;
        u.pm = fm + ((wgid % nig) % gsz); u.pn = (wgid % nig) / gsz; return true;
    }
    __device__ __forceinline__ void a_ready(const Unit&) const {}
    __device__ __forceinline__ void done(const Unit&) const {}
};

typedef float cvt_f32x2 __attribute__((ext_vector_type(2))); typedef __bf16 cvt_bf16x2 __attribute__((ext_vector_type(2)));
__device__ __forceinline__ unsigned cvt_pk_bf16(float lo, float hi) { cvt_f32x2 v = {lo, hi}; cvt_bf16x2 b = __builtin_convertvector(v, cvt_bf16x2); return __builtin_bit_cast(unsigned, b); }
__device__ __forceinline__ float sigm(float x) { return __builtin_amdgcn_rcpf(1.0f + __expf(-x)); }
__device__ __forceinline__ float bflo(unsigned w) { return __uint_as_float(w << 16); }
__device__ __forceinline__ float bfhi(unsigned w) { return __uint_as_float(w & 0xffff0000u); }
__device__ __forceinline__ u32x4 pack8(const f32x4& v0, const f32x4& v1) { u32x4 w; w.x = cvt_pk_bf16(v0[0], v0[1]); w.y = cvt_pk_bf16(v0[2], v0[3]); w.z = cvt_pk_bf16(v1[0], v1[1]); w.w = cvt_pk_bf16(v1[2], v1[3]); return w; }
struct EpiStore {
    static constexpr bool PERM = true, AFTER_DRAIN = false;
    bf16_t* O; int ldc;
    __device__ __forceinline__ void operator()(const f32x4 (&acc)[2][2][4][2], const Unit& u, int wr, int wc, int fr, int fq) const {
        const int row0 = u.pm * BM + wr * 64 + fr, col0 = u.pn * BM + wc * 32 + 8 * fq;
#pragma unroll
        for (int ai = 0; ai < 2; ++ai)
#pragma unroll
            for (int m = 0; m < 4; ++m) { bf16_t* rowp = O + (size_t)(row0 + ai * HALF + m * 16) * ldc + col0;
#pragma unroll
                for (int bj = 0; bj < 2; ++bj) *(u32x4*)(rowp + bj * HALF) = pack8(acc[ai][bj][m][0], acc[ai][bj][m][1]); }
    }
};
struct EpiIn {
    static constexpr bool PERM = true, AFTER_DRAIN = false;
    bf16_t* O; int ldc; const float* bgate; int gate_tile0;
    __device__ __forceinline__ void operator()(const f32x4 (&acc)[2][2][4][2], const Unit& u, int wr, int wc, int fr, int fq) const {
        const int row0 = u.pm * BM + wr * 64 + fr, col0 = u.pn * BM + wc * 32 + 8 * fq;
        if (u.pn >= gate_tile0) {
            const float* bp = bgate + (col0 - gate_tile0 * BM);
            f32x4 bv[2][2];
#pragma unroll
            for (int bj = 0; bj < 2; ++bj)
#pragma unroll
                for (int n = 0; n < 2; ++n) bv[bj][n] = *(const f32x4*)(bp + bj * HALF + 4 * n);
#pragma unroll
            for (int ai = 0; ai < 2; ++ai)
#pragma unroll
                for (int m = 0; m < 4; ++m) { bf16_t* rowp = O + (size_t)(row0 + ai * HALF + m * 16) * ldc + col0;
#pragma unroll
                    for (int bj = 0; bj < 2; ++bj) { f32x4 v0 = acc[ai][bj][m][0] + bv[bj][0], v1 = acc[ai][bj][m][1] + bv[bj][1];
#pragma unroll
                        for (int j = 0; j < 4; ++j) { v0[j] = sigm(v0[j]); v1[j] = sigm(v1[j]); }
                        *(u32x4*)(rowp + bj * HALF) = pack8(v0, v1); } }
        } else {
#pragma unroll
            for (int ai = 0; ai < 2; ++ai)
#pragma unroll
                for (int m = 0; m < 4; ++m) { bf16_t* rowp = O + (size_t)(row0 + ai * HALF + m * 16) * ldc + col0;
#pragma unroll
                    for (int bj = 0; bj < 2; ++bj) *(u32x4*)(rowp + bj * HALF) = pack8(acc[ai][bj][m][0], acc[ai][bj][m][1]); }
        }
    }
};
struct EpiGlu {
    static constexpr bool PERM = true, AFTER_DRAIN = false;
    const bf16_t* G; bf16_t* O; int ldc; const float* bias;
    __device__ __forceinline__ void operator()(const f32x4 (&acc)[2][2][4][2], const Unit& u, int wr, int wc, int fr, int fq) const {
        const int row0 = u.pm * BM + wr * 64 + fr, col0 = u.pn * BM + wc * 32 + 8 * fq;
        f32x4 bv[2][2];
#pragma unroll
        for (int bj = 0; bj < 2; ++bj)
#pragma unroll
            for (int n = 0; n < 2; ++n) bv[bj][n] = *(const f32x4*)(bias + col0 + bj * HALF + 4 * n);
#pragma unroll
        for (int ai = 0; ai < 2; ++ai) {
            u32x4 gw[4][2];
#pragma unroll
            for (int m = 0; m < 4; ++m)
#pragma unroll
                for (int bj = 0; bj < 2; ++bj) gw[m][bj] = *(const u32x4*)(G + (size_t)(row0 + ai * HALF + m * 16) * ldc + col0 + bj * HALF);
#pragma unroll
            for (int m = 0; m < 4; ++m) { const size_t off = (size_t)(row0 + ai * HALF + m * 16) * ldc + col0;
#pragma unroll
                for (int bj = 0; bj < 2; ++bj) { const u32x4 g4 = gw[m][bj];
                    f32x4 v0 = acc[ai][bj][m][0] + bv[bj][0], v1 = acc[ai][bj][m][1] + bv[bj][1];
                    v0[0] = bflo(g4.x) * sigm(v0[0]); v0[1] = bfhi(g4.x) * sigm(v0[1]); v0[2] = bflo(g4.y) * sigm(v0[2]); v0[3] = bfhi(g4.y) * sigm(v0[3]);
                    v1[0] = bflo(g4.z) * sigm(v1[0]); v1[1] = bfhi(g4.z) * sigm(v1[1]); v1[2] = bflo(g4.w) * sigm(v1[2]); v1[3] = bfhi(g4.w) * sigm(v1[3]);
                    *(u32x4*)(O + off + bj * HALF) = pack8(v0, v1); } }
        }
    }
};
struct EpiBr {
    static constexpr bool PERM = true, AFTER_DRAIN = false;
    const bf16_t* gates; int ldg; bf16_t* Mg; bf16_t* Mg2; int ldm;
    __device__ __forceinline__ void operator()(const f32x4 (&acc)[2][2][4][2], const Unit& u, int wr, int wc, int fr, int fq) const {
        const int br = u.pm >> 6, pm = u.pm & 63, pn = u.pn & 7;
        const int row0 = pm * BM + wr * 64 + fr, col0 = pn * BM + wc * 32 + 8 * fq;
        bf16_t* dst = (br == 2) ? Mg2 : Mg;
#pragma unroll
        for (int ai = 0; ai < 2; ++ai)
#pragma unroll
            for (int mp = 0; mp < 2; ++mp) {
                u32x4 gw[2][2], ow[2][2], pw[2][2];
#pragma unroll
                for (int mm = 0; mm < 2; ++mm)
#pragma unroll
                    for (int bj = 0; bj < 2; ++bj) { const int row = row0 + ai * HALF + (2 * mp + mm) * 16;
                        gw[mm][bj] = *(const u32x4*)(gates + (size_t)row * ldg + br * ldm + col0 + bj * HALF);
                        if (br == 0) { ow[mm][bj] = *(const u32x4*)(Mg + (size_t)row * ldm + col0 + bj * HALF); pw[mm][bj] = *(const u32x4*)(Mg2 + (size_t)row * ldm + col0 + bj * HALF); } }
#pragma unroll
                for (int mm = 0; mm < 2; ++mm)
#pragma unroll
                    for (int bj = 0; bj < 2; ++bj) { const int m = 2 * mp + mm; const int row = row0 + ai * HALF + m * 16; const u32x4 g4 = gw[mm][bj];
                        f32x4 v0 = acc[ai][bj][m][0], v1 = acc[ai][bj][m][1];
                        v0[0] *= bflo(g4.x); v0[1] *= bfhi(g4.x); v0[2] *= bflo(g4.y); v0[3] *= bfhi(g4.y); v1[0] *= bflo(g4.z); v1[1] *= bfhi(g4.z); v1[2] *= bflo(g4.w); v1[3] *= bfhi(g4.w);
                        if (br == 0) { const u32x4 o4 = ow[mm][bj], p4 = pw[mm][bj];
                            v0[0] += bflo(o4.x) + bflo(p4.x); v0[1] += bfhi(o4.x) + bfhi(p4.x); v0[2] += bflo(o4.y) + bflo(p4.y); v0[3] += bfhi(o4.y) + bfhi(p4.y);
                            v1[0] += bflo(o4.z) + bflo(p4.z); v1[1] += bfhi(o4.z) + bfhi(p4.z); v1[2] += bflo(o4.w) + bflo(p4.w); v1[3] += bfhi(o4.w) + bfhi(p4.w); }
                        *(u32x4*)(dst + (size_t)row * ldm + col0 + bj * HALF) = pack8(v0, v1); }
            }
    }
};
struct BrPairOrder {
    StaticOrder so;
    __host__ __device__ void init(int M, int N, int G_, int c_) { so.init(M, N, G_, c_); }
    __host__ __device__ bool next(int i, Unit& u) const { Unit t; if (!so.next(i >> 1, t)) return false; const int br = 1 + (i & 1); u.pm = t.pm + 64 * br; u.pn = t.pn + 8 * br; return true; }
    __device__ __forceinline__ void a_ready(const Unit&) const {}
    __device__ __forceinline__ void done(const Unit&) const {}
};
template <class Epi, class Sched, bool ALIGN_EPI = false, bool SP2 = false>
__device__ __forceinline__ void gemm_phase(PG8_LAS unsigned char* lds, const Gemm g, const Sched& S, const Epi& E) {
    int tid = threadIdx.x; asm volatile("" : "+v"(tid)); const int wid = __builtin_amdgcn_readfirstlane(tid >> 6), lane = tid & 63, wr = wid >> 2, wc = wid & 3, fr = lane & 15, fq = lane >> 4;
    const int K = g.K, nt = K / BK;
    unsigned voffA[2], voffB[2];
#pragma unroll
    for (int i = 0; i < 2; ++i) { int R, C; stage_rc(tid * 16 + i * 8192, R, C); const int Rb = Epi::PERM ? ((R & ~31) + perm32(R & 31)) : R;
        voffA[i] = (unsigned)(R * K + C) * 2u; voffB[i] = (unsigned)(Rb * K + C) * 2u; }
    const size_t kstep = (size_t)(BK * 2);
    const size_t hstep = (size_t)HALF * K * 2;
    const size_t tstep = 2 * hstep;
    const unsigned ldsw = (unsigned)wid * 1024u;
    const int aoff = lds_byte(wr * 64 + fr, fq * 8), boff = lds_byte(wc * 32 + fr, fq * 8);
#define PG8_SA(b, h) (((b) * 2 + (h)) * HTB)
#define PG8_SB(b, h) ((4 + (b) * 2 + (h)) * HTB)
#define PG8_STAGE(bufoff, gbase, voff) do { _Pragma("unroll") for (int _i = 0; _i < 2; ++_i) \
        __builtin_amdgcn_global_load_lds((const unsigned*)((const char*)(gbase) + (voff)[_i]), (PG8_LAS unsigned*)(lds + (bufoff) + ldsw + _i * 8192), 16, 0, 0); } while (0)
#define PG8_LDA(dst, b, h) do { _Pragma("unroll") for (int m = 0; m < 4; ++m) _Pragma("unroll") for (int k = 0; k < 2; ++k) dst[m][k] = *(const PG8_LAS bf16x8*)(lds + PG8_SA(b, h) + aoff + m * 2048 + k * 1024); } while (0)
#define PG8_LDB(dst, b, h) do { _Pragma("unroll") for (int n = 0; n < 2; ++n) _Pragma("unroll") for (int k = 0; k < 2; ++k) dst[n][k] = *(const PG8_LAS bf16x8*)(lds + PG8_SB(b, h) + boff + n * 2048 + k * 1024); } while (0)
#define PG8_MMA(ai, bj, At, Bt) do { __builtin_amdgcn_s_setprio(1); _Pragma("unroll") for (int m = 0; m < 4; ++m) _Pragma("unroll") for (int n = 0; n < 2; ++n) _Pragma("unroll") for (int k = 0; k < 2; ++k) \
        acc[ai][bj][m][n] = __builtin_amdgcn_mfma_f32_16x16x32_bf16(Bt[n][k], At[m][k], acc[ai][bj][m][n], 0, 0, 0); __builtin_amdgcn_s_setprio(0); } while (0)
#define PG8_WAIT_V(n) asm volatile("s_waitcnt vmcnt(" #n ")" ::: "memory")
#define PG8_WAIT_L(n) asm volatile("s_waitcnt lgkmcnt(" #n ")" ::: "memory")
#define PG8_BAR __builtin_amdgcn_s_barrier()
#define PG8_SCHED __builtin_amdgcn_sched_barrier(0)
    Unit cur, nxt; int ui = 0;
    if (!S.next(0, cur)) return;
    f32x4 acc[2][2][4][2];
#pragma unroll
    for (int a = 0; a < 2; ++a)
#pragma unroll
        for (int b = 0; b < 2; ++b)
#pragma unroll
            for (int m = 0; m < 4; ++m)
#pragma unroll
                for (int n = 0; n < 2; ++n) acc[a][b][m][n] = (f32x4){0.f, 0.f, 0.f, 0.f};
    bf16x8 At[4][2], B0[2][2], B1[2][2];
    const char* cA = (const char*)g.A + (size_t)cur.pm * tstep; const char* cB = (const char*)g.Bt + (size_t)cur.pn * tstep;
    S.a_ready(cur);
    if constexpr (SP2) {
        PG8_STAGE(PG8_SB(0, 0), cB, voffB); PG8_STAGE(PG8_SB(0, 1), cB + hstep, voffB); PG8_STAGE(PG8_SA(0, 0), cA, voffA); PG8_STAGE(PG8_SA(0, 1), cA + hstep, voffA);
        if (wr == 1) PG8_BAR;
        PG8_WAIT_V(2); PG8_BAR;
        PG8_STAGE(PG8_SB(1, 0), cB + kstep, voffB); PG8_STAGE(PG8_SA(1, 0), cA + kstep, voffA); PG8_STAGE(PG8_SB(1, 1), cB + hstep + kstep, voffB);
        PG8_WAIT_V(6); PG8_BAR;
    } else {
        PG8_STAGE(PG8_SB(0, 0), cB, voffB); PG8_STAGE(PG8_SA(0, 0), cA, voffA); PG8_STAGE(PG8_SB(0, 1), cB + hstep, voffB); PG8_STAGE(PG8_SA(0, 1), cA + hstep, voffA);
        if (wr == 1) PG8_BAR;
        PG8_WAIT_V(4); PG8_BAR;
        PG8_STAGE(PG8_SB(1, 0), cB + kstep, voffB); PG8_STAGE(PG8_SA(1, 0), cA + kstep, voffA); PG8_STAGE(PG8_SB(1, 1), cB + hstep + kstep, voffB);
        PG8_WAIT_V(6); PG8_BAR;
    }
    for (;;) {
        const bool has_next = S.next(ui + 1, nxt);
        const char* nA = has_next ? (const char*)g.A + (size_t)nxt.pm * tstep : cA; const char* nB = has_next ? (const char*)g.Bt + (size_t)nxt.pn * tstep : cB;
        for (int t = 0; t < nt; t += 2) {
            const bool last = (t == nt - 2);
            const char* a1 = cA + (size_t)(t + 1) * kstep;
            const char* a2 = last ? nA : cA + (size_t)(t + 2) * kstep; const char* b2 = last ? nB : cB + (size_t)(t + 2) * kstep;
            const char* a3 = a2 + kstep; const char* b3 = b2 + kstep;
            if (last && has_next) S.a_ready(nxt);
            if constexpr (SP2) {
            PG8_LDB(B0, 0, 0); PG8_LDB(B1, 0, 1); PG8_SCHED; PG8_LDA(At, 0, 0); PG8_STAGE(PG8_SA(1, 1), a1 + hstep, voffA);
            PG8_WAIT_V(8); PG8_WAIT_L(0); PG8_BAR; PG8_MMA(0, 0, At, B0); PG8_MMA(0, 1, At, B1); PG8_BAR; PG8_SCHED;
            PG8_LDA(At, 0, 1); PG8_STAGE(PG8_SB(0, 0), b2, voffB); PG8_STAGE(PG8_SB(0, 1), b2 + hstep, voffB); PG8_STAGE(PG8_SA(0, 0), a2, voffA);
            PG8_WAIT_V(8); PG8_WAIT_L(0); PG8_BAR; PG8_MMA(1, 0, At, B0); PG8_MMA(1, 1, At, B1); PG8_BAR; PG8_SCHED;
            PG8_LDB(B0, 1, 0); PG8_LDB(B1, 1, 1); PG8_SCHED; PG8_LDA(At, 1, 0); PG8_STAGE(PG8_SA(0, 1), a2 + hstep, voffA);
            PG8_WAIT_V(8); PG8_WAIT_L(0); PG8_BAR; PG8_MMA(0, 0, At, B0); PG8_MMA(0, 1, At, B1); PG8_BAR; PG8_SCHED;
            PG8_LDA(At, 1, 1); PG8_STAGE(PG8_SB(1, 0), b3, voffB); PG8_STAGE(PG8_SB(1, 1), b3 + hstep, voffB); PG8_STAGE(PG8_SA(1, 0), a3, voffA);
            PG8_WAIT_V(8); PG8_WAIT_L(0); PG8_BAR; PG8_MMA(1, 0, At, B0); PG8_MMA(1, 1, At, B1); PG8_BAR; PG8_SCHED;
            } else {
            PG8_LDB(B0, 0, 0); PG8_SCHED; PG8_LDA(At, 0, 0); PG8_STAGE(PG8_SA(1, 1), a1 + hstep, voffA);
            PG8_WAIT_L(8); PG8_BAR; PG8_WAIT_L(0); PG8_MMA(0, 0, At, B0); PG8_BAR; PG8_SCHED;
            PG8_LDB(B1, 0, 1); PG8_STAGE(PG8_SB(0, 0), b2, voffB);
            PG8_BAR; PG8_WAIT_L(0); PG8_MMA(0, 1, At, B1); PG8_BAR;
            PG8_LDA(At, 0, 1); PG8_STAGE(PG8_SA(0, 0), a2, voffA);
            PG8_BAR; PG8_WAIT_L(0); PG8_MMA(1, 0, At, B0); PG8_BAR; PG8_SCHED;
            PG8_STAGE(PG8_SB(0, 1), b2 + hstep, voffB);
            PG8_WAIT_V(6); PG8_BAR; PG8_MMA(1, 1, At, B1); PG8_BAR;
            PG8_LDB(B0, 1, 0); PG8_SCHED; PG8_LDA(At, 1, 0); PG8_STAGE(PG8_SA(0, 1), a2 + hstep, voffA);
            PG8_WAIT_L(8); PG8_BAR; PG8_WAIT_L(0); PG8_MMA(0, 0, At, B0); PG8_BAR; PG8_SCHED;
            PG8_LDB(B1, 1, 1); PG8_STAGE(PG8_SB(1, 0), b3, voffB);
            PG8_BAR; PG8_WAIT_L(0); PG8_MMA(0, 1, At, B1); PG8_BAR;
            PG8_LDA(At, 1, 1); PG8_STAGE(PG8_SA(1, 0), a3, voffA);
            PG8_BAR; PG8_WAIT_L(0); PG8_MMA(1, 0, At, B0); PG8_BAR; PG8_SCHED;
            PG8_STAGE(PG8_SB(1, 1), b3 + hstep, voffB);
            PG8_WAIT_V(6); PG8_BAR; PG8_MMA(1, 1, At, B1); PG8_BAR;
            }
        }
        if constexpr (ALIGN_EPI) { if (wr == 0) PG8_BAR; }
        if constexpr (!Epi::AFTER_DRAIN) { E(acc, cur, wr, wc, fr, fq); S.done(cur); }
        if (!has_next) break;
#pragma unroll
        for (int a = 0; a < 2; ++a)
#pragma unroll
            for (int b = 0; b < 2; ++b)
#pragma unroll
                for (int m = 0; m < 4; ++m)
#pragma unroll
                    for (int n = 0; n < 2; ++n) acc[a][b][m][n] = (f32x4){0.f, 0.f, 0.f, 0.f};
        cur = nxt; cA = nA; cB = nB; ++ui;
        if constexpr (ALIGN_EPI) { if (wr == 1) PG8_BAR; }
    }
    PG8_WAIT_V(0);
    if constexpr (!ALIGN_EPI) { if (wr == 0) PG8_BAR; }
    PG8_BAR;
    if constexpr (Epi::AFTER_DRAIN) { E.fused(acc, cur, wr, wc, fr, fq, lds, wid, lane); S.done(cur); }
#undef PG8_SA
#undef PG8_SB
#undef PG8_STAGE
#undef PG8_LDA
#undef PG8_LDB
#undef PG8_MMA
#undef PG8_WAIT_V
#undef PG8_WAIT_L
#undef PG8_BAR
#undef PG8_SCHED
}
}
constexpr int NWAVES = 8;
constexpr int DM = 2048, BATCH = 8, SEQ = 2048, DEPTH = 4, M = BATCH * SEQ;
constexpr int SSMW = 512, NGRP = 32, NST = 64, HD = 64;
constexpr int OFF_Q = 512, OFF_K = 2048, OFF_V = 3584, OFF_CB = 5120, OFF_CC = 5632, OFF_CH = 6144, OFF_GATE = 6656, N_IN = 12800;
constexpr int DFF = 5632, NUP = 2 * DFF;
constexpr int NMOD = 6 * DM;
constexpr float RMS_EPS = 1e-6f;
enum { I_X = 0, I_C, I_WMOD, I_BMOD, I_GPRE_MIX, I_GPOST_MIX, I_GPRE_FFN, I_GPOST_FFN, I_WIN, I_LOGDT, I_ARE, I_AIM, I_BRE, I_BIM, I_CRE, I_CIM, I_SSMD, I_WGLU, I_BGLU,
       I_CONVW, I_WSSM, I_WATT, I_WCNV, I_BGATE, I_WO, I_WUP, I_FCONVW, I_WDOWN, N_INPUTS };
constexpr size_t MiB = 1u << 20;
constexpr size_t WS_CTL = 0, CTL_ZERO_BYTES = 1 * MiB;
constexpr size_t WS_MOD = 1 * MiB;
constexpr size_t WS_W = 4 * MiB;
constexpr size_t WB_IN = 0, WB_GLU = WB_IN + (size_t)N_IN * DM * 2, WB_BR = WB_GLU + (size_t)SSMW * SSMW * 2, WB_O = WB_BR + (size_t)3 * DM * SSMW * 2,
                 WB_UP = WB_O + (size_t)DM * DM * 2, WB_DN = WB_UP + (size_t)NUP * DM * 2, WB_LAYER = WB_DN + (size_t)DM * DFF * 2;
static_assert(WB_LAYER == (size_t)(50 * MiB + MiB / 2 + 6 * MiB + 8 * MiB + 44 * MiB + 22 * MiB), "weights per layer");
constexpr size_t WS_H = 528 * MiB;
constexpr size_t WS_PROJ = 592 * MiB;
constexpr size_t WS_ACT = 992 * MiB;
constexpr size_t WS_G = 1168 * MiB;
constexpr size_t WS_A3 = 1184 * MiB;
constexpr size_t WS_MG = 1232 * MiB;
constexpr size_t WS_Y = 1296 * MiB;
constexpr size_t WS_END = 1360 * MiB;
static_assert(WS_W + DEPTH * WB_LAYER <= WS_H && WS_PROJ + (size_t)M * N_IN * 2 <= WS_ACT && WS_ACT + (size_t)M * DFF * 2 <= WS_G, "ws map");
constexpr int CW_BAR = 4096;
constexpr int RING_BYTES = 131072, MISC_OFF = 143360, LDS_BYTES = 147456;

#define GAS __attribute__((address_space(1)))
#define LAS __attribute__((address_space(3)))
typedef unsigned short bf16;
typedef unsigned v4u __attribute__((ext_vector_type(4)));
typedef unsigned v2u __attribute__((ext_vector_type(2)));
typedef float f32x4 __attribute__((ext_vector_type(4)));
typedef short bf16x8 __attribute__((ext_vector_type(8)));
typedef short s16x4 __attribute__((ext_vector_type(4)));
#define LDS_WAIT() asm volatile("s_waitcnt lgkmcnt(0)" ::: "memory")
#define VM_WAIT() asm volatile("s_waitcnt vmcnt(0)" ::: "memory")
__device__ __forceinline__ unsigned f2bf(float f) { unsigned u = __builtin_bit_cast(unsigned, f); return (u + 0x7fffu + ((u >> 16) & 1u)) >> 16; }
__device__ __forceinline__ unsigned pk2(float lo, float hi) { return pg8::cvt_pk_bf16(lo, hi); }
__device__ __forceinline__ float bflo(unsigned w) { return __uint_as_float(w << 16); }
__device__ __forceinline__ float bfhi(unsigned w) { return __uint_as_float(w & 0xffff0000u); }
__device__ __forceinline__ void unpack8(const v4u w, float (&f)[8]) { f[0] = bflo(w.x); f[1] = bfhi(w.x); f[2] = bflo(w.y); f[3] = bfhi(w.y); f[4] = bflo(w.z); f[5] = bfhi(w.z); f[6] = bflo(w.w); f[7] = bfhi(w.w); }
__device__ __forceinline__ v4u pack8f(const float (&f)[8]) { v4u w; w.x = pk2(f[0], f[1]); w.y = pk2(f[2], f[3]); w.z = pk2(f[4], f[5]); w.w = pk2(f[6], f[7]); return w; }
__device__ __forceinline__ float wave_sum(float v) {
#pragma unroll
    for (int o = 1; o < 64; o <<= 1) v += __shfl_xor(v, o);
    return v;
}
#define XB_TMO      128
#define XB_XCNT(j)  (256  + 64 * (j))
#define XB_XSUB(j)  (1280 + 64 * (j))
#define XB_XGEN(j)  (2304 + 64 * (j))
#define XB_TOP      3328
#define XB_TOPGEN   3392
#define XCD_BAR_WORDS 3456
#define XB_SPIN_CAP (1u << 18)

__device__ __forceinline__ unsigned xb_ld(unsigned* p)              { return __hip_atomic_load(p, __ATOMIC_RELAXED, __HIP_MEMORY_SCOPE_AGENT); }
__device__ __forceinline__ unsigned xb_add(unsigned* p, unsigned v) { return __hip_atomic_fetch_add(p, v, __ATOMIC_RELAXED, __HIP_MEMORY_SCOPE_AGENT); }
__device__ __forceinline__ unsigned xb_xcc_id() { return (unsigned)__builtin_amdgcn_s_getreg((3 << 11) | 20) & 0xFu; }
#define XB_SPIN(cond, bar) do { unsigned _sp = 0; while (cond) { __builtin_amdgcn_s_sleep(1); \
    if ((++_sp & 255u) == 0u) { if (xb_ld(&(bar)[XB_TMO])) break; if (_sp > XB_SPIN_CAP) { atomicAdd(&(bar)[XB_TMO], 1u); break; } } } } while (0)

struct XcdBarrier {
    unsigned* bar; unsigned x;
    volatile LAS unsigned* st;
};

__device__ __forceinline__ XcdBarrier xcd_barrier_post(unsigned* bar, volatile LAS unsigned* st) {
    XcdBarrier b; b.bar = bar; b.x = xb_xcc_id(); b.st = st;
    if (threadIdx.x == 0) (void)xb_add(&bar[XB_XCNT(b.x)], 1u);
    return b;
}
__device__ __forceinline__ void xcd_barrier_complete(unsigned* bar, unsigned x, unsigned& nloc, unsigned& nx) {
    const unsigned G = gridDim.x * gridDim.y * gridDim.z;
    unsigned sum, cnt, mine, sp = 0u;
    for (;;) {
        sum = 0u; cnt = 0u; mine = 0u;
#pragma unroll
        for (unsigned j = 0; j < 16; ++j) { const unsigned c = xb_ld(&bar[XB_XCNT(j)]); sum += c; cnt += (c > 0u) ? 1u : 0u; mine = (j == x) ? c : mine; }
        if (sum == G) break;
        __builtin_amdgcn_s_sleep(1);
        if ((++sp & 255u) == 0u) { if (xb_ld(&bar[XB_TMO])) break; if (sp > XB_SPIN_CAP) { atomicAdd(&bar[XB_TMO], 1u); break; } }
    }
    nloc = mine > 0u ? mine : 1u; nx = cnt > 0u ? cnt : 1u;
}

__device__ __forceinline__ void xcd_barrier(const XcdBarrier& b) {
    asm volatile("s_waitcnt vmcnt(0)" ::: "memory");
    __syncthreads();
    if (threadIdx.x == 0) {
        unsigned* bar = b.bar;
        __builtin_amdgcn_s_waitcnt(0);
        unsigned nloc = b.st[0], nx = b.st[1];
        if (nloc == 0u) { xcd_barrier_complete(bar, b.x, nloc, nx); b.st[0] = nloc; b.st[1] = nx; }
        const unsigned old = xb_add(&bar[XB_XSUB(b.x)], 1u);
        const unsigned gen = old / nloc;
        if (old + 1u == (gen + 1u) * nloc) {
            __builtin_amdgcn_fence(__ATOMIC_RELEASE, "agent");
            asm volatile("s_waitcnt vmcnt(0)" ::: "memory");
            const unsigned og = xb_add(&bar[XB_TOP], 1u);
            const unsigned tg = og / nx;
            if (og + 1u == (tg + 1u) * nx) xb_add(&bar[XB_TOPGEN], 1u);
            else XB_SPIN(xb_ld(&bar[XB_TOPGEN]) == tg, bar);
            __builtin_amdgcn_fence(__ATOMIC_ACQUIRE, "agent");
            xb_add(&bar[XB_XGEN(b.x)], 1u);
            asm volatile("s_waitcnt vmcnt(0)" ::: "memory");
        } else {
            XB_SPIN(xb_ld(&bar[XB_XGEN(b.x)]) == gen, bar);
            __builtin_amdgcn_fence(__ATOMIC_ACQUIRE, "agent");
            asm volatile("s_waitcnt vmcnt(0)" ::: "memory");
        }
    }
    __syncthreads();
}
__device__ __forceinline__ void p0_transpose_item(const float* W, int K, int N, bf16* WT, int row_off, LAS float* scr, int item, int lane) {
    const int nblk = N / 32, kb = item / nblk, nb = item % nblk, k0 = 64 * kb, n0 = 32 * nb;
#pragma unroll 8
    for (int i = 0; i < 32; ++i) { const int kk = 2 * i + (lane >> 5); scr[kk * 33 + (lane & 31)] = W[(size_t)(k0 + kk) * N + n0 + (lane & 31)]; }
    LDS_WAIT(); asm volatile("" ::: "memory");
    const int c = lane & 7;
#pragma unroll
    for (int j = 0; j < 4; ++j) { const int n = (lane >> 3) + 8 * j; const LAS float* s = scr + (8 * c) * 33 + n;
        v4u o; o.x = pk2(s[0 * 33], s[1 * 33]); o.y = pk2(s[2 * 33], s[3 * 33]); o.z = pk2(s[4 * 33], s[5 * 33]); o.w = pk2(s[6 * 33], s[7 * 33]);
        *(GAS v4u*)(WT + (size_t)(row_off + n0 + n) * K + k0 + 8 * c) = o; }
    LDS_WAIT(); asm volatile("" ::: "memory");
}
constexpr int TI_IN = (DM / 64) * (N_IN / 32), TI_GLU = (SSMW / 64) * (SSMW / 32), TI_BR = (SSMW / 64) * (DM / 32), TI_O = (DM / 64) * (DM / 32), TI_UP = (DM / 64) * (NUP / 32), TI_DN = (DFF / 64) * (DM / 32);
constexpr int TI_LAYER = TI_IN + TI_GLU + 3 * TI_BR + TI_O + TI_UP + TI_DN, TI_ALL = DEPTH * TI_LAYER;
__device__ __forceinline__ void p0_transpose_any(const float* const* in, unsigned char* ws, LAS float* scr, int it, int lane) {
    const int l = it / TI_LAYER; int r = it % TI_LAYER;
    unsigned char* wl = ws + WS_W + (size_t)l * WB_LAYER;
    if (r < TI_IN) { p0_transpose_item(in[I_WIN] + (size_t)l * DM * N_IN, DM, N_IN, (bf16*)(wl + WB_IN), 0, scr, r, lane); return; } r -= TI_IN;
    if (r < TI_GLU) { p0_transpose_item(in[I_WGLU] + (size_t)l * SSMW * SSMW, SSMW, SSMW, (bf16*)(wl + WB_GLU), 0, scr, r, lane); return; } r -= TI_GLU;
    if (r < TI_BR) { p0_transpose_item(in[I_WSSM] + (size_t)l * SSMW * DM, SSMW, DM, (bf16*)(wl + WB_BR), 0, scr, r, lane); return; } r -= TI_BR;
    if (r < TI_BR) { p0_transpose_item(in[I_WATT] + (size_t)l * SSMW * DM, SSMW, DM, (bf16*)(wl + WB_BR), DM, scr, r, lane); return; } r -= TI_BR;
    if (r < TI_BR) { p0_transpose_item(in[I_WCNV] + (size_t)l * SSMW * DM, SSMW, DM, (bf16*)(wl + WB_BR), 2 * DM, scr, r, lane); return; } r -= TI_BR;
    if (r < TI_O) { p0_transpose_item(in[I_WO] + (size_t)l * DM * DM, DM, DM, (bf16*)(wl + WB_O), 0, scr, r, lane); return; } r -= TI_O;
    if (r < TI_UP) { p0_transpose_item(in[I_WUP] + (size_t)l * DM * NUP, DM, NUP, (bf16*)(wl + WB_UP), 0, scr, r, lane); return; } r -= TI_UP;
    p0_transpose_item(in[I_WDOWN] + (size_t)l * DFF * DM, DFF, DM, (bf16*)(wl + WB_DN), 0, scr, r, lane);
}
__device__ __forceinline__ void p0_mod_item(const float* const* in, float* mod, const LAS float* condL, int item, int lane) {
    const int l = item / (NMOD / 64), j = (item % (NMOD / 64)) * 64 + lane;
    const float* wp = in[I_WMOD] + (size_t)l * DM * NMOD + j;
    float acc[8];
#pragma unroll
    for (int b = 0; b < 8; ++b) acc[b] = 0.f;
#pragma unroll 8
    for (int k = 0; k < DM; ++k) { const float w = wp[(size_t)k * NMOD]; const f32x4 c0 = *(const LAS f32x4*)(condL + k * 8), c1 = *(const LAS f32x4*)(condL + k * 8 + 4);
        acc[0] += w * c0[0]; acc[1] += w * c0[1]; acc[2] += w * c0[2]; acc[3] += w * c0[3]; acc[4] += w * c1[0]; acc[5] += w * c1[1]; acc[6] += w * c1[2]; acc[7] += w * c1[3]; }
    const float bm = in[I_BMOD][l * NMOD + j];
#pragma unroll
    for (int b = 0; b < 8; ++b) mod[(size_t)(l * BATCH + b) * NMOD + j] = acc[b] + bm;
}
constexpr int MOD_ITEMS = DEPTH * (NMOD / 64);
__device__ __forceinline__ void p0_prologue(const float* const* in, unsigned char* ws, LAS unsigned char* lds, int tid, int wave, int lane, int vcu, int G) {
    LAS float* condL = (LAS float*)lds;
    LAS float* scr = (LAS float*)(lds + 65536 + wave * 8448);
    for (int idx = tid; idx < BATCH * DM; idx += NWAVES * 64) { const int b = idx & 7, k = idx >> 3; const float cv = in[I_C][b * DM + k]; condL[idx] = cv / (1.0f + __expf(-cv)); }
    __syncthreads();
    const int gw2 = wave * G + vcu, NGW = G * NWAVES;
    const int nmodw = MOD_ITEMS < NGW ? MOD_ITEMS : NGW;
    constexpr int TPM = 25;
    if (gw2 < nmodw) {
        for (int q = gw2; q < MOD_ITEMS; q += nmodw) p0_mod_item(in, (float*)(ws + WS_MOD), condL, q, lane);
        for (int it = gw2 * TPM; it < (gw2 + 1) * TPM && it < TI_ALL; ++it) p0_transpose_any(in, ws, scr, it, lane);
    }
    const int rest0 = nmodw * TPM < TI_ALL ? nmodw * TPM : TI_ALL;
    if (NGW > nmodw) { if (gw2 >= nmodw) for (int it = rest0 + (gw2 - nmodw); it < TI_ALL; it += NGW - nmodw) p0_transpose_any(in, ws, scr, it, lane); }
    else { for (int it = rest0 + gw2; it < TI_ALL; it += NGW) p0_transpose_any(in, ws, scr, it, lane); }
}

template <bool POST, bool PRE>
__device__ __forceinline__ void norm_rows(const float* xi, float* xo, const bf16* y, const float* gpost, const float* gt, const float* gpre, const float* sc, const float* sh, bf16* h, int gw, int NGW, int lane) {
    constexpr int RPW = 8;
    for (int m0 = gw * RPW; m0 < M; m0 += NGW * RPW) {
        const int b = m0 / SEQ;
        for (int m = m0; m < m0 + RPW; ++m) {
            float xv[4][8];
#pragma unroll
            for (int j = 0; j < 4; ++j) { const int col = 8 * (lane + 64 * j); const f32x4 a = *(const GAS f32x4*)(xi + (size_t)m * DM + col), c = *(const GAS f32x4*)(xi + (size_t)m * DM + col + 4);
                xv[j][0] = a[0]; xv[j][1] = a[1]; xv[j][2] = a[2]; xv[j][3] = a[3]; xv[j][4] = c[0]; xv[j][5] = c[1]; xv[j][6] = c[2]; xv[j][7] = c[3]; }
            if (POST) {
                float yv[4][8]; float ss = 0.f;
#pragma unroll
                for (int j = 0; j < 4; ++j) { const int col = 8 * (lane + 64 * j); const v4u w = *(const GAS v4u*)(y + (size_t)m * DM + col); unpack8(w, yv[j]);
#pragma unroll
                    for (int e = 0; e < 8; ++e) ss += yv[j][e] * yv[j][e]; }
                const float rs = rsqrtf(wave_sum(ss) * (1.0f / DM) + RMS_EPS);
#pragma unroll
                for (int j = 0; j < 4; ++j) { const int col = 8 * (lane + 64 * j);
                    const f32x4 g0 = *(const GAS f32x4*)(gpost + col), g1 = *(const GAS f32x4*)(gpost + col + 4), t0 = *(const GAS f32x4*)(gt + (size_t)b * NMOD + col), t1 = *(const GAS f32x4*)(gt + (size_t)b * NMOD + col + 4);
#pragma unroll
                    for (int e = 0; e < 4; ++e) { xv[j][e] += t0[e] * (yv[j][e] * rs * g0[e]); xv[j][e + 4] += t1[e] * (yv[j][e + 4] * rs * g1[e]); }
                    *(GAS f32x4*)(xo + (size_t)m * DM + col) = (f32x4){xv[j][0], xv[j][1], xv[j][2], xv[j][3]}; *(GAS f32x4*)(xo + (size_t)m * DM + col + 4) = (f32x4){xv[j][4], xv[j][5], xv[j][6], xv[j][7]}; }
            }
            if (PRE) {
                float ss = 0.f;
#pragma unroll
                for (int j = 0; j < 4; ++j)
#pragma unroll
                    for (int e = 0; e < 8; ++e) ss += xv[j][e] * xv[j][e];
                const float rs = rsqrtf(wave_sum(ss) * (1.0f / DM) + RMS_EPS);
#pragma unroll
                for (int j = 0; j < 4; ++j) { const int col = 8 * (lane + 64 * j); float o[8];
                    const f32x4 g0 = *(const GAS f32x4*)(gpre + col), g1 = *(const GAS f32x4*)(gpre + col + 4), s0 = *(const GAS f32x4*)(sc + (size_t)b * NMOD + col), s1 = *(const GAS f32x4*)(sc + (size_t)b * NMOD + col + 4),
                                h0 = *(const GAS f32x4*)(sh + (size_t)b * NMOD + col), h1 = *(const GAS f32x4*)(sh + (size_t)b * NMOD + col + 4);
#pragma unroll
                    for (int e = 0; e < 4; ++e) { o[e] = xv[j][e] * rs * g0[e] * (1.0f + s0[e]) + h0[e]; o[e + 4] = xv[j][e + 4] * rs * g1[e] * (1.0f + s1[e]) + h1[e]; }
                    *(GAS v4u*)(h + (size_t)m * DM + col) = pack8f(o); }
            }
        }
    }
}
__device__ __forceinline__ void ffn_act_phase(const bf16* up, bf16* act, const float* cw  , int gw, int NGW, int lane) {
    constexpr int NCH = DFF / 512, NRUN = M / 64;
    for (int it = gw; it < NCH * NRUN; it += NGW) {
        const int run = it / NCH, ch = it % NCH, m0 = run * 64, col = ch * 512 + lane * 8;
        float wa[3][8], wb[3][8];
#pragma unroll
        for (int k = 0; k < 3; ++k) { const f32x4 a0 = *(const GAS f32x4*)(cw + k * NUP + col), a1 = *(const GAS f32x4*)(cw + k * NUP + col + 4), b0 = *(const GAS f32x4*)(cw + k * NUP + DFF + col), b1 = *(const GAS f32x4*)(cw + k * NUP + DFF + col + 4);
#pragma unroll
            for (int e = 0; e < 4; ++e) { wa[k][e] = a0[e]; wa[k][e + 4] = a1[e]; wb[k][e] = b0[e]; wb[k][e + 4] = b1[e]; } }
        float a1[8], a2[8], b1[8], b2[8];
        if ((m0 % SEQ) == 0) {
#pragma unroll
            for (int e = 0; e < 8; ++e) { a1[e] = 0.f; a2[e] = 0.f; b1[e] = 0.f; b2[e] = 0.f; }
        } else {
            unpack8(*(const GAS v4u*)(up + (size_t)(m0 - 1) * NUP + col), a1); unpack8(*(const GAS v4u*)(up + (size_t)(m0 - 2) * NUP + col), a2);
            unpack8(*(const GAS v4u*)(up + (size_t)(m0 - 1) * NUP + DFF + col), b1); unpack8(*(const GAS v4u*)(up + (size_t)(m0 - 2) * NUP + DFF + col), b2);
        }
#pragma unroll 4
        for (int t = 0; t < 64; ++t) {
            float a0[8], b0[8], o[8];
            unpack8(*(const GAS v4u*)(up + (size_t)(m0 + t) * NUP + col), a0); unpack8(*(const GAS v4u*)(up + (size_t)(m0 + t) * NUP + DFF + col), b0);
#pragma unroll
            for (int e = 0; e < 8; ++e) { const float ca = wa[0][e] * a0[e] + wa[1][e] * a1[e] + wa[2][e] * a2[e], cb = wb[0][e] * b0[e] + wb[1][e] * b1[e] + wb[2][e] * b2[e];
                o[e] = ca * __builtin_amdgcn_rcpf(1.0f + __expf(-ca)) * cb; a2[e] = a1[e]; a1[e] = a0[e]; b2[e] = b1[e]; b1[e] = b0[e]; }
            *(GAS v4u*)(act + (size_t)(m0 + t) * DFF + col) = pack8f(o);
        }
    }
}
__device__ __forceinline__ void conv_mix_items(const bf16* proj, bf16* outc, const float* cw  , int first, int step, int lane) {
    for (int run = first; run < M / 64; run += step) {
        const int m0 = run * 64, col = lane * 8;
        float w[3][8];
#pragma unroll
        for (int k = 0; k < 3; ++k) { const f32x4 a0 = *(const GAS f32x4*)(cw + k * 512 + col), a1 = *(const GAS f32x4*)(cw + k * 512 + col + 4);
#pragma unroll
            for (int e = 0; e < 4; ++e) { w[k][e] = a0[e]; w[k][e + 4] = a1[e]; } }
        float z1[8], z2[8];
        if ((m0 % SEQ) == 0) {
#pragma unroll
            for (int e = 0; e < 8; ++e) { z1[e] = 0.f; z2[e] = 0.f; }
        } else {
            float p[8], q[8];
            unpack8(*(const GAS v4u*)(proj + (size_t)(m0 - 1) * N_IN + OFF_CC + col), p); unpack8(*(const GAS v4u*)(proj + (size_t)(m0 - 1) * N_IN + OFF_CH + col), q);
#pragma unroll
            for (int e = 0; e < 8; ++e) z1[e] = p[e] * q[e];
            unpack8(*(const GAS v4u*)(proj + (size_t)(m0 - 2) * N_IN + OFF_CC + col), p); unpack8(*(const GAS v4u*)(proj + (size_t)(m0 - 2) * N_IN + OFF_CH + col), q);
#pragma unroll
            for (int e = 0; e < 8; ++e) z2[e] = p[e] * q[e];
        }
#pragma unroll 4
        for (int t = 0; t < 64; ++t) {
            float p[8], q[8], bb[8], o[8];
            const bf16* rp = proj + (size_t)(m0 + t) * N_IN;
            unpack8(*(const GAS v4u*)(rp + OFF_CC + col), p); unpack8(*(const GAS v4u*)(rp + OFF_CH + col), q); unpack8(*(const GAS v4u*)(rp + OFF_CB + col), bb);
#pragma unroll
            for (int e = 0; e < 8; ++e) { const float z0 = p[e] * q[e]; o[e] = bb[e] * (w[0][e] * z0 + w[1][e] * z1[e] + w[2][e] * z2[e]); z2[e] = z1[e]; z1[e] = z0; }
            *(GAS v4u*)(outc + (size_t)(m0 + t) * 512 + col) = pack8f(o);
        }
    }
}
constexpr int SSM_UF = 0, SSM_HS = 32768, SSM_E = 32768 + 8 * 4608, SSM_LDS_END = SSM_E + 4096;
constexpr int ATT_VLDS = 81920;
static_assert(SSM_LDS_END <= ATT_VLDS && ATT_VLDS + 8 * 4608 <= RING_BYTES, "mixer LDS map");
__device__ __forceinline__ float gelu_tanh(float y) { const float z = 0.7978845608028654f * (y + 0.044715f * y * y * y); const float e = __expf(2.0f * z); const float th = 1.0f - 2.0f * __builtin_amdgcn_rcpf(1.0f + e); return 0.5f * y * (1.0f + th); }
__device__ __forceinline__ void ssm_stage_u(const bf16* proj, LAS float* Uf, int b, int g, int T0, int lane) {
#pragma unroll
    for (int i = 0; i < 2; ++i) { const int piece = lane + 64 * i, tt = piece >> 1, half = piece & 1;
        const v4u w = *(const GAS v4u*)(proj + (size_t)(b * SEQ + T0 + tt) * N_IN + g * 16 + half * 8); float f[8]; unpack8(w, f);
        *(LAS f32x4*)(Uf + tt * 16 + half * 8) = (f32x4){f[0], f[1], f[2], f[3]}; *(LAS f32x4*)(Uf + tt * 16 + half * 8 + 4) = (f32x4){f[4], f[5], f[6], f[7]}; }
    LDS_WAIT();
}
__device__ __forceinline__ void ssm_unit(const float* const* in, int l, int b, int g, const bf16* proj, bf16* gbuf, LAS unsigned char* lds, int wave, int lane) {
    const int n = lane, lg = l * NGRP + g, gn = lg * NST + n;
    const float dt = expf(in[I_LOGDT][lg]);
    const float ar = in[I_ARE][gn], ai = in[I_AIM][gn];
    const float mag = expf(ar * dt), ang = ai * dt;
    const float kq2 = rintf(ang * 0.15915494309189535f); float red = fmaf(-kq2, 6.2831854820251465f, ang); red = fmaf(-kq2, -1.7484555e-7f, red);
    const float lr = mag * cosf(red), li = mag * sinf(red);
    const float den = ar * ar + ai * ai, fre = ((lr - 1.0f) * ar + li * ai) / den, fim = (li * ar - (lr - 1.0f) * ai) / den;
    float bbr[16], bbi[16];
    { const float* bre = in[I_BRE] + (size_t)gn * 16; const float* bim = in[I_BIM] + (size_t)gn * 16;
#pragma unroll
      for (int q = 0; q < 4; ++q) { const f32x4 r4 = *(const GAS f32x4*)(bre + 4 * q), i4 = *(const GAS f32x4*)(bim + 4 * q);
#pragma unroll
          for (int e = 0; e < 4; ++e) { bbr[4 * q + e] = fre * r4[e] - fim * i4[e]; bbi[4 * q + e] = fre * i4[e] + fim * r4[e]; } } }
    const int cc = lane & 15, kq = lane >> 4;
    bf16x8 Cf[4];
#pragma unroll
    for (int kb = 0; kb < 4; ++kb) { const float* src = (kb < 2 ? in[I_CRE] : in[I_CIM]) + (size_t)(lg * 16 + cc) * NST + (kb & 1) * 32 + 8 * kq; const float sg = kb < 2 ? 1.0f : -1.0f;
        const f32x4 a = *(const GAS f32x4*)src, c4 = *(const GAS f32x4*)(src + 4);
        const unsigned w0 = pk2(sg * a[0], sg * a[1]), w1 = pk2(sg * a[2], sg * a[3]), w2 = pk2(sg * c4[0], sg * c4[1]), w3 = pk2(sg * c4[2], sg * c4[3]);
        Cf[kb] = __builtin_bit_cast(bf16x8, (v4u){w0, w1, w2, w3}); }
    const float dsk = in[I_SSMD][l * SSMW + g * 16 + cc];
    LAS float* Uf = (LAS float*)(lds + SSM_UF + wave * 4096);
    LAS bf16* Hs = (LAS bf16*)(lds + SSM_HS + wave * 4608);
    LAS float* E = (LAS float*)(lds + SSM_E);
    float hr = 0.f, hi = 0.f;
    for (int s = 0; s < 4; ++s) {
        ssm_stage_u(proj, Uf, b, g, 256 * wave + 64 * s, lane);
        for (int tt = 0; tt < 64; ++tt) {
            const f32x4 u0 = *(const LAS f32x4*)(Uf + tt * 16), u1 = *(const LAS f32x4*)(Uf + tt * 16 + 4), u2 = *(const LAS f32x4*)(Uf + tt * 16 + 8), u3 = *(const LAS f32x4*)(Uf + tt * 16 + 12);
            float xr = 0.f, xi = 0.f;
#pragma unroll
            for (int e = 0; e < 4; ++e) { xr += bbr[e] * u0[e]; xi += bbi[e] * u0[e]; xr += bbr[4 + e] * u1[e]; xi += bbi[4 + e] * u1[e]; xr += bbr[8 + e] * u2[e]; xi += bbi[8 + e] * u2[e]; xr += bbr[12 + e] * u3[e]; xi += bbi[12 + e] * u3[e]; }
            const float nr = lr * hr - li * hi + xr, ni = lr * hi + li * hr + xi; hr = nr; hi = ni;
        }
        asm volatile("" ::: "memory");
    }
    E[(wave * 64 + n) * 2] = hr; E[(wave * 64 + n) * 2 + 1] = hi;
    float pr = lr, pi = li;
#pragma unroll
    for (int q = 0; q < 8; ++q) { const float t = pr * pr - pi * pi; pi = 2.0f * pr * pi; pr = t; }
    __syncthreads();
    hr = 0.f; hi = 0.f;
    for (int j = 0; j < wave; ++j) { const float er = E[(j * 64 + n) * 2], ei = E[(j * 64 + n) * 2 + 1]; const float nr = pr * hr - pi * hi + er, ni = pr * hi + pi * hr + ei; hr = nr; hi = ni; }
    for (int s = 0; s < 4; ++s) {
        const int T0 = 256 * wave + 64 * s;
        ssm_stage_u(proj, Uf, b, g, T0, lane);
        for (int bt = 0; bt < 4; ++bt) {
#pragma unroll 4
            for (int t16 = 0; t16 < 16; ++t16) { const int tt = bt * 16 + t16;
                const f32x4 u0 = *(const LAS f32x4*)(Uf + tt * 16), u1 = *(const LAS f32x4*)(Uf + tt * 16 + 4), u2 = *(const LAS f32x4*)(Uf + tt * 16 + 8), u3 = *(const LAS f32x4*)(Uf + tt * 16 + 12);
                float xr = 0.f, xi = 0.f;
#pragma unroll
                for (int e = 0; e < 4; ++e) { xr += bbr[e] * u0[e]; xi += bbi[e] * u0[e]; xr += bbr[4 + e] * u1[e]; xi += bbi[4 + e] * u1[e]; xr += bbr[8 + e] * u2[e]; xi += bbi[8 + e] * u2[e]; xr += bbr[12 + e] * u3[e]; xi += bbi[12 + e] * u3[e]; }
                const float nr = lr * hr - li * hi + xr, ni = lr * hi + li * hr + xi; hr = nr; hi = ni;
                Hs[t16 * 136 + n] = (bf16)f2bf(hr); Hs[t16 * 136 + 64 + n] = (bf16)f2bf(hi); }
            LDS_WAIT();
            f32x4 Y = (f32x4){0.f, 0.f, 0.f, 0.f};
#pragma unroll
            for (int kb = 0; kb < 4; ++kb) { const bf16x8 a = *(const LAS bf16x8*)(Hs + cc * 136 + kb * 32 + kq * 8); Y = __builtin_amdgcn_mfma_f32_16x16x32_bf16(a, Cf[kb], Y, 0, 0, 0); }
#pragma unroll
            for (int i = 0; i < 4; ++i) { const int tt = bt * 16 + 4 * kq + i; const float uval = Uf[tt * 16 + cc]; const float yv = gelu_tanh(Y[i] + dsk * uval);
                gbuf[(size_t)(b * SEQ + T0 + tt) * SSMW + g * 16 + cc] = (bf16)f2bf(yv); }
            LDS_WAIT(); asm volatile("" ::: "memory");
        }
    }
}

__device__ __forceinline__ s16x4 vtr(const LAS unsigned char* p) { return __builtin_bit_cast(s16x4, __builtin_amdgcn_ds_read_tr16_b64_v4i16((LAS s16x4*)p)); }
__device__ __forceinline__ float xmax16(float v) { const unsigned u = __float_as_uint(v); auto r = __builtin_amdgcn_permlane16_swap(u, u, false, false); return fmaxf(__uint_as_float(r[0]), __uint_as_float(r[1])); }
__device__ __forceinline__ float xmax32(float v) { const unsigned u = __float_as_uint(v); auto r = __builtin_amdgcn_permlane32_swap(u, u, false, false); return fmaxf(__uint_as_float(r[0]), __uint_as_float(r[1])); }
__device__ __forceinline__ float xsum16(float v) { const unsigned u = __float_as_uint(v); auto r = __builtin_amdgcn_permlane16_swap(u, u, false, false); return __uint_as_float(r[0]) + __uint_as_float(r[1]); }
__device__ __forceinline__ float xsum32(float v) { const unsigned u = __float_as_uint(v); auto r = __builtin_amdgcn_permlane32_swap(u, u, false, false); return __uint_as_float(r[0]) + __uint_as_float(r[1]); }
struct AttnKV { bf16x8 k[2][2]; v4u v[4]; };
__device__ __forceinline__ void attn_load(AttnKV& t, const bf16* kbase, const bf16* vbase, int kt0, int rg, int sh, int lane) {
    const int col = lane & 15;
#pragma unroll
    for (int half = 0; half < 2; ++half) { int kp = kt0 + 16 * half + col; kp = kp < 0 ? 0 : kp; const bf16* kr = kbase + (size_t)(rg + (kp << sh)) * N_IN;
        t.k[half][0] = *(const GAS bf16x8*)kr; t.k[half][1] = *(const GAS bf16x8*)(kr + 32); }
#pragma unroll
    for (int i = 0; i < 4; ++i) { const int chunk = lane + 64 * i, row = chunk >> 3, c16 = chunk & 7; int kp = kt0 + row; kp = kp < 0 ? 0 : kp;
        t.v[i] = *(const GAS v4u*)(vbase + (size_t)(rg + (kp << sh)) * N_IN + c16 * 8); }
}
__device__ __forceinline__ void attn_tile(const bf16* proj, bf16* aout, LAS unsigned char* vlds, int b, int h, int r, int i0, int lane) {
    const int col = lane & 15, grp = lane >> 4;
    const size_t rowb = (size_t)b * SEQ;
    const int tq = r + 16 * (i0 + col);
    const bf16* qrow = proj + (rowb + tq) * N_IN + OFF_Q + h * 64 + grp * 8;
    bf16x8 Qf[3][2];
#pragma unroll
    for (int g = 0; g < 3; ++g)
#pragma unroll
        for (int dh = 0; dh < 2; ++dh) Qf[g][dh] = *(const GAS bf16x8*)(qrow + g * 512 + dh * 32);
    f32x4 acc[4];
#pragma unroll
    for (int d = 0; d < 4; ++d) acc[d] = (f32x4){0.f, 0.f, 0.f, 0.f};
    float mrun = -1e30f, lrun = 0.f;
    const float L2E = 1.4426950408889634f;
    const int tq4 = (lane & 15) >> 2, tp4 = lane & 3;
    const LAS unsigned char* vrd = vlds + (4 * grp + tq4) * 144 + tp4 * 8;
    LAS unsigned char* vwr = vlds + (lane >> 3) * 144 + (lane & 7) * 16;
#pragma unroll
    for (int g = 0; g < 3; ++g) {
        const int sh = 2 * g, dil = 1 << sh, rg = r & (dil - 1);
        const int qp = (tq - rg) >> sh;
        const int kstart = (g == 0) ? (16 * i0 - 128) : (g == 1 ? 4 * i0 - 128 : i0 - 144), ntile = (g == 0) ? 12 : (g == 1 ? 6 : 5);
        const float c_qk = 0.125f * L2E, c_b = exp2f(-(float)(g * 8 + h + 1) * (1.0f / 3.0f)) * (float)dil * L2E;
        const bf16* kbase = proj + rowb * N_IN + OFF_K + g * 512 + h * 64 + grp * 8;
        const bf16* vbase = proj + rowb * N_IN + OFF_V + g * 512 + h * 64;
        int ti = 0;
        while (kstart + 32 * ti + 32 <= 0) ++ti;
        AttnKV cur, nxt;
        attn_load(cur, kbase, vbase, kstart + 32 * ti, rg, sh, lane);
        for (; ti < ntile; ++ti) {
            const int kt0 = kstart + 32 * ti;
            if (ti + 1 < ntile) attn_load(nxt, kbase, vbase, kt0 + 32, rg, sh, lane);
            f32x4 S[2];
#pragma unroll
            for (int half = 0; half < 2; ++half) {
                S[half] = __builtin_amdgcn_mfma_f32_16x16x32_bf16(cur.k[half][0], Qf[g][0], (f32x4){0.f, 0.f, 0.f, 0.f}, 0, 0, 0);
                S[half] = __builtin_amdgcn_mfma_f32_16x16x32_bf16(cur.k[half][1], Qf[g][1], S[half], 0, 0, 0); }
#pragma unroll
            for (int i = 0; i < 4; ++i) *(LAS v4u*)(vwr + i * 8 * 144) = cur.v[i];
            float sc[8]; float mx = -1e30f;
#pragma unroll
            for (int half = 0; half < 2; ++half)
#pragma unroll
                for (int i = 0; i < 4; ++i) { const int kp = kt0 + 16 * half + 4 * grp + i, dist = qp - kp; const bool valid = (dist >= 0) && (dist <= 128) && (kp >= 0);
                    const float s = valid ? (S[half][i] * c_qk - c_b * (float)dist) : -1e30f; sc[half * 4 + i] = s; mx = fmaxf(mx, s); }
            mx = xmax32(xmax16(mx));
            const float mnew = fmaxf(mrun, mx), alpha = __builtin_amdgcn_exp2f(mrun - mnew);
            float p[8], psum = 0.f;
#pragma unroll
            for (int j = 0; j < 8; ++j) { p[j] = (sc[j] > -1e29f) ? __builtin_amdgcn_exp2f(sc[j] - mnew) : 0.f; psum += p[j]; }
            psum = xsum32(xsum16(psum));
            lrun = lrun * alpha + psum; mrun = mnew;
#pragma unroll
            for (int d = 0; d < 4; ++d) acc[d] = acc[d] * alpha;
            const bf16x8 Pf = __builtin_bit_cast(bf16x8, (v4u){pk2(p[0], p[1]), pk2(p[2], p[3]), pk2(p[4], p[5]), pk2(p[6], p[7])});
            LDS_WAIT();
#pragma unroll
            for (int d = 0; d < 4; ++d) { const s16x4 lo = vtr(vrd + d * 32), hi = vtr(vrd + 16 * 144 + d * 32);
                const bf16x8 Vf = (bf16x8){lo[0], lo[1], lo[2], lo[3], hi[0], hi[1], hi[2], hi[3]};
                acc[d] = __builtin_amdgcn_mfma_f32_16x16x32_bf16(Vf, Pf, acc[d], 0, 0, 0); }
            LDS_WAIT(); asm volatile("" ::: "memory");
            cur = nxt;
        }
    }
    const float inv = 1.0f / lrun;
    bf16* orow = aout + (rowb + tq) * SSMW + h * 64 + 4 * grp;
#pragma unroll
    for (int d = 0; d < 4; ++d) { v2u w; w.x = pk2(acc[d][0] * inv, acc[d][1] * inv); w.y = pk2(acc[d][2] * inv, acc[d][3] * inv); *(GAS v2u*)(orow + d * 16) = w; }
}
#ifndef MK_PER_PHASE
#define MK_PER_PHASE 0
#endif
__device__ __forceinline__ int launder(int v) { asm volatile("" : "+v"(v)); return v; }
#define PH_LOCALS const int tid = launder((int)threadIdx.x), lane = tid & 63, wave = __builtin_amdgcn_readfirstlane(tid >> 6), gw = vcu * NWAVES + wave; (void)tid; (void)lane; (void)wave; (void)gw;
constexpr int PH_PER_LAYER = 11, N_PHASES = 1 + DEPTH * PH_PER_LAYER;
struct Args { const float* in[N_INPUTS]; float* out; unsigned char* ws; int ph_lo, ph_hi; };
static_assert(sizeof(Args) == N_INPUTS * 8 + 8 + 8 + 8, "Args has no padding");
__global__ void __launch_bounds__(NWAVES * 64, 2) trunk_fwd(Args args) {
    extern __shared__ __attribute__((aligned(16))) unsigned char lds_raw[];
    LAS unsigned char* lds = (LAS unsigned char*)lds_raw;
    volatile LAS unsigned* MISC = (volatile LAS unsigned*)(lds + MISC_OFF);
    const int G = gridDim.x, bx = blockIdx.x, vcu = (G % 8 == 0) ? (bx % 8) * (G / 8) + bx / 8 : bx;
    const int NGW = G * NWAVES;
    unsigned char* ws = args.ws;
    const float* const* in = args.in;
    for (int u = threadIdx.x; u < (LDS_BYTES - MISC_OFF) / 4; u += NWAVES * 64) MISC[u] = 0u;
    __syncthreads();
    unsigned* barw = (unsigned*)(ws + WS_CTL) + CW_BAR;
    XcdBarrier bar; bar.bar = barw; bar.x = 0; bar.st = nullptr;
    if (!MK_PER_PHASE) bar = xcd_barrier_post(barw, MISC + 8);
    const int lo = args.ph_lo, hi = args.ph_hi;
#ifndef PH_MASK
#define PH_MASK 0xFFFF
#endif
#define EN(k) (((PH_MASK) >> (k)) & 1)
#ifndef REP_MASK
#define REP_MASK 0
#endif
#define NREP(k) (1 + (((REP_MASK) >> (k)) & 1))
#define PH_IN(id) (lo <= (id) && (id) < hi)
#define PH_SEAM(id) do { if ((id) + 1 < hi) { if (!MK_PER_PHASE) xcd_barrier(bar); } } while (0)
    float* mod = (float*)(ws + WS_MOD);
    bf16* Hb = (bf16*)(ws + WS_H); bf16* PJ = (bf16*)(ws + WS_PROJ); bf16* UP = (bf16*)(ws + WS_PROJ); bf16* ACT = (bf16*)(ws + WS_ACT);
    bf16* GB = (bf16*)(ws + WS_G); bf16* A3 = (bf16*)(ws + WS_A3); bf16* MG = (bf16*)(ws + WS_MG); bf16* YB = (bf16*)(ws + WS_Y);
    float* xout = args.out;

    if (EN(0) && PH_IN(0)) for (int rp = 0; rp < NREP(0); ++rp) { PH_LOCALS; p0_prologue(in, ws, lds, tid, wave, lane, vcu, G); PH_SEAM(0); }

    for (int l = 0; l < DEPTH; ++l) {
        const int pb = 1 + l * PH_PER_LAYER;
        const unsigned char* wl = ws + WS_W + (size_t)l * WB_LAYER;
        const float* modl = mod + (size_t)l * BATCH * NMOD;
        const float* xcur = (l == 0) ? in[I_X] : xout;
        if (l == 0 && PH_IN(pb + 0) && EN(1)) { PH_LOCALS;
            norm_rows<false, true>(in[I_X], nullptr, nullptr, nullptr, nullptr, in[I_GPRE_MIX] + l * DM, modl + DM, modl, Hb, gw, NGW, lane);
            PH_SEAM(pb + 0);
        }
        if (PH_IN(pb + 1) && EN(2)) for (int rp = 0; rp < NREP(2); ++rp) { PH_LOCALS;
            pg8::Gemm g{Hb, (const bf16*)(wl + WB_IN), M, N_IN, DM}; pg8::StaticOrder S; S.init(M, N_IN, G, bx);
            pg8::EpiIn E{PJ, N_IN, in[I_BGATE] + (size_t)l * 3 * DM, OFF_GATE / 256};
            pg8::gemm_phase<pg8::EpiIn, pg8::StaticOrder, true, true>(lds, g, S, E);
            PH_SEAM(pb + 1);
        }
        if (PH_IN(pb + 2) && EN(3)) { PH_LOCALS;
            for (int rep = 0; rep < NREP(12); ++rep)
            for (int uidx = vcu; uidx < BATCH * NGRP; uidx += G) { ssm_unit(in, l, uidx / NGRP, uidx % NGRP, PJ, GB, lds, wave, lane); __syncthreads(); }
            for (int rep = 0; rep < NREP(13); ++rep)
            { LAS unsigned char* vl = lds + ATT_VLDS + wave * 4608; int k = 0;
              for (int T = gw; T < BATCH * 8 * 16 * 8; T += NGW, ++k) { const int it = ((T & 7) + 2 * k) & 7, r = (T >> 3) & 15, bh = T >> 7;
                  attn_tile(PJ, A3 + (size_t)M * SSMW, vl, bh >> 3, bh & 7, r, 16 * it, lane); } }
            for (int rep = 0; rep < NREP(14); ++rep)
            conv_mix_items(PJ, A3 + (size_t)2 * M * SSMW, in[I_CONVW] + (size_t)l * 3 * SSMW, gw, NGW, lane);
            PH_SEAM(pb + 2);
        }
        if (PH_IN(pb + 3) && EN(4)) for (int rp = 0; rp < NREP(4); ++rp) { PH_LOCALS;
            { pg8::Gemm g{GB, (const bf16*)(wl + WB_GLU), M, SSMW, SSMW}; pg8::StaticOrder S; S.init(M, SSMW, G, bx);
              pg8::EpiGlu E{GB, A3, SSMW, in[I_BGLU] + (size_t)l * SSMW};
              pg8::gemm_phase<pg8::EpiGlu, pg8::StaticOrder, true, true>(lds, g, S, E); }
            { pg8::Gemm g{A3, (const bf16*)(wl + WB_BR), M, DM, SSMW}; pg8::BrPairOrder S; S.init(M, DM, G, bx);
              pg8::EpiBr E{PJ + OFF_GATE, N_IN, MG, YB, DM};
              pg8::gemm_phase<pg8::EpiBr, pg8::BrPairOrder, true, true>(lds, g, S, E); }
            PH_SEAM(pb + 3);
        }
        if (PH_IN(pb + 4) && EN(5)) { PH_LOCALS;
            pg8::Gemm g{A3, (const bf16*)(wl + WB_BR), M, DM, SSMW}; pg8::StaticOrder S; S.init(M, DM, G, bx);
            pg8::EpiBr E{PJ + OFF_GATE, N_IN, MG, YB, DM};
            pg8::gemm_phase<pg8::EpiBr, pg8::StaticOrder, true, true>(lds, g, S, E);
            PH_SEAM(pb + 4);
        }
        if (PH_IN(pb + 5) && EN(6)) for (int rp = 0; rp < NREP(6); ++rp) { PH_LOCALS;
            pg8::Gemm g{MG, (const bf16*)(wl + WB_O), M, DM, DM}; pg8::StaticOrder S; S.init(M, DM, G, bx);
            pg8::EpiStore E{YB, DM};
            pg8::gemm_phase<pg8::EpiStore, pg8::StaticOrder, true, true>(lds, g, S, E);
            PH_SEAM(pb + 5);
        }
        if (PH_IN(pb + 6) && EN(7)) { PH_LOCALS;
            norm_rows<true, true>(xcur, xout, YB, in[I_GPOST_MIX] + l * DM, modl + 2 * DM, in[I_GPRE_FFN] + l * DM, modl + 4 * DM, modl + 3 * DM, Hb, gw, NGW, lane);
            PH_SEAM(pb + 6);
        }
        if (PH_IN(pb + 7) && EN(8)) for (int rp = 0; rp < NREP(8); ++rp) { PH_LOCALS;
            pg8::Gemm g{Hb, (const bf16*)(wl + WB_UP), M, NUP, DM}; pg8::StaticOrder S; S.init(M, NUP, G, bx);
            pg8::EpiStore E{UP, NUP};
            pg8::gemm_phase<pg8::EpiStore, pg8::StaticOrder, true, true>(lds, g, S, E);
            PH_SEAM(pb + 7);
        }
        if (PH_IN(pb + 8) && EN(9)) for (int rp = 0; rp < NREP(9); ++rp) { PH_LOCALS; ffn_act_phase(UP, ACT, in[I_FCONVW] + (size_t)l * 3 * NUP, gw, NGW, lane); PH_SEAM(pb + 8); }
        if (PH_IN(pb + 9) && EN(10)) for (int rp = 0; rp < NREP(10); ++rp) { PH_LOCALS;
            pg8::Gemm g{ACT, (const bf16*)(wl + WB_DN), M, DM, DFF}; pg8::StaticOrder S; S.init(M, DM, G, bx);
            pg8::EpiStore E{YB, DM};
            pg8::gemm_phase<pg8::EpiStore, pg8::StaticOrder, true, true>(lds, g, S, E);
            PH_SEAM(pb + 9);
        }
        if (PH_IN(pb + 10) && EN(11)) { PH_LOCALS;
            if (l + 1 < DEPTH) norm_rows<true, true>(xout, xout, YB, in[I_GPOST_FFN] + l * DM, modl + 5 * DM, in[I_GPRE_MIX] + (l + 1) * DM, modl + BATCH * NMOD + DM, modl + BATCH * NMOD, Hb, gw, NGW, lane);
            else norm_rows<true, false>(xout, xout, YB, in[I_GPOST_FFN] + l * DM, modl + 5 * DM, nullptr, nullptr, nullptr, nullptr, gw, NGW, lane);
            PH_SEAM(pb + 10);
        }
    }
#undef PH_IN
#undef PH_SEAM
}


#ifndef DBG_STOP
#define DBG_STOP -1
#endif
#ifndef DBG_BUF
#define DBG_BUF 0
#endif
__global__ void __launch_bounds__(256) dbg_dump(const bf16* src, int ld, int col0, int ncol, int outc0, float* out) {
    for (size_t i = (size_t)blockIdx.x * 256 + threadIdx.x; i < (size_t)M * ncol; i += (size_t)gridDim.x * 256) { const size_t m = i / ncol; const int c = (int)(i % ncol);
        out[m * DM + outc0 + c] = __uint_as_float(((unsigned)src[m * ld + col0 + c]) << 16); }
}
extern "C" void kernel_launch(void* const* d_in, const int* in_sizes, int n_in, void* d_out, int out_size, void* d_ws, size_t ws_size, hipStream_t stream) {
    static int grid = 0;
    if (grid == 0) {
        if (n_in != N_INPUTS || in_sizes[0] != M * DM || out_size != M * DM || ws_size < WS_END) { fprintf(stderr, "kernel_launch: unexpected shapes (n_in %d, in0 %d, out %d, ws %zu < %zu); nothing launched\n", n_in, n_in > 0 ? in_sizes[0] : -1, out_size, ws_size, (size_t)WS_END); grid = -1; return; }
        int dev = 0, cus = 0, per_cu = 0;
        if (hipGetDevice(&dev) != hipSuccess || hipDeviceGetAttribute(&cus, hipDeviceAttributeMultiprocessorCount, dev) != hipSuccess) { fprintf(stderr, "kernel_launch: device query failed\n"); grid = -1; return; }
        if (hipFuncSetAttribute((const void*)trunk_fwd, hipFuncAttributeMaxDynamicSharedMemorySize, LDS_BYTES) != hipSuccess) { fprintf(stderr, "kernel_launch: hipFuncSetAttribute failed\n"); grid = -1; return; }
        if (hipOccupancyMaxActiveBlocksPerMultiprocessor(&per_cu, (const void*)trunk_fwd, NWAVES * 64, LDS_BYTES) != hipSuccess || per_cu < 1) { fprintf(stderr, "kernel_launch: occupancy query reports %d blocks per CU\n", per_cu); }
        (void)hipGetLastError();
        grid = cus;
    }
    if (grid < 0) return;
    if (hipMemsetAsync((char*)d_ws + WS_CTL, 0, CTL_ZERO_BYTES, stream) != hipSuccess) { fprintf(stderr, "kernel_launch: memset failed\n"); return; }
    Args a{};
    for (int i = 0; i < N_INPUTS; ++i) a.in[i] = (const float*)d_in[i];
    a.out = (float*)d_out; a.ws = (unsigned char*)d_ws;
#if MK_PER_PHASE
    for (int p = 0; p < N_PHASES; ++p) {
        if (p > 0 && ((p - 1) % PH_PER_LAYER) == 0 && p != 1) continue;
        a.ph_lo = p; a.ph_hi = p + 1;
        hipLaunchKernelGGL(trunk_fwd, dim3(grid), dim3(NWAVES * 64), LDS_BYTES, stream, a);
        if (p == DBG_STOP) {
            unsigned char* w = (unsigned char*)d_ws; float* o = (float*)d_out;
            if (DBG_BUF == 0) hipLaunchKernelGGL(dbg_dump, dim3(2048), dim3(256), 0, stream, (const bf16*)(w + WS_H), DM, 0, DM, 0, o);
            if (DBG_BUF == 1) hipLaunchKernelGGL(dbg_dump, dim3(2048), dim3(256), 0, stream, (const bf16*)(w + WS_PROJ), N_IN, 0, DM, 0, o);
            if (DBG_BUF == 2) hipLaunchKernelGGL(dbg_dump, dim3(2048), dim3(256), 0, stream, (const bf16*)(w + WS_PROJ), N_IN, N_IN - DM, DM, 0, o);
            if (DBG_BUF == 3) { hipLaunchKernelGGL(dbg_dump, dim3(2048), dim3(256), 0, stream, (const bf16*)(w + WS_G), SSMW, 0, SSMW, 0, o);
                                hipLaunchKernelGGL(dbg_dump, dim3(2048), dim3(256), 0, stream, (const bf16*)(w + WS_A3), SSMW, 0, SSMW, 512, o);
                                hipLaunchKernelGGL(dbg_dump, dim3(2048), dim3(256), 0, stream, (const bf16*)(w + WS_A3) + (size_t)M * SSMW, SSMW, 0, SSMW, 1024, o);
                                hipLaunchKernelGGL(dbg_dump, dim3(2048), dim3(256), 0, stream, (const bf16*)(w + WS_A3) + (size_t)2 * M * SSMW, SSMW, 0, SSMW, 1536, o); }
            if (DBG_BUF == 4) hipLaunchKernelGGL(dbg_dump, dim3(2048), dim3(256), 0, stream, (const bf16*)(w + WS_MG), DM, 0, DM, 0, o);
            if (DBG_BUF == 5) hipLaunchKernelGGL(dbg_dump, dim3(2048), dim3(256), 0, stream, (const bf16*)(w + WS_Y), DM, 0, DM, 0, o);
            if (DBG_BUF == 6) hipLaunchKernelGGL(dbg_dump, dim3(2048), dim3(256), 0, stream, (const bf16*)(w + WS_ACT), DFF, 0, DM, 0, o);
            break;
        }
    }
#else
    a.ph_lo = 0; a.ph_hi = N_PHASES;
    hipLaunchKernelGGL(trunk_fwd, dim3(grid), dim3(NWAVES * 64), LDS_BYTES, stream, a);
#endif
    const hipError_t le = hipPeekAtLastError();
    if (le != hipSuccess) fprintf(stderr, "kernel_launch: launch failed: %s\n", hipGetErrorName(le));
}
```

```cpp
#include <hip/hip_runtime.h>
#include <cstdio>
#include <cstdint>
namespace pg8 {
#define PG8_LAS __attribute__((address_space(3)))
typedef unsigned short bf16_t;
typedef short bf16x8 __attribute__((ext_vector_type(8)));
typedef float f32x4 __attribute__((ext_vector_type(4)));
typedef unsigned u32x4 __attribute__((ext_vector_type(4)));
constexpr int BM = 256, BK = 64, HALF = 128, HTB = HALF * BK * 2  , STAGE_BYTES = 8 * HTB, NXCD = 8, WGM = 8;

__host__ __device__ __forceinline__ int lds_byte(int r, int c) { const int st = (r >> 4) * 2 + (c >> 5), rr = r & 15, cc = c & 31, ob = rr * 64 + cc * 2; return st * 1024 + (ob ^ (((ob >> 9) & 1) << 5)); }
__host__ __device__ __forceinline__ void stage_rc(int b, int& R, int& C) { const int st = b / 1024, sb = b % 1024, swz = sb ^ (((sb >> 9) & 1) << 5); R = (st >> 1) * 16 + swz / 64; C = (st & 1) * 32 + (swz % 64) / 2; }
__host__ __device__ __forceinline__ int perm32(int rho) { const int n = rho >> 4, i = rho & 15; return 8 * (i >> 2) + 4 * n + (i & 3); }

struct Unit { int pm, pn; };
struct Gemm { const bf16_t* A; const bf16_t* Bt; int M, N, K; };

struct StaticOrder {
    int nM, nN, nwg, G, c;
    __host__ __device__ void init(int M, int N, int G_, int c_) { nM = M / BM; nN = N / BM; nwg = nM * nN; G = G_; c = c_; }
    __host__ __device__ bool next(int i, Unit& u) const {
        const long L = (long)i * G + c; if (L >= nwg) return false;
        int wgid = (int)L; { const int q = nwg / NXCD, r = nwg % NXCD, xcd = wgid % NXCD, off = wgid / NXCD; wgid = (xcd < r ? xcd * (q + 1) : r * (q + 1) + (xcd - r) * q) + off; }
        const int nig = WGM * nN, gid = wgid / nig, fm = gid * WGM, gsz = (nM - fm) < WGM ? (nM - fm) : WGM;
        u.pm = fm + ((wgid % nig) % gsz); u.pn = (wgid % nig) / gsz; return true;
    }
    __device__ __forceinline__ void a_ready(const Unit&) const {}
    __device__ __forceinline__ void done(const Unit&) const {}
};

typedef float cvt_f32x2 __attribute__((ext_vector_type(2))); typedef __bf16 cvt_bf16x2 __attribute__((ext_vector_type(2)));
__device__ __forceinline__ unsigned cvt_pk_bf16(float lo, float hi) { cvt_f32x2 v = {lo, hi}; cvt_bf16x2 b = __builtin_convertvector(v, cvt_bf16x2); return __builtin_bit_cast(unsigned, b); }
__device__ __forceinline__ float sigm(float x) { return __builtin_amdgcn_rcpf(1.0f + __expf(-x)); }
__device__ __forceinline__ float bflo(unsigned w) { return __uint_as_float(w << 16); }
__device__ __forceinline__ float bfhi(unsigned w) { return __uint_as_float(w & 0xffff0000u); }
__device__ __forceinline__ u32x4 pack8(const f32x4& v0, const f32x4& v1) { u32x4 w; w.x = cvt_pk_bf16(v0[0], v0[1]); w.y = cvt_pk_bf16(v0[2], v0[3]); w.z = cvt_pk_bf16(v1[0], v1[1]); w.w = cvt_pk_bf16(v1[2], v1[3]); return w; }
struct EpiStore {
    static constexpr bool PERM = true, AFTER_DRAIN = false, ASWAP = false;
    bf16_t* O; int ldc;
    __device__ __forceinline__ void operator()(const f32x4 (&acc)[2][2][4][2], const Unit& u, int wr, int wc, int fr, int fq) const {
        const int row0 = u.pm * BM + wr * 64 + fr, col0 = u.pn * BM + wc * 32 + 8 * fq;
#pragma unroll
        for (int ai = 0; ai < 2; ++ai)
#pragma unroll
            for (int m = 0; m < 4; ++m) { bf16_t* rowp = O + (size_t)(row0 + ai * HALF + m * 16) * ldc + col0;
#pragma unroll
                for (int bj = 0; bj < 2; ++bj) *(u32x4*)(rowp + bj * HALF) = pack8(acc[ai][bj][m][0], acc[ai][bj][m][1]); }
    }
};
struct EpiIn {
    static constexpr bool PERM = true, AFTER_DRAIN = false, ASWAP = false;
    bf16_t* O; int ldc; const float* bgate; int gate_tile0;
    __device__ __forceinline__ void operator()(const f32x4 (&acc)[2][2][4][2], const Unit& u, int wr, int wc, int fr, int fq) const {
        const int row0 = u.pm * BM + wr * 64 + fr, col0 = u.pn * BM + wc * 32 + 8 * fq;
        if (u.pn >= gate_tile0) {
            const float* bp = bgate + (col0 - gate_tile0 * BM);
            f32x4 bv[2][2];
#pragma unroll
            for (int bj = 0; bj < 2; ++bj)
#pragma unroll
                for (int n = 0; n < 2; ++n) bv[bj][n] = *(const f32x4*)(bp + bj * HALF + 4 * n);
#pragma unroll
            for (int ai = 0; ai < 2; ++ai)
#pragma unroll
                for (int m = 0; m < 4; ++m) { bf16_t* rowp = O + (size_t)(row0 + ai * HALF + m * 16) * ldc + col0;
#pragma unroll
                    for (int bj = 0; bj < 2; ++bj) { f32x4 v0 = acc[ai][bj][m][0] + bv[bj][0], v1 = acc[ai][bj][m][1] + bv[bj][1];
#pragma unroll
                        for (int j = 0; j < 4; ++j) { v0[j] = sigm(v0[j]); v1[j] = sigm(v1[j]); }
                        *(u32x4*)(rowp + bj * HALF) = pack8(v0, v1); } }
        } else {
#pragma unroll
            for (int ai = 0; ai < 2; ++ai)
#pragma unroll
                for (int m = 0; m < 4; ++m) { bf16_t* rowp = O + (size_t)(row0 + ai * HALF + m * 16) * ldc + col0;
#pragma unroll
                    for (int bj = 0; bj < 2; ++bj) *(u32x4*)(rowp + bj * HALF) = pack8(acc[ai][bj][m][0], acc[ai][bj][m][1]); }
        }
    }
};
struct EpiGlu {
    static constexpr bool PERM = true, AFTER_DRAIN = false, ASWAP = false;
    const bf16_t* G; bf16_t* O; int ldc; const float* bias;
    __device__ __forceinline__ void operator()(const f32x4 (&acc)[2][2][4][2], const Unit& u, int wr, int wc, int fr, int fq) const {
        const int row0 = u.pm * BM + wr * 64 + fr, col0 = u.pn * BM + wc * 32 + 8 * fq;
        f32x4 bv[2][2];
#pragma unroll
        for (int bj = 0; bj < 2; ++bj)
#pragma unroll
            for (int n = 0; n < 2; ++n) bv[bj][n] = *(const f32x4*)(bias + col0 + bj * HALF + 4 * n);
#pragma unroll
        for (int ai = 0; ai < 2; ++ai) {
            u32x4 gw[4][2];
#pragma unroll
            for (int m = 0; m < 4; ++m)
#pragma unroll
                for (int bj = 0; bj < 2; ++bj) gw[m][bj] = *(const u32x4*)(G + (size_t)(row0 + ai * HALF + m * 16) * ldc + col0 + bj * HALF);
#pragma unroll
            for (int m = 0; m < 4; ++m) { const size_t off = (size_t)(row0 + ai * HALF + m * 16) * ldc + col0;
#pragma unroll
                for (int bj = 0; bj < 2; ++bj) { const u32x4 g4 = gw[m][bj];
                    f32x4 v0 = acc[ai][bj][m][0] + bv[bj][0], v1 = acc[ai][bj][m][1] + bv[bj][1];
                    v0[0] = bflo(g4.x) * sigm(v0[0]); v0[1] = bfhi(g4.x) * sigm(v0[1]); v0[2] = bflo(g4.y) * sigm(v0[2]); v0[3] = bfhi(g4.y) * sigm(v0[3]);
                    v1[0] = bflo(g4.z) * sigm(v1[0]); v1[1] = bfhi(g4.z) * sigm(v1[1]); v1[2] = bflo(g4.w) * sigm(v1[2]); v1[3] = bfhi(g4.w) * sigm(v1[3]);
                    *(u32x4*)(O + off + bj * HALF) = pack8(v0, v1); } }
        }
    }
};
struct EpiBr {
    static constexpr bool PERM = true, AFTER_DRAIN = false, ASWAP = false;
    const bf16_t* gates; int ldg; bf16_t* Mg; bf16_t* Mg2; int ldm;
    __device__ __forceinline__ void operator()(const f32x4 (&acc)[2][2][4][2], const Unit& u, int wr, int wc, int fr, int fq) const {
        const int br = u.pm >> 6, pm = u.pm & 63, pn = u.pn & 7;
        const int row0 = pm * BM + wr * 64 + fr, col0 = pn * BM + wc * 32 + 8 * fq;
        bf16_t* dst = (br == 2) ? Mg2 : Mg;
#pragma unroll
        for (int ai = 0; ai < 2; ++ai)
#pragma unroll
            for (int mp = 0; mp < 2; ++mp) {
                u32x4 gw[2][2], ow[2][2], pw[2][2];
#pragma unroll
                for (int mm = 0; mm < 2; ++mm)
#pragma unroll
                    for (int bj = 0; bj < 2; ++bj) { const int row = row0 + ai * HALF + (2 * mp + mm) * 16;
                        gw[mm][bj] = *(const u32x4*)(gates + (size_t)row * ldg + br * ldm + col0 + bj * HALF);
                        if (br == 0) { ow[mm][bj] = *(const u32x4*)(Mg + (size_t)row * ldm + col0 + bj * HALF); pw[mm][bj] = *(const u32x4*)(Mg2 + (size_t)row * ldm + col0 + bj * HALF); } }
#pragma unroll
                for (int mm = 0; mm < 2; ++mm)
#pragma unroll
                    for (int bj = 0; bj < 2; ++bj) { const int m = 2 * mp + mm; const int row = row0 + ai * HALF + m * 16; const u32x4 g4 = gw[mm][bj];
                        f32x4 v0 = acc[ai][bj][m][0], v1 = acc[ai][bj][m][1];
                        v0[0] *= bflo(g4.x); v0[1] *= bfhi(g4.x); v0[2] *= bflo(g4.y); v0[3] *= bfhi(g4.y); v1[0] *= bflo(g4.z); v1[1] *= bfhi(g4.z); v1[2] *= bflo(g4.w); v1[3] *= bfhi(g4.w);
                        if (br == 0) { const u32x4 o4 = ow[mm][bj], p4 = pw[mm][bj];
                            v0[0] += bflo(o4.x) + bflo(p4.x); v0[1] += bfhi(o4.x) + bfhi(p4.x); v0[2] += bflo(o4.y) + bflo(p4.y); v0[3] += bfhi(o4.y) + bfhi(p4.y);
                            v1[0] += bflo(o4.z) + bflo(p4.z); v1[1] += bfhi(o4.z) + bfhi(p4.z); v1[2] += bflo(o4.w) + bflo(p4.w); v1[3] += bfhi(o4.w) + bfhi(p4.w); }
                        *(u32x4*)(dst + (size_t)row * ldm + col0 + bj * HALF) = pack8(v0, v1); }
            }
    }
};
typedef float f32x2 __attribute__((ext_vector_type(2))); typedef unsigned u32x2 __attribute__((ext_vector_type(2)));
__device__ __forceinline__ unsigned dpp_shr1(unsigned old, unsigned v) { return (unsigned)__builtin_amdgcn_update_dpp((int)old, (int)v, 0x111, 0xF, 0xF, false); }
__device__ __forceinline__ unsigned dpp_shr2(unsigned old, unsigned v) { return (unsigned)__builtin_amdgcn_update_dpp((int)old, (int)v, 0x112, 0xF, 0xF, false); }
__device__ __forceinline__ unsigned dpp_ror1(unsigned v) { return (unsigned)__builtin_amdgcn_update_dpp(0, (int)v, 0x121, 0xF, 0xF, true); }
__device__ __forceinline__ unsigned dpp_ror2(unsigned v) { return (unsigned)__builtin_amdgcn_update_dpp(0, (int)v, 0x122, 0xF, 0xF, true); }
struct EpiUpAct {
    static constexpr bool PERM = true, AFTER_DRAIN = false, ASWAP = true;
    bf16_t* ACT; int dff; const float* cw; bf16_t* halo;
    __device__ __forceinline__ void operator()(const f32x4 (&acc)[2][2][4][2], const Unit& u, int wr_, int wc_, int fr_, int fq_) const {
        int tl = threadIdx.x; asm volatile("" : "+v"(tl));
        const int lane = tl & 63, wid = tl >> 6, wr = wid >> 2, wc = wid & 3, fr = lane & 15, fq = lane >> 4; (void)wr_; (void)wc_; (void)fr_; (void)fq_;
        const int nup = 2 * dff, j0 = u.pn * 128 + wc * 32 + 8 * fq;
        const int tok0 = u.pm * BM + wr * 128;
        unsigned pk[8][2][2][2];
#pragma unroll
        for (int q = 0; q < 8; ++q)
#pragma unroll
            for (int bj = 0; bj < 2; ++bj)
#pragma unroll
                for (int n = 0; n < 2; ++n) { const f32x4 v = acc[q >> 2][bj][q & 3][n]; pk[q][bj][n][0] = cvt_pk_bf16(v[0], v[1]); pk[q][bj][n][1] = cvt_pk_bf16(v[2], v[3]); }
        __builtin_amdgcn_sched_barrier(0);
        { const int blk = tok0 >> 7;
          if (fr < 2) {
#pragma unroll
              for (int bj = 0; bj < 2; ++bj) *(u32x4*)(halo + ((size_t)blk * 4 + fr) * nup + bj * dff + j0) = (u32x4){pk[0][bj][0][0], pk[0][bj][0][1], pk[0][bj][1][0], pk[0][bj][1][1]}; }
          if (fr >= 14) {
#pragma unroll
              for (int bj = 0; bj < 2; ++bj) *(u32x4*)(halo + ((size_t)blk * 4 + fr - 12) * nup + bj * dff + j0) = (u32x4){pk[7][bj][0][0], pk[7][bj][0][1], pk[7][bj][1][0], pk[7][bj][1][1]}; } }
        __builtin_amdgcn_sched_barrier(0);
        unsigned op[8][2][2];
#pragma unroll
        for (int n = 0; n < 2; ++n)
#pragma unroll
            for (int h = 0; h < 2; ++h) {
                f32x2 wa[3], wb[3];
                { int wo = j0 + 4 * n + 2 * h; asm volatile("" : "+v"(wo));
#pragma unroll
                  for (int k = 0; k < 3; ++k) { wa[k] = *(const __attribute__((address_space(1))) f32x2*)(cw + wo + k * nup); wb[k] = *(const __attribute__((address_space(1))) f32x2*)(cw + wo + k * nup + dff); } }
                unsigned ra1 = 0u, ra2 = 0u, rb1 = 0u, rb2 = 0u;
#pragma unroll
                for (int q = 0; q < 8; ++q) { unsigned a = pk[q][0][n][h], b = pk[q][1][n][h];
                    if (q > 0) asm volatile("" : "+v"(a), "+v"(b), "+v"(op[q - 1][n][h])); else asm volatile("" : "+v"(a), "+v"(b));
                    const unsigned pa1 = dpp_shr1(ra1, a), pa2 = dpp_shr2(ra2, a), pb1 = dpp_shr1(rb1, b), pb2 = dpp_shr2(rb2, b);
                    if (q < 7) { ra1 = dpp_ror1(a); ra2 = dpp_ror2(a); rb1 = dpp_ror1(b); rb2 = dpp_ror2(b); }
                    const float ca0 = wa[0][0] * bflo(a) + wa[1][0] * bflo(pa1) + wa[2][0] * bflo(pa2), ca1 = wa[0][1] * bfhi(a) + wa[1][1] * bfhi(pa1) + wa[2][1] * bfhi(pa2);
                    const float cb0 = wb[0][0] * bflo(b) + wb[1][0] * bflo(pb1) + wb[2][0] * bflo(pb2), cb1 = wb[0][1] * bfhi(b) + wb[1][1] * bfhi(pb1) + wb[2][1] * bfhi(pb2);
                    op[q][n][h] = cvt_pk_bf16(ca0 * sigm(ca0) * cb0, ca1 * sigm(ca1) * cb1);
                    __builtin_amdgcn_sched_barrier(0); }
            }
        size_t ao = (size_t)(tok0 + fr) * dff + j0;
#pragma unroll
        for (int q = 0; q < 8; ++q) { asm volatile("" : "+v"(ao));
            if (q > 0 || fr >= 2) *(__attribute__((address_space(1))) u32x4*)(ACT + ao) = (u32x4){op[q][0][0], op[q][0][1], op[q][1][0], op[q][1][1]};
            ao += (size_t)16 * dff; }
    }
};
struct BrPairOrder {
    StaticOrder so;
    __host__ __device__ void init(int M, int N, int G_, int c_) { so.init(M, N, G_, c_); }
    __host__ __device__ bool next(int i, Unit& u) const { Unit t; if (!so.next(i >> 1, t)) return false; const int br = 1 + (i & 1); u.pm = t.pm + 64 * br; u.pn = t.pn + 8 * br; return true; }
    __device__ __forceinline__ void a_ready(const Unit&) const {}
    __device__ __forceinline__ void done(const Unit&) const {}
};
template <class Epi, class Sched, bool ALIGN_EPI = false, bool SP2 = false>
__device__ __forceinline__ void gemm_phase(PG8_LAS unsigned char* lds, const Gemm g, const Sched& S, const Epi& E) {
    int tid = threadIdx.x; asm volatile("" : "+v"(tid)); const int wid = __builtin_amdgcn_readfirstlane(tid >> 6), lane = tid & 63, wr = wid >> 2, wc = wid & 3, fr = lane & 15, fq = lane >> 4;
    const int K = g.K, nt = K / BK;
    unsigned voffA[2], voffB[2];
#pragma unroll
    for (int i = 0; i < 2; ++i) { int R, C; stage_rc(tid * 16 + i * 8192, R, C); const int Rb = Epi::PERM ? ((R & ~31) + perm32(R & 31)) : R;
        const int Ra = Epi::ASWAP ? ((R >> 6) * 128 + (R & 63)) : R;
        voffA[i] = (unsigned)(Ra * K + C) * 2u; voffB[i] = (unsigned)(Rb * K + C) * 2u; }
    const size_t kstep = (size_t)(BK * 2);
    const size_t hstep = (size_t)HALF * K * 2;
    const size_t hstepA = Epi::ASWAP ? (size_t)64 * K * 2 : hstep;
    const size_t tstep = 2 * hstep;
    const unsigned ldsw = (unsigned)wid * 1024u;
    const int aoff = lds_byte(wr * 64 + fr, fq * 8), boff = lds_byte(wc * 32 + fr, fq * 8);
#define PG8_SA(b, h) (((b) * 2 + (h)) * HTB)
#define PG8_SB(b, h) ((4 + (b) * 2 + (h)) * HTB)
#define PG8_STAGE(bufoff, gbase, voff) do { _Pragma("unroll") for (int _i = 0; _i < 2; ++_i) \
        __builtin_amdgcn_global_load_lds((const unsigned*)((const char*)(gbase) + (voff)[_i]), (PG8_LAS unsigned*)(lds + (bufoff) + ldsw + _i * 8192), 16, 0, 0); } while (0)
#define PG8_LDA(dst, b, h) do { _Pragma("unroll") for (int m = 0; m < 4; ++m) _Pragma("unroll") for (int k = 0; k < 2; ++k) dst[m][k] = *(const PG8_LAS bf16x8*)(lds + PG8_SA(b, h) + aoff + m * 2048 + k * 1024); } while (0)
#define PG8_LDB(dst, b, h) do { _Pragma("unroll") for (int n = 0; n < 2; ++n) _Pragma("unroll") for (int k = 0; k < 2; ++k) dst[n][k] = *(const PG8_LAS bf16x8*)(lds + PG8_SB(b, h) + boff + n * 2048 + k * 1024); } while (0)
#define PG8_MMA(ai, bj, At, Bt) do { __builtin_amdgcn_s_setprio(1); _Pragma("unroll") for (int m = 0; m < 4; ++m) _Pragma("unroll") for (int n = 0; n < 2; ++n) _Pragma("unroll") for (int k = 0; k < 2; ++k) \
        acc[ai][bj][m][n] = __builtin_amdgcn_mfma_f32_16x16x32_bf16(Bt[n][k], At[m][k], acc[ai][bj][m][n], 0, 0, 0); __builtin_amdgcn_s_setprio(0); } while (0)
#define PG8_WAIT_V(n) asm volatile("s_waitcnt vmcnt(" #n ")" ::: "memory")
#define PG8_WAIT_L(n) asm volatile("s_waitcnt lgkmcnt(" #n ")" ::: "memory")
#define PG8_BAR __builtin_amdgcn_s_barrier()
#define PG8_SCHED __builtin_amdgcn_sched_barrier(0)
    Unit cur, nxt; int ui = 0;
    if (!S.next(0, cur)) return;
    f32x4 acc[2][2][4][2];
#pragma unroll
    for (int a = 0; a < 2; ++a)
#pragma unroll
        for (int b = 0; b < 2; ++b)
#pragma unroll
            for (int m = 0; m < 4; ++m)
#pragma unroll
                for (int n = 0; n < 2; ++n) acc[a][b][m][n] = (f32x4){0.f, 0.f, 0.f, 0.f};
    bf16x8 At[4][2], B0[2][2], B1[2][2];
    const char* cA = (const char*)g.A + (size_t)cur.pm * tstep; const char* cB = (const char*)g.Bt + (size_t)cur.pn * tstep;
    S.a_ready(cur);
    if constexpr (SP2) {
        PG8_STAGE(PG8_SB(0, 0), cB, voffB); PG8_STAGE(PG8_SB(0, 1), cB + hstep, voffB); PG8_STAGE(PG8_SA(0, 0), cA, voffA); PG8_STAGE(PG8_SA(0, 1), cA + hstepA, voffA);
        if (wr == 1) PG8_BAR;
        PG8_WAIT_V(2); PG8_BAR;
        PG8_STAGE(PG8_SB(1, 0), cB + kstep, voffB); PG8_STAGE(PG8_SA(1, 0), cA + kstep, voffA); PG8_STAGE(PG8_SB(1, 1), cB + hstep + kstep, voffB);
        PG8_WAIT_V(6); PG8_BAR;
    } else {
        PG8_STAGE(PG8_SB(0, 0), cB, voffB); PG8_STAGE(PG8_SA(0, 0), cA, voffA); PG8_STAGE(PG8_SB(0, 1), cB + hstep, voffB); PG8_STAGE(PG8_SA(0, 1), cA + hstepA, voffA);
        if (wr == 1) PG8_BAR;
        PG8_WAIT_V(4); PG8_BAR;
        PG8_STAGE(PG8_SB(1, 0), cB + kstep, voffB); PG8_STAGE(PG8_SA(1, 0), cA + kstep, voffA); PG8_STAGE(PG8_SB(1, 1), cB + hstep + kstep, voffB);
        PG8_WAIT_V(6); PG8_BAR;
    }
    for (;;) {
        const bool has_next = S.next(ui + 1, nxt);
        const char* nA = has_next ? (const char*)g.A + (size_t)nxt.pm * tstep : cA; const char* nB = has_next ? (const char*)g.Bt + (size_t)nxt.pn * tstep : cB;
        for (int t = 0; t < nt; t += 2) {
            const bool last = (t == nt - 2);
            const char* a1 = cA + (size_t)(t + 1) * kstep;
            const char* a2 = last ? nA : cA + (size_t)(t + 2) * kstep; const char* b2 = last ? nB : cB + (size_t)(t + 2) * kstep;
            const char* a3 = a2 + kstep; const char* b3 = b2 + kstep;
            if (last && has_next) S.a_ready(nxt);
            if constexpr (SP2) {
            PG8_LDB(B0, 0, 0); PG8_LDB(B1, 0, 1); PG8_SCHED; PG8_LDA(At, 0, 0); PG8_STAGE(PG8_SA(1, 1), a1 + hstepA, voffA);
            PG8_WAIT_V(8); PG8_WAIT_L(0); PG8_BAR; PG8_MMA(0, 0, At, B0); PG8_MMA(0, 1, At, B1); PG8_BAR; PG8_SCHED;
            PG8_LDA(At, 0, 1); PG8_STAGE(PG8_SB(0, 0), b2, voffB); PG8_STAGE(PG8_SB(0, 1), b2 + hstep, voffB); PG8_STAGE(PG8_SA(0, 0), a2, voffA);
            PG8_WAIT_V(8); PG8_WAIT_L(0); PG8_BAR; PG8_MMA(1, 0, At, B0); PG8_MMA(1, 1, At, B1); PG8_BAR; PG8_SCHED;
            PG8_LDB(B0, 1, 0); PG8_LDB(B1, 1, 1); PG8_SCHED; PG8_LDA(At, 1, 0); PG8_STAGE(PG8_SA(0, 1), a2 + hstepA, voffA);
            PG8_WAIT_V(8); PG8_WAIT_L(0); PG8_BAR; PG8_MMA(0, 0, At, B0); PG8_MMA(0, 1, At, B1); PG8_BAR; PG8_SCHED;
            PG8_LDA(At, 1, 1); PG8_STAGE(PG8_SB(1, 0), b3, voffB); PG8_STAGE(PG8_SB(1, 1), b3 + hstep, voffB); PG8_STAGE(PG8_SA(1, 0), a3, voffA);
            PG8_WAIT_V(8); PG8_WAIT_L(0); PG8_BAR; PG8_MMA(1, 0, At, B0); PG8_MMA(1, 1, At, B1); PG8_BAR; PG8_SCHED;
            } else {
            PG8_LDB(B0, 0, 0); PG8_SCHED; PG8_LDA(At, 0, 0); PG8_STAGE(PG8_SA(1, 1), a1 + hstepA, voffA);
            PG8_WAIT_L(8); PG8_BAR; PG8_WAIT_L(0); PG8_MMA(0, 0, At, B0); PG8_BAR; PG8_SCHED;
            PG8_LDB(B1, 0, 1); PG8_STAGE(PG8_SB(0, 0), b2, voffB);
            PG8_BAR; PG8_WAIT_L(0); PG8_MMA(0, 1, At, B1); PG8_BAR;
            PG8_LDA(At, 0, 1); PG8_STAGE(PG8_SA(0, 0), a2, voffA);
            PG8_BAR; PG8_WAIT_L(0); PG8_MMA(1, 0, At, B0); PG8_BAR; PG8_SCHED;
            PG8_STAGE(PG8_SB(0, 1), b2 + hstep, voffB);
            PG8_WAIT_V(6); PG8_BAR; PG8_MMA(1, 1, At, B1); PG8_BAR;
            PG8_LDB(B0, 1, 0); PG8_SCHED; PG8_LDA(At, 1, 0); PG8_STAGE(PG8_SA(0, 1), a2 + hstepA, voffA);
            PG8_WAIT_L(8); PG8_BAR; PG8_WAIT_L(0); PG8_MMA(0, 0, At, B0); PG8_BAR; PG8_SCHED;
            PG8_LDB(B1, 1, 1); PG8_STAGE(PG8_SB(1, 0), b3, voffB);
            PG8_BAR; PG8_WAIT_L(0); PG8_MMA(0, 1, At, B1); PG8_BAR;
            PG8_LDA(At, 1, 1); PG8_STAGE(PG8_SA(1, 0), a3, voffA);
            PG8_BAR; PG8_WAIT_L(0); PG8_MMA(1, 0, At, B0); PG8_BAR; PG8_SCHED;
            PG8_STAGE(PG8_SB(1, 1), b3 + hstep, voffB);
            PG8_WAIT_V(6); PG8_BAR; PG8_MMA(1, 1, At, B1); PG8_BAR;
            }
        }
        if constexpr (ALIGN_EPI) { if (wr == 0) PG8_BAR; }
        if constexpr (!Epi::AFTER_DRAIN) { E(acc, cur, wr, wc, fr, fq); S.done(cur); }
        if (!has_next) break;
#pragma unroll
        for (int a = 0; a < 2; ++a)
#pragma unroll
            for (int b = 0; b < 2; ++b)
#pragma unroll
                for (int m = 0; m < 4; ++m)
#pragma unroll
                    for (int n = 0; n < 2; ++n) acc[a][b][m][n] = (f32x4){0.f, 0.f, 0.f, 0.f};
        cur = nxt; cA = nA; cB = nB; ++ui;
        if constexpr (ALIGN_EPI) { if (wr == 1) PG8_BAR; }
    }
    PG8_WAIT_V(0);
    if constexpr (!ALIGN_EPI) { if (wr == 0) PG8_BAR; }
    PG8_BAR;
    if constexpr (Epi::AFTER_DRAIN) { E.fused(acc, cur, wr, wc, fr, fq, lds, wid, lane); S.done(cur); }
#undef PG8_SA
#undef PG8_SB
#undef PG8_STAGE
#undef PG8_LDA
#undef PG8_LDB
#undef PG8_MMA
#undef PG8_WAIT_V
#undef PG8_WAIT_L
#undef PG8_BAR
#undef PG8_SCHED
}
}
constexpr int NWAVES = 8;
constexpr int DM = 2048, BATCH = 8, SEQ = 2048, DEPTH = 4, M = BATCH * SEQ;
constexpr int SSMW = 512, NGRP = 32, NST = 64, HD = 64;
constexpr int OFF_Q = 512, OFF_K = 2048, OFF_V = 3584, OFF_CB = 5120, OFF_CC = 5632, OFF_CH = 6144, OFF_GATE = 6656, N_IN = 12800;
constexpr int DFF = 5632, NUP = 2 * DFF;
constexpr int NMOD = 6 * DM;
constexpr float RMS_EPS = 1e-6f;
enum { I_X = 0, I_C, I_WMOD, I_BMOD, I_GPRE_MIX, I_GPOST_MIX, I_GPRE_FFN, I_GPOST_FFN, I_WIN, I_LOGDT, I_ARE, I_AIM, I_BRE, I_BIM, I_CRE, I_CIM, I_SSMD, I_WGLU, I_BGLU,
       I_CONVW, I_WSSM, I_WATT, I_WCNV, I_BGATE, I_WO, I_WUP, I_FCONVW, I_WDOWN, N_INPUTS };
constexpr size_t MiB = 1u << 20;
constexpr size_t WS_CTL = 0, CTL_ZERO_BYTES = 1 * MiB;
constexpr size_t WS_MOD = 1 * MiB;
constexpr size_t WS_W = 4 * MiB;
constexpr size_t WB_IN = 0, WB_GLU = WB_IN + (size_t)N_IN * DM * 2, WB_BR = WB_GLU + (size_t)SSMW * SSMW * 2, WB_O = WB_BR + (size_t)3 * DM * SSMW * 2,
                 WB_UP = WB_O + (size_t)DM * DM * 2, WB_DN = WB_UP + (size_t)NUP * DM * 2, WB_LAYER = WB_DN + (size_t)DM * DFF * 2;
static_assert(WB_LAYER == (size_t)(50 * MiB + MiB / 2 + 6 * MiB + 8 * MiB + 44 * MiB + 22 * MiB), "weights per layer");
constexpr size_t WS_H = 528 * MiB;
constexpr size_t WS_PROJ = 592 * MiB;
constexpr size_t WS_ACT = 992 * MiB;
constexpr size_t WS_G = 1168 * MiB;
constexpr size_t WS_A3 = 1184 * MiB;
constexpr size_t WS_MG = 1232 * MiB;
constexpr size_t WS_Y = 1296 * MiB;
constexpr size_t WS_END = 1360 * MiB;
static_assert(WS_W + DEPTH * WB_LAYER <= WS_H && WS_PROJ + (size_t)M * N_IN * 2 <= WS_ACT && WS_ACT + (size_t)M * DFF * 2 <= WS_G, "ws map");
constexpr int CW_BAR = 4096;
constexpr int RING_BYTES = 131072, MISC_OFF = 143360, LDS_BYTES = 147456;

#define GAS __attribute__((address_space(1)))
#define LAS __attribute__((address_space(3)))
typedef unsigned short bf16;
typedef unsigned v4u __attribute__((ext_vector_type(4)));
typedef unsigned v2u __attribute__((ext_vector_type(2)));
typedef float f32x4 __attribute__((ext_vector_type(4)));
typedef short bf16x8 __attribute__((ext_vector_type(8)));
typedef short s16x4 __attribute__((ext_vector_type(4)));
#define LDS_WAIT() asm volatile("s_waitcnt lgkmcnt(0)" ::: "memory")
#define VM_WAIT() asm volatile("s_waitcnt vmcnt(0)" ::: "memory")
__device__ __forceinline__ unsigned f2bf(float f) { unsigned u = __builtin_bit_cast(unsigned, f); return (u + 0x7fffu + ((u >> 16) & 1u)) >> 16; }
__device__ __forceinline__ unsigned pk2(float lo, float hi) { return pg8::cvt_pk_bf16(lo, hi); }
__device__ __forceinline__ float bflo(unsigned w) { return __uint_as_float(w << 16); }
__device__ __forceinline__ float bfhi(unsigned w) { return __uint_as_float(w & 0xffff0000u); }
__device__ __forceinline__ void unpack8(const v4u w, float (&f)[8]) { f[0] = bflo(w.x); f[1] = bfhi(w.x); f[2] = bflo(w.y); f[3] = bfhi(w.y); f[4] = bflo(w.z); f[5] = bfhi(w.z); f[6] = bflo(w.w); f[7] = bfhi(w.w); }
__device__ __forceinline__ v4u pack8f(const float (&f)[8]) { v4u w; w.x = pk2(f[0], f[1]); w.y = pk2(f[2], f[3]); w.z = pk2(f[4], f[5]); w.w = pk2(f[6], f[7]); return w; }
__device__ __forceinline__ float wave_sum(float v) {
#pragma unroll
    for (int o = 1; o < 64; o <<= 1) v += __shfl_xor(v, o);
    return v;
}
#define XB_TMO      128
#define XB_XCNT(j)  (256  + 64 * (j))
#define XB_XSUB(j)  (1280 + 64 * (j))
#define XB_XGEN(j)  (2304 + 64 * (j))
#define XB_TOP      3328
#define XB_TOPGEN   3392
#define XCD_BAR_WORDS 3456
#define XB_SPIN_CAP (1u << 18)

__device__ __forceinline__ unsigned xb_ld(unsigned* p)              { return __hip_atomic_load(p, __ATOMIC_RELAXED, __HIP_MEMORY_SCOPE_AGENT); }
__device__ __forceinline__ unsigned xb_add(unsigned* p, unsigned v) { return __hip_atomic_fetch_add(p, v, __ATOMIC_RELAXED, __HIP_MEMORY_SCOPE_AGENT); }
__device__ __forceinline__ unsigned xb_xcc_id() { return (unsigned)__builtin_amdgcn_s_getreg((3 << 11) | 20) & 0xFu; }
#define XB_SPIN(cond, bar) do { unsigned _sp = 0; while (cond) { __builtin_amdgcn_s_sleep(1); \
    if ((++_sp & 255u) == 0u) { if (xb_ld(&(bar)[XB_TMO])) break; if (_sp > XB_SPIN_CAP) { atomicAdd(&(bar)[XB_TMO], 1u); break; } } } } while (0)

struct XcdBarrier {
    unsigned* bar; unsigned x;
    volatile LAS unsigned* st;
};

__device__ __forceinline__ XcdBarrier xcd_barrier_post(unsigned* bar, volatile LAS unsigned* st) {
    XcdBarrier b; b.bar = bar; b.x = xb_xcc_id(); b.st = st;
    if (threadIdx.x == 0) (void)xb_add(&bar[XB_XCNT(b.x)], 1u);
    return b;
}
__device__ __forceinline__ void xcd_barrier_complete(unsigned* bar, unsigned x, unsigned& nloc, unsigned& nx) {
    const unsigned G = gridDim.x * gridDim.y * gridDim.z;
    unsigned sum, cnt, mine, sp = 0u;
    for (;;) {
        sum = 0u; cnt = 0u; mine = 0u;
#pragma unroll
        for (unsigned j = 0; j < 16; ++j) { const unsigned c = xb_ld(&bar[XB_XCNT(j)]); sum += c; cnt += (c > 0u) ? 1u : 0u; mine = (j == x) ? c : mine; }
        if (sum == G) break;
        __builtin_amdgcn_s_sleep(1);
        if ((++sp & 255u) == 0u) { if (xb_ld(&bar[XB_TMO])) break; if (sp > XB_SPIN_CAP) { atomicAdd(&bar[XB_TMO], 1u); break; } }
    }
    nloc = mine > 0u ? mine : 1u; nx = cnt > 0u ? cnt : 1u;
}

__device__ __forceinline__ void xcd_barrier(const XcdBarrier& b) {
    asm volatile("s_waitcnt vmcnt(0)" ::: "memory");
    __syncthreads();
    if (threadIdx.x == 0) {
        unsigned* bar = b.bar;
        __builtin_amdgcn_s_waitcnt(0);
        unsigned nloc = b.st[0], nx = b.st[1];
        if (nloc == 0u) { xcd_barrier_complete(bar, b.x, nloc, nx); b.st[0] = nloc; b.st[1] = nx; }
        const unsigned old = xb_add(&bar[XB_XSUB(b.x)], 1u);
        const unsigned gen = old / nloc;
        if (old + 1u == (gen + 1u) * nloc) {
            __builtin_amdgcn_fence(__ATOMIC_RELEASE, "agent");
            asm volatile("s_waitcnt vmcnt(0)" ::: "memory");
            const unsigned og = xb_add(&bar[XB_TOP], 1u);
            const unsigned tg = og / nx;
            if (og + 1u == (tg + 1u) * nx) xb_add(&bar[XB_TOPGEN], 1u);
            else XB_SPIN(xb_ld(&bar[XB_TOPGEN]) == tg, bar);
            __builtin_amdgcn_fence(__ATOMIC_ACQUIRE, "agent");
            xb_add(&bar[XB_XGEN(b.x)], 1u);
            asm volatile("s_waitcnt vmcnt(0)" ::: "memory");
        } else {
            XB_SPIN(xb_ld(&bar[XB_XGEN(b.x)]) == gen, bar);
            __builtin_amdgcn_fence(__ATOMIC_ACQUIRE, "agent");
            asm volatile("s_waitcnt vmcnt(0)" ::: "memory");
        }
    }
    __syncthreads();
}
__device__ __forceinline__ void p0_transpose_item(const float* W, int K, int N, bf16* WT, int row_off, LAS float* scr, int item, int lane) {
    const int nblk = N / 32, kb = item / nblk, nb = item % nblk, k0 = 64 * kb, n0 = 32 * nb;
#pragma unroll 8
    for (int i = 0; i < 32; ++i) { const int kk = 2 * i + (lane >> 5); scr[kk * 33 + (lane & 31)] = W[(size_t)(k0 + kk) * N + n0 + (lane & 31)]; }
    LDS_WAIT(); asm volatile("" ::: "memory");
    const int c = lane & 7;
#pragma unroll
    for (int j = 0; j < 4; ++j) { const int n = (lane >> 3) + 8 * j; const LAS float* s = scr + (8 * c) * 33 + n;
        v4u o; o.x = pk2(s[0 * 33], s[1 * 33]); o.y = pk2(s[2 * 33], s[3 * 33]); o.z = pk2(s[4 * 33], s[5 * 33]); o.w = pk2(s[6 * 33], s[7 * 33]);
        *(GAS v4u*)(WT + (size_t)(row_off + n0 + n) * K + k0 + 8 * c) = o; }
    LDS_WAIT(); asm volatile("" ::: "memory");
}
constexpr int TI_IN = (DM / 64) * (N_IN / 32), TI_GLU = (SSMW / 64) * (SSMW / 32), TI_BR = (SSMW / 64) * (DM / 32), TI_O = (DM / 64) * (DM / 32), TI_UP = (DM / 64) * (NUP / 32), TI_DN = (DFF / 64) * (DM / 32);
constexpr int TI_LAYER = TI_IN + TI_GLU + 3 * TI_BR + TI_O + TI_UP + TI_DN, TI_ALL = DEPTH * TI_LAYER;
__device__ __forceinline__ void p0_transpose_any(const float* const* in, unsigned char* ws, LAS float* scr, int it, int lane) {
    const int l = it / TI_LAYER; int r = it % TI_LAYER;
    unsigned char* wl = ws + WS_W + (size_t)l * WB_LAYER;
    if (r < TI_IN) { p0_transpose_item(in[I_WIN] + (size_t)l * DM * N_IN, DM, N_IN, (bf16*)(wl + WB_IN), 0, scr, r, lane); return; } r -= TI_IN;
    if (r < TI_GLU) { p0_transpose_item(in[I_WGLU] + (size_t)l * SSMW * SSMW, SSMW, SSMW, (bf16*)(wl + WB_GLU), 0, scr, r, lane); return; } r -= TI_GLU;
    if (r < TI_BR) { p0_transpose_item(in[I_WSSM] + (size_t)l * SSMW * DM, SSMW, DM, (bf16*)(wl + WB_BR), 0, scr, r, lane); return; } r -= TI_BR;
    if (r < TI_BR) { p0_transpose_item(in[I_WATT] + (size_t)l * SSMW * DM, SSMW, DM, (bf16*)(wl + WB_BR), DM, scr, r, lane); return; } r -= TI_BR;
    if (r < TI_BR) { p0_transpose_item(in[I_WCNV] + (size_t)l * SSMW * DM, SSMW, DM, (bf16*)(wl + WB_BR), 2 * DM, scr, r, lane); return; } r -= TI_BR;
    if (r < TI_O) { p0_transpose_item(in[I_WO] + (size_t)l * DM * DM, DM, DM, (bf16*)(wl + WB_O), 0, scr, r, lane); return; } r -= TI_O;
    if (r < TI_UP) { const int n0 = 32 * (r % (NUP / 32));
        const int d0 = (n0 < DFF) ? 256 * (n0 / 128) + (n0 % 128) : 256 * ((n0 - DFF) / 128) + 128 + ((n0 - DFF) % 128);
        p0_transpose_item(in[I_WUP] + (size_t)l * DM * NUP, DM, NUP, (bf16*)(wl + WB_UP), d0 - n0, scr, r, lane); return; } r -= TI_UP;
    p0_transpose_item(in[I_WDOWN] + (size_t)l * DFF * DM, DFF, DM, (bf16*)(wl + WB_DN), 0, scr, r, lane);
}
__device__ __forceinline__ void p0_mod_item(const float* const* in, float* mod, const LAS float* condL, int item, int lane) {
    const int l = item / (NMOD / 64), j = (item % (NMOD / 64)) * 64 + lane;
    const float* wp = in[I_WMOD] + (size_t)l * DM * NMOD + j;
    float acc[8];
#pragma unroll
    for (int b = 0; b < 8; ++b) acc[b] = 0.f;
#pragma unroll 8
    for (int k = 0; k < DM; ++k) { const float w = wp[(size_t)k * NMOD]; const f32x4 c0 = *(const LAS f32x4*)(condL + k * 8), c1 = *(const LAS f32x4*)(condL + k * 8 + 4);
        acc[0] += w * c0[0]; acc[1] += w * c0[1]; acc[2] += w * c0[2]; acc[3] += w * c0[3]; acc[4] += w * c1[0]; acc[5] += w * c1[1]; acc[6] += w * c1[2]; acc[7] += w * c1[3]; }
    const float bm = in[I_BMOD][l * NMOD + j];
#pragma unroll
    for (int b = 0; b < 8; ++b) mod[(size_t)(l * BATCH + b) * NMOD + j] = acc[b] + bm;
}
constexpr int MOD_ITEMS = DEPTH * (NMOD / 64);
__device__ __forceinline__ void p0_prologue(const float* const* in, unsigned char* ws, LAS unsigned char* lds, int tid, int wave, int lane, int vcu, int G) {
    LAS float* condL = (LAS float*)lds;
    LAS float* scr = (LAS float*)(lds + 65536 + wave * 8448);
    for (int idx = tid; idx < BATCH * DM; idx += NWAVES * 64) { const int b = idx & 7, k = idx >> 3; const float cv = in[I_C][b * DM + k]; condL[idx] = cv / (1.0f + __expf(-cv)); }
    __syncthreads();
    const int gw2 = wave * G + vcu, NGW = G * NWAVES;
    const int nmodw = MOD_ITEMS < NGW ? MOD_ITEMS : NGW;
    constexpr int TPM = 25;
    if (gw2 < nmodw) {
        for (int q = gw2; q < MOD_ITEMS; q += nmodw) p0_mod_item(in, (float*)(ws + WS_MOD), condL, q, lane);
        for (int it = gw2 * TPM; it < (gw2 + 1) * TPM && it < TI_ALL; ++it) p0_transpose_any(in, ws, scr, it, lane);
    }
    const int rest0 = nmodw * TPM < TI_ALL ? nmodw * TPM : TI_ALL;
    if (NGW > nmodw) { if (gw2 >= nmodw) for (int it = rest0 + (gw2 - nmodw); it < TI_ALL; it += NGW - nmodw) p0_transpose_any(in, ws, scr, it, lane); }
    else { for (int it = rest0 + gw2; it < TI_ALL; it += NGW) p0_transpose_any(in, ws, scr, it, lane); }
}

template <bool POST, bool PRE>
__device__ __forceinline__ void norm_rows(const float* xi, float* xo, const bf16* y, const float* gpost, const float* gt, const float* gpre, const float* sc, const float* sh, bf16* h, int gw, int NGW, int lane) {
    constexpr int RPW = 8;
    for (int m0 = gw * RPW; m0 < M; m0 += NGW * RPW) {
        const int b = m0 / SEQ;
        for (int m = m0; m < m0 + RPW; ++m) {
            float xv[4][8];
#pragma unroll
            for (int j = 0; j < 4; ++j) { const int col = 8 * (lane + 64 * j); const f32x4 a = *(const GAS f32x4*)(xi + (size_t)m * DM + col), c = *(const GAS f32x4*)(xi + (size_t)m * DM + col + 4);
                xv[j][0] = a[0]; xv[j][1] = a[1]; xv[j][2] = a[2]; xv[j][3] = a[3]; xv[j][4] = c[0]; xv[j][5] = c[1]; xv[j][6] = c[2]; xv[j][7] = c[3]; }
            if (POST) {
                float yv[4][8]; float ss = 0.f;
#pragma unroll
                for (int j = 0; j < 4; ++j) { const int col = 8 * (lane + 64 * j); const v4u w = *(const GAS v4u*)(y + (size_t)m * DM + col); unpack8(w, yv[j]);
#pragma unroll
                    for (int e = 0; e < 8; ++e) ss += yv[j][e] * yv[j][e]; }
                const float rs = rsqrtf(wave_sum(ss) * (1.0f / DM) + RMS_EPS);
#pragma unroll
                for (int j = 0; j < 4; ++j) { const int col = 8 * (lane + 64 * j);
                    const f32x4 g0 = *(const GAS f32x4*)(gpost + col), g1 = *(const GAS f32x4*)(gpost + col + 4), t0 = *(const GAS f32x4*)(gt + (size_t)b * NMOD + col), t1 = *(const GAS f32x4*)(gt + (size_t)b * NMOD + col + 4);
#pragma unroll
                    for (int e = 0; e < 4; ++e) { xv[j][e] += t0[e] * (yv[j][e] * rs * g0[e]); xv[j][e + 4] += t1[e] * (yv[j][e + 4] * rs * g1[e]); }
                    *(GAS f32x4*)(xo + (size_t)m * DM + col) = (f32x4){xv[j][0], xv[j][1], xv[j][2], xv[j][3]}; *(GAS f32x4*)(xo + (size_t)m * DM + col + 4) = (f32x4){xv[j][4], xv[j][5], xv[j][6], xv[j][7]}; }
            }
            if (PRE) {
                float ss = 0.f;
#pragma unroll
                for (int j = 0; j < 4; ++j)
#pragma unroll
                    for (int e = 0; e < 8; ++e) ss += xv[j][e] * xv[j][e];
                const float rs = rsqrtf(wave_sum(ss) * (1.0f / DM) + RMS_EPS);
#pragma unroll
                for (int j = 0; j < 4; ++j) { const int col = 8 * (lane + 64 * j); float o[8];
                    const f32x4 g0 = *(const GAS f32x4*)(gpre + col), g1 = *(const GAS f32x4*)(gpre + col + 4), s0 = *(const GAS f32x4*)(sc + (size_t)b * NMOD + col), s1 = *(const GAS f32x4*)(sc + (size_t)b * NMOD + col + 4),
                                h0 = *(const GAS f32x4*)(sh + (size_t)b * NMOD + col), h1 = *(const GAS f32x4*)(sh + (size_t)b * NMOD + col + 4);
#pragma unroll
                    for (int e = 0; e < 4; ++e) { o[e] = xv[j][e] * rs * g0[e] * (1.0f + s0[e]) + h0[e]; o[e + 4] = xv[j][e + 4] * rs * g1[e] * (1.0f + s1[e]) + h1[e]; }
                    *(GAS v4u*)(h + (size_t)m * DM + col) = pack8f(o); }
            }
        }
    }
}
__device__ __forceinline__ void ffn_fix_phase(const bf16* halo, bf16* act, const float* cw  , int gw, int NGW, int lane) {
    constexpr int NCH = DFF / 512, NBLK = M / 128;
    for (int it = gw; it < NCH * NBLK; it += NGW) {
        const int blk = it / NCH, ch = it % NCH, t0 = blk * 128, col = ch * 512 + lane * 8;
        float wa[3][8], wb[3][8];
#pragma unroll
        for (int k = 0; k < 3; ++k) { const f32x4 a0 = *(const GAS f32x4*)(cw + k * NUP + col), a1 = *(const GAS f32x4*)(cw + k * NUP + col + 4), b0 = *(const GAS f32x4*)(cw + k * NUP + DFF + col), b1 = *(const GAS f32x4*)(cw + k * NUP + DFF + col + 4);
#pragma unroll
            for (int e = 0; e < 4; ++e) { wa[k][e] = a0[e]; wa[k][e + 4] = a1[e]; wb[k][e] = b0[e]; wb[k][e + 4] = b1[e]; } }
        float am1[8], am2[8], bm1[8], bm2[8], a0[8], a1[8], b0[8], b1[8];
        if ((t0 % SEQ) == 0) {
#pragma unroll
            for (int e = 0; e < 8; ++e) { am1[e] = 0.f; am2[e] = 0.f; bm1[e] = 0.f; bm2[e] = 0.f; }
        } else { const bf16* hp = halo + (size_t)(blk - 1) * 4 * NUP;
            unpack8(*(const GAS v4u*)(hp + 3 * NUP + col), am1); unpack8(*(const GAS v4u*)(hp + 2 * NUP + col), am2);
            unpack8(*(const GAS v4u*)(hp + 3 * NUP + DFF + col), bm1); unpack8(*(const GAS v4u*)(hp + 2 * NUP + DFF + col), bm2); }
        { const bf16* hp = halo + (size_t)blk * 4 * NUP;
          unpack8(*(const GAS v4u*)(hp + col), a0); unpack8(*(const GAS v4u*)(hp + NUP + col), a1);
          unpack8(*(const GAS v4u*)(hp + DFF + col), b0); unpack8(*(const GAS v4u*)(hp + NUP + DFF + col), b1); }
        float o0[8], o1[8];
#pragma unroll
        for (int e = 0; e < 8; ++e) {
            const float ca0 = wa[0][e] * a0[e] + wa[1][e] * am1[e] + wa[2][e] * am2[e], cb0 = wb[0][e] * b0[e] + wb[1][e] * bm1[e] + wb[2][e] * bm2[e];
            const float ca1 = wa[0][e] * a1[e] + wa[1][e] * a0[e] + wa[2][e] * am1[e], cb1 = wb[0][e] * b1[e] + wb[1][e] * b0[e] + wb[2][e] * bm1[e];
            o0[e] = ca0 * __builtin_amdgcn_rcpf(1.0f + __expf(-ca0)) * cb0; o1[e] = ca1 * __builtin_amdgcn_rcpf(1.0f + __expf(-ca1)) * cb1; }
        *(GAS v4u*)(act + (size_t)t0 * DFF + col) = pack8f(o0); *(GAS v4u*)(act + (size_t)(t0 + 1) * DFF + col) = pack8f(o1);
    }
}
__device__ __forceinline__ void conv_mix_items(const bf16* proj, bf16* outc, const float* cw  , int first, int step, int lane) {
    for (int run = first; run < M / 64; run += step) {
        const int m0 = run * 64, col = lane * 8;
        float w[3][8];
#pragma unroll
        for (int k = 0; k < 3; ++k) { const f32x4 a0 = *(const GAS f32x4*)(cw + k * 512 + col), a1 = *(const GAS f32x4*)(cw + k * 512 + col + 4);
#pragma unroll
            for (int e = 0; e < 4; ++e) { w[k][e] = a0[e]; w[k][e + 4] = a1[e]; } }
        float z1[8], z2[8];
        if ((m0 % SEQ) == 0) {
#pragma unroll
            for (int e = 0; e < 8; ++e) { z1[e] = 0.f; z2[e] = 0.f; }
        } else {
            float p[8], q[8];
            unpack8(*(const GAS v4u*)(proj + (size_t)(m0 - 1) * N_IN + OFF_CC + col), p); unpack8(*(const GAS v4u*)(proj + (size_t)(m0 - 1) * N_IN + OFF_CH + col), q);
#pragma unroll
            for (int e = 0; e < 8; ++e) z1[e] = p[e] * q[e];
            unpack8(*(const GAS v4u*)(proj + (size_t)(m0 - 2) * N_IN + OFF_CC + col), p); unpack8(*(const GAS v4u*)(proj + (size_t)(m0 - 2) * N_IN + OFF_CH + col), q);
#pragma unroll
            for (int e = 0; e < 8; ++e) z2[e] = p[e] * q[e];
        }
#pragma unroll 4
        for (int t = 0; t < 64; ++t) {
            float p[8], q[8], bb[8], o[8];
            const bf16* rp = proj + (size_t)(m0 + t) * N_IN;
            unpack8(*(const GAS v4u*)(rp + OFF_CC + col), p); unpack8(*(const GAS v4u*)(rp + OFF_CH + col), q); unpack8(*(const GAS v4u*)(rp + OFF_CB + col), bb);
#pragma unroll
            for (int e = 0; e < 8; ++e) { const float z0 = p[e] * q[e]; o[e] = bb[e] * (w[0][e] * z0 + w[1][e] * z1[e] + w[2][e] * z2[e]); z2[e] = z1[e]; z1[e] = z0; }
            *(GAS v4u*)(outc + (size_t)(m0 + t) * 512 + col) = pack8f(o);
        }
    }
}
constexpr int SSM_UF = 0, SSM_HS = 32768, SSM_E = 32768 + 8 * 4608, SSM_LDS_END = SSM_E + 4096;
constexpr int ATT_VLDS = 81920;
static_assert(SSM_LDS_END <= ATT_VLDS && ATT_VLDS + 8 * 4608 <= RING_BYTES, "mixer LDS map");
__device__ __forceinline__ float gelu_tanh(float y) { const float z = 0.7978845608028654f * (y + 0.044715f * y * y * y); const float e = __expf(2.0f * z); const float th = 1.0f - 2.0f * __builtin_amdgcn_rcpf(1.0f + e); return 0.5f * y * (1.0f + th); }
__device__ __forceinline__ void ssm_stage_u(const bf16* proj, LAS float* Uf, int b, int g, int T0, int lane) {
#pragma unroll
    for (int i = 0; i < 2; ++i) { const int piece = lane + 64 * i, tt = piece >> 1, half = piece & 1;
        const v4u w = *(const GAS v4u*)(proj + (size_t)(b * SEQ + T0 + tt) * N_IN + g * 16 + half * 8); float f[8]; unpack8(w, f);
        *(LAS f32x4*)(Uf + tt * 16 + half * 8) = (f32x4){f[0], f[1], f[2], f[3]}; *(LAS f32x4*)(Uf + tt * 16 + half * 8 + 4) = (f32x4){f[4], f[5], f[6], f[7]}; }
    LDS_WAIT();
}
__device__ __forceinline__ void ssm_unit(const float* const* in, int l, int b, int g, const bf16* proj, bf16* gbuf, LAS unsigned char* lds, int wave, int lane) {
    const int n = lane, lg = l * NGRP + g, gn = lg * NST + n;
    const float dt = expf(in[I_LOGDT][lg]);
    const float ar = in[I_ARE][gn], ai = in[I_AIM][gn];
    const float mag = expf(ar * dt), ang = ai * dt;
    const float kq2 = rintf(ang * 0.15915494309189535f); float red = fmaf(-kq2, 6.2831854820251465f, ang); red = fmaf(-kq2, -1.7484555e-7f, red);
    const float lr = mag * cosf(red), li = mag * sinf(red);
    const float den = ar * ar + ai * ai, fre = ((lr - 1.0f) * ar + li * ai) / den, fim = (li * ar - (lr - 1.0f) * ai) / den;
    float bbr[16], bbi[16];
    { const float* bre = in[I_BRE] + (size_t)gn * 16; const float* bim = in[I_BIM] + (size_t)gn * 16;
#pragma unroll
      for (int q = 0; q < 4; ++q) { const f32x4 r4 = *(const GAS f32x4*)(bre + 4 * q), i4 = *(const GAS f32x4*)(bim + 4 * q);
#pragma unroll
          for (int e = 0; e < 4; ++e) { bbr[4 * q + e] = fre * r4[e] - fim * i4[e]; bbi[4 * q + e] = fre * i4[e] + fim * r4[e]; } } }
    const int cc = lane & 15, kq = lane >> 4;
    bf16x8 Cf[4];
#pragma unroll
    for (int kb = 0; kb < 4; ++kb) { const float* src = (kb < 2 ? in[I_CRE] : in[I_CIM]) + (size_t)(lg * 16 + cc) * NST + (kb & 1) * 32 + 8 * kq; const float sg = kb < 2 ? 1.0f : -1.0f;
        const f32x4 a = *(const GAS f32x4*)src, c4 = *(const GAS f32x4*)(src + 4);
        const unsigned w0 = pk2(sg * a[0], sg * a[1]), w1 = pk2(sg * a[2], sg * a[3]), w2 = pk2(sg * c4[0], sg * c4[1]), w3 = pk2(sg * c4[2], sg * c4[3]);
        Cf[kb] = __builtin_bit_cast(bf16x8, (v4u){w0, w1, w2, w3}); }
    const float dsk = in[I_SSMD][l * SSMW + g * 16 + cc];
    LAS float* Uf = (LAS float*)(lds + SSM_UF + wave * 4096);
    LAS bf16* Hs = (LAS bf16*)(lds + SSM_HS + wave * 4608);
    LAS float* E = (LAS float*)(lds + SSM_E);
    float hr = 0.f, hi = 0.f;
    for (int s = 0; s < 4; ++s) {
        ssm_stage_u(proj, Uf, b, g, 256 * wave + 64 * s, lane);
        for (int tt = 0; tt < 64; ++tt) {
            const f32x4 u0 = *(const LAS f32x4*)(Uf + tt * 16), u1 = *(const LAS f32x4*)(Uf + tt * 16 + 4), u2 = *(const LAS f32x4*)(Uf + tt * 16 + 8), u3 = *(const LAS f32x4*)(Uf + tt * 16 + 12);
            float xr = 0.f, xi = 0.f;
#pragma unroll
            for (int e = 0; e < 4; ++e) { xr += bbr[e] * u0[e]; xi += bbi[e] * u0[e]; xr += bbr[4 + e] * u1[e]; xi += bbi[4 + e] * u1[e]; xr += bbr[8 + e] * u2[e]; xi += bbi[8 + e] * u2[e]; xr += bbr[12 + e] * u3[e]; xi += bbi[12 + e] * u3[e]; }
            const float nr = lr * hr - li * hi + xr, ni = lr * hi + li * hr + xi; hr = nr; hi = ni;
        }
        asm volatile("" ::: "memory");
    }
    E[(wave * 64 + n) * 2] = hr; E[(wave * 64 + n) * 2 + 1] = hi;
    float pr = lr, pi = li;
#pragma unroll
    for (int q = 0; q < 8; ++q) { const float t = pr * pr - pi * pi; pi = 2.0f * pr * pi; pr = t; }
    __syncthreads();
    hr = 0.f; hi = 0.f;
    for (int j = 0; j < wave; ++j) { const float er = E[(j * 64 + n) * 2], ei = E[(j * 64 + n) * 2 + 1]; const float nr = pr * hr - pi * hi + er, ni = pr * hi + pi * hr + ei; hr = nr; hi = ni; }
    for (int s = 0; s < 4; ++s) {
        const int T0 = 256 * wave + 64 * s;
        ssm_stage_u(proj, Uf, b, g, T0, lane);
        for (int bt = 0; bt < 4; ++bt) {
#pragma unroll 4
            for (int t16 = 0; t16 < 16; ++t16) { const int tt = bt * 16 + t16;
                const f32x4 u0 = *(const LAS f32x4*)(Uf + tt * 16), u1 = *(const LAS f32x4*)(Uf + tt * 16 + 4), u2 = *(const LAS f32x4*)(Uf + tt * 16 + 8), u3 = *(const LAS f32x4*)(Uf + tt * 16 + 12);
                float xr = 0.f, xi = 0.f;
#pragma unroll
                for (int e = 0; e < 4; ++e) { xr += bbr[e] * u0[e]; xi += bbi[e] * u0[e]; xr += bbr[4 + e] * u1[e]; xi += bbi[4 + e] * u1[e]; xr += bbr[8 + e] * u2[e]; xi += bbi[8 + e] * u2[e]; xr += bbr[12 + e] * u3[e]; xi += bbi[12 + e] * u3[e]; }
                const float nr = lr * hr - li * hi + xr, ni = lr * hi + li * hr + xi; hr = nr; hi = ni;
                Hs[t16 * 136 + n] = (bf16)f2bf(hr); Hs[t16 * 136 + 64 + n] = (bf16)f2bf(hi); }
            LDS_WAIT();
            f32x4 Y = (f32x4){0.f, 0.f, 0.f, 0.f};
#pragma unroll
            for (int kb = 0; kb < 4; ++kb) { const bf16x8 a = *(const LAS bf16x8*)(Hs + cc * 136 + kb * 32 + kq * 8); Y = __builtin_amdgcn_mfma_f32_16x16x32_bf16(a, Cf[kb], Y, 0, 0, 0); }
#pragma unroll
            for (int i = 0; i < 4; ++i) { const int tt = bt * 16 + 4 * kq + i; const float uval = Uf[tt * 16 + cc]; const float yv = gelu_tanh(Y[i] + dsk * uval);
                gbuf[(size_t)(b * SEQ + T0 + tt) * SSMW + g * 16 + cc] = (bf16)f2bf(yv); }
            LDS_WAIT(); asm volatile("" ::: "memory");
        }
    }
}

__device__ __forceinline__ s16x4 vtr(const LAS unsigned char* p) { return __builtin_bit_cast(s16x4, __builtin_amdgcn_ds_read_tr16_b64_v4i16((LAS s16x4*)p)); }
__device__ __forceinline__ float xmax16(float v) { const unsigned u = __float_as_uint(v); auto r = __builtin_amdgcn_permlane16_swap(u, u, false, false); return fmaxf(__uint_as_float(r[0]), __uint_as_float(r[1])); }
__device__ __forceinline__ float xmax32(float v) { const unsigned u = __float_as_uint(v); auto r = __builtin_amdgcn_permlane32_swap(u, u, false, false); return fmaxf(__uint_as_float(r[0]), __uint_as_float(r[1])); }
__device__ __forceinline__ float xsum16(float v) { const unsigned u = __float_as_uint(v); auto r = __builtin_amdgcn_permlane16_swap(u, u, false, false); return __uint_as_float(r[0]) + __uint_as_float(r[1]); }
__device__ __forceinline__ float xsum32(float v) { const unsigned u = __float_as_uint(v); auto r = __builtin_amdgcn_permlane32_swap(u, u, false, false); return __uint_as_float(r[0]) + __uint_as_float(r[1]); }
struct AttnKV { bf16x8 k[2][2]; v4u v[4]; };
__device__ __forceinline__ void attn_load(AttnKV& t, const bf16* kbase, const bf16* vbase, int kt0, int rg, int sh, int lane) {
    const int col = lane & 15;
#pragma unroll
    for (int half = 0; half < 2; ++half) { int kp = kt0 + 16 * half + col; kp = kp < 0 ? 0 : kp; const bf16* kr = kbase + (size_t)(rg + (kp << sh)) * N_IN;
        t.k[half][0] = *(const GAS bf16x8*)kr; t.k[half][1] = *(const GAS bf16x8*)(kr + 32); }
#pragma unroll
    for (int i = 0; i < 4; ++i) { const int chunk = lane + 64 * i, row = chunk >> 3, c16 = chunk & 7; int kp = kt0 + row; kp = kp < 0 ? 0 : kp;
        t.v[i] = *(const GAS v4u*)(vbase + (size_t)(rg + (kp << sh)) * N_IN + c16 * 8); }
}
__device__ __forceinline__ void attn_tile(const bf16* proj, bf16* aout, LAS unsigned char* vlds, int b, int h, int r, int i0, int lane) {
    const int col = lane & 15, grp = lane >> 4;
    const size_t rowb = (size_t)b * SEQ;
    const int tq = r + 16 * (i0 + col);
    const bf16* qrow = proj + (rowb + tq) * N_IN + OFF_Q + h * 64 + grp * 8;
    bf16x8 Qf[3][2];
#pragma unroll
    for (int g = 0; g < 3; ++g)
#pragma unroll
        for (int dh = 0; dh < 2; ++dh) Qf[g][dh] = *(const GAS bf16x8*)(qrow + g * 512 + dh * 32);
    f32x4 acc[4];
#pragma unroll
    for (int d = 0; d < 4; ++d) acc[d] = (f32x4){0.f, 0.f, 0.f, 0.f};
    float mrun = -1e30f, lrun = 0.f;
    const float L2E = 1.4426950408889634f;
    const int tq4 = (lane & 15) >> 2, tp4 = lane & 3;
    const LAS unsigned char* vrd = vlds + (4 * grp + tq4) * 144 + tp4 * 8;
    LAS unsigned char* vwr = vlds + (lane >> 3) * 144 + (lane & 7) * 16;
#pragma unroll
    for (int g = 0; g < 3; ++g) {
        const int sh = 2 * g, dil = 1 << sh, rg = r & (dil - 1);
        const int qp = (tq - rg) >> sh;
        const int kstart = (g == 0) ? (16 * i0 - 128) : (g == 1 ? 4 * i0 - 128 : i0 - 144), ntile = (g == 0) ? 12 : (g == 1 ? 6 : 5);
        const float c_qk = 0.125f * L2E, c_b = exp2f(-(float)(g * 8 + h + 1) * (1.0f / 3.0f)) * (float)dil * L2E;
        const bf16* kbase = proj + rowb * N_IN + OFF_K + g * 512 + h * 64 + grp * 8;
        const bf16* vbase = proj + rowb * N_IN + OFF_V + g * 512 + h * 64;
        int ti = 0;
        while (kstart + 32 * ti + 32 <= 0) ++ti;
        AttnKV cur, nxt;
        attn_load(cur, kbase, vbase, kstart + 32 * ti, rg, sh, lane);
        for (; ti < ntile; ++ti) {
            const int kt0 = kstart + 32 * ti;
            if (ti + 1 < ntile) attn_load(nxt, kbase, vbase, kt0 + 32, rg, sh, lane);
            f32x4 S[2];
#pragma unroll
            for (int half = 0; half < 2; ++half) {
                S[half] = __builtin_amdgcn_mfma_f32_16x16x32_bf16(cur.k[half][0], Qf[g][0], (f32x4){0.f, 0.f, 0.f, 0.f}, 0, 0, 0);
                S[half] = __builtin_amdgcn_mfma_f32_16x16x32_bf16(cur.k[half][1], Qf[g][1], S[half], 0, 0, 0); }
#pragma unroll
            for (int i = 0; i < 4; ++i) *(LAS v4u*)(vwr + i * 8 * 144) = cur.v[i];
            float sc[8]; float mx = -1e30f;
#pragma unroll
            for (int half = 0; half < 2; ++half)
#pragma unroll
                for (int i = 0; i < 4; ++i) { const int kp = kt0 + 16 * half + 4 * grp + i, dist = qp - kp; const bool valid = (dist >= 0) && (dist <= 128) && (kp >= 0);
                    const float s = valid ? (S[half][i] * c_qk - c_b * (float)dist) : -1e30f; sc[half * 4 + i] = s; mx = fmaxf(mx, s); }
            mx = xmax32(xmax16(mx));
            const float mnew = fmaxf(mrun, mx), alpha = __builtin_amdgcn_exp2f(mrun - mnew);
            float p[8], psum = 0.f;
#pragma unroll
            for (int j = 0; j < 8; ++j) { p[j] = (sc[j] > -1e29f) ? __builtin_amdgcn_exp2f(sc[j] - mnew) : 0.f; psum += p[j]; }
            psum = xsum32(xsum16(psum));
            lrun = lrun * alpha + psum; mrun = mnew;
#pragma unroll
            for (int d = 0; d < 4; ++d) acc[d] = acc[d] * alpha;
            const bf16x8 Pf = __builtin_bit_cast(bf16x8, (v4u){pk2(p[0], p[1]), pk2(p[2], p[3]), pk2(p[4], p[5]), pk2(p[6], p[7])});
            LDS_WAIT();
#pragma unroll
            for (int d = 0; d < 4; ++d) { const s16x4 lo = vtr(vrd + d * 32), hi = vtr(vrd + 16 * 144 + d * 32);
                const bf16x8 Vf = (bf16x8){lo[0], lo[1], lo[2], lo[3], hi[0], hi[1], hi[2], hi[3]};
                acc[d] = __builtin_amdgcn_mfma_f32_16x16x32_bf16(Vf, Pf, acc[d], 0, 0, 0); }
            LDS_WAIT(); asm volatile("" ::: "memory");
            cur = nxt;
        }
    }
    const float inv = 1.0f / lrun;
    bf16* orow = aout + (rowb + tq) * SSMW + h * 64 + 4 * grp;
#pragma unroll
    for (int d = 0; d < 4; ++d) { v2u w; w.x = pk2(acc[d][0] * inv, acc[d][1] * inv); w.y = pk2(acc[d][2] * inv, acc[d][3] * inv); *(GAS v2u*)(orow + d * 16) = w; }
}
#ifndef UPACT_ALIGN
#define UPACT_ALIGN true
#endif
#ifndef MK_PER_PHASE
#define MK_PER_PHASE 0
#endif
__device__ __forceinline__ int launder(int v) { asm volatile("" : "+v"(v)); return v; }
#define PH_LOCALS const int tid = launder((int)threadIdx.x), lane = tid & 63, wave = __builtin_amdgcn_readfirstlane(tid >> 6), gw = vcu * NWAVES + wave; (void)tid; (void)lane; (void)wave; (void)gw;
constexpr int PH_PER_LAYER = 11, N_PHASES = 1 + DEPTH * PH_PER_LAYER;
struct Args { const float* in[N_INPUTS]; float* out; unsigned char* ws; int ph_lo, ph_hi; };
static_assert(sizeof(Args) == N_INPUTS * 8 + 8 + 8 + 8, "Args has no padding");
__global__ void __launch_bounds__(NWAVES * 64, 2) trunk_fwd(Args args) {
    extern __shared__ __attribute__((aligned(16))) unsigned char lds_raw[];
    LAS unsigned char* lds = (LAS unsigned char*)lds_raw;
    volatile LAS unsigned* MISC = (volatile LAS unsigned*)(lds + MISC_OFF);
    const int G = gridDim.x, bx = blockIdx.x, vcu = (G % 8 == 0) ? (bx % 8) * (G / 8) + bx / 8 : bx;
    const int NGW = G * NWAVES;
    unsigned char* ws = args.ws;
    const float* const* in = args.in;
    for (int u = threadIdx.x; u < (LDS_BYTES - MISC_OFF) / 4; u += NWAVES * 64) MISC[u] = 0u;
    __syncthreads();
    unsigned* barw = (unsigned*)(ws + WS_CTL) + CW_BAR;
    XcdBarrier bar; bar.bar = barw; bar.x = 0; bar.st = nullptr;
    if (!MK_PER_PHASE) bar = xcd_barrier_post(barw, MISC + 8);
    const int lo = args.ph_lo, hi = args.ph_hi;
#ifndef PH_MASK
#define PH_MASK 0xFFFF
#endif
#define EN(k) (((PH_MASK) >> (k)) & 1)
#ifndef REP_MASK
#define REP_MASK 0
#endif
#define NREP(k) (1 + (((REP_MASK) >> (k)) & 1))
#define PH_IN(id) (lo <= (id) && (id) < hi)
#define PH_SEAM(id) do { if ((id) + 1 < hi) { if (!MK_PER_PHASE) xcd_barrier(bar); } } while (0)
    float* mod = (float*)(ws + WS_MOD);
    bf16* Hb = (bf16*)(ws + WS_H); bf16* PJ = (bf16*)(ws + WS_PROJ); bf16* UP = (bf16*)(ws + WS_PROJ); bf16* ACT = (bf16*)(ws + WS_ACT);
    bf16* GB = (bf16*)(ws + WS_G); bf16* A3 = (bf16*)(ws + WS_A3); bf16* MG = (bf16*)(ws + WS_MG); bf16* YB = (bf16*)(ws + WS_Y);
    float* xout = args.out;

    if (EN(0) && PH_IN(0)) for (int rp = 0; rp < NREP(0); ++rp) { PH_LOCALS; p0_prologue(in, ws, lds, tid, wave, lane, vcu, G); PH_SEAM(0); }

    for (int l = 0; l < DEPTH; ++l) {
        const int pb = 1 + l * PH_PER_LAYER;
        const unsigned char* wl = ws + WS_W + (size_t)l * WB_LAYER;
        const float* modl = mod + (size_t)l * BATCH * NMOD;
        const float* xcur = (l == 0) ? in[I_X] : xout;
        if (l == 0 && PH_IN(pb + 0) && EN(1)) { PH_LOCALS;
            norm_rows<false, true>(in[I_X], nullptr, nullptr, nullptr, nullptr, in[I_GPRE_MIX] + l * DM, modl + DM, modl, Hb, gw, NGW, lane);
            PH_SEAM(pb + 0);
        }
        if (PH_IN(pb + 1) && EN(2)) for (int rp = 0; rp < NREP(2); ++rp) { PH_LOCALS;
            pg8::Gemm g{Hb, (const bf16*)(wl + WB_IN), M, N_IN, DM}; pg8::StaticOrder S; S.init(M, N_IN, G, bx);
            pg8::EpiIn E{PJ, N_IN, in[I_BGATE] + (size_t)l * 3 * DM, OFF_GATE / 256};
            pg8::gemm_phase<pg8::EpiIn, pg8::StaticOrder, true, true>(lds, g, S, E);
            PH_SEAM(pb + 1);
        }
        if (PH_IN(pb + 2) && EN(3)) { PH_LOCALS;
            for (int rep = 0; rep < NREP(12); ++rep)
            for (int uidx = vcu; uidx < BATCH * NGRP; uidx += G) { ssm_unit(in, l, uidx / NGRP, uidx % NGRP, PJ, GB, lds, wave, lane); __syncthreads(); }
            for (int rep = 0; rep < NREP(13); ++rep)
            { LAS unsigned char* vl = lds + ATT_VLDS + wave * 4608; int k = 0;
              for (int T = gw; T < BATCH * 8 * 16 * 8; T += NGW, ++k) { const int it = ((T & 7) + 2 * k) & 7, r = (T >> 3) & 15, bh = T >> 7;
                  attn_tile(PJ, A3 + (size_t)M * SSMW, vl, bh >> 3, bh & 7, r, 16 * it, lane); } }
            for (int rep = 0; rep < NREP(14); ++rep)
            conv_mix_items(PJ, A3 + (size_t)2 * M * SSMW, in[I_CONVW] + (size_t)l * 3 * SSMW, gw, NGW, lane);
            PH_SEAM(pb + 2);
        }
        if (PH_IN(pb + 3) && EN(4)) for (int rp = 0; rp < NREP(4); ++rp) { PH_LOCALS;
            { pg8::Gemm g{GB, (const bf16*)(wl + WB_GLU), M, SSMW, SSMW}; pg8::StaticOrder S; S.init(M, SSMW, G, bx);
              pg8::EpiGlu E{GB, A3, SSMW, in[I_BGLU] + (size_t)l * SSMW};
              pg8::gemm_phase<pg8::EpiGlu, pg8::StaticOrder, true, true>(lds, g, S, E); }
            { pg8::Gemm g{A3, (const bf16*)(wl + WB_BR), M, DM, SSMW}; pg8::BrPairOrder S; S.init(M, DM, G, bx);
              pg8::EpiBr E{PJ + OFF_GATE, N_IN, MG, YB, DM};
              pg8::gemm_phase<pg8::EpiBr, pg8::BrPairOrder, true, true>(lds, g, S, E); }
            PH_SEAM(pb + 3);
        }
        if (PH_IN(pb + 4) && EN(5)) { PH_LOCALS;
            pg8::Gemm g{A3, (const bf16*)(wl + WB_BR), M, DM, SSMW}; pg8::StaticOrder S; S.init(M, DM, G, bx);
            pg8::EpiBr E{PJ + OFF_GATE, N_IN, MG, YB, DM};
            pg8::gemm_phase<pg8::EpiBr, pg8::StaticOrder, true, true>(lds, g, S, E);
            PH_SEAM(pb + 4);
        }
        if (PH_IN(pb + 5) && EN(6)) for (int rp = 0; rp < NREP(6); ++rp) { PH_LOCALS;
            pg8::Gemm g{MG, (const bf16*)(wl + WB_O), M, DM, DM}; pg8::StaticOrder S; S.init(M, DM, G, bx);
            pg8::EpiStore E{YB, DM};
            pg8::gemm_phase<pg8::EpiStore, pg8::StaticOrder, true, true>(lds, g, S, E);
            PH_SEAM(pb + 5);
        }
        if (PH_IN(pb + 6) && EN(7)) { PH_LOCALS;
            norm_rows<true, true>(xcur, xout, YB, in[I_GPOST_MIX] + l * DM, modl + 2 * DM, in[I_GPRE_FFN] + l * DM, modl + 4 * DM, modl + 3 * DM, Hb, gw, NGW, lane);
            PH_SEAM(pb + 6);
        }
        if (PH_IN(pb + 7) && EN(8)) for (int rp = 0; rp < NREP(8); ++rp) { PH_LOCALS;
            pg8::Gemm g{Hb, (const bf16*)(wl + WB_UP), M, NUP, DM}; pg8::StaticOrder S; S.init(M, NUP, G, bx);
            pg8::EpiUpAct E{ACT, DFF, in[I_FCONVW] + (size_t)l * 3 * NUP, UP  };
            pg8::gemm_phase<pg8::EpiUpAct, pg8::StaticOrder, UPACT_ALIGN, true>(lds, g, S, E);
            PH_SEAM(pb + 7);
        }
        if (PH_IN(pb + 8) && EN(9)) for (int rp = 0; rp < NREP(9); ++rp) { PH_LOCALS; ffn_fix_phase(UP, ACT, in[I_FCONVW] + (size_t)l * 3 * NUP, gw, NGW, lane); PH_SEAM(pb + 8); }
        if (PH_IN(pb + 9) && EN(10)) for (int rp = 0; rp < NREP(10); ++rp) { PH_LOCALS;
            pg8::Gemm g{ACT, (const bf16*)(wl + WB_DN), M, DM, DFF}; pg8::StaticOrder S; S.init(M, DM, G, bx);
            pg8::EpiStore E{YB, DM};
            pg8::gemm_phase<pg8::EpiStore, pg8::StaticOrder, true, true>(lds, g, S, E);
            PH_SEAM(pb + 9);
        }
        if (PH_IN(pb + 10) && EN(11)) { PH_LOCALS;
            if (l + 1 < DEPTH) norm_rows<true, true>(xout, xout, YB, in[I_GPOST_FFN] + l * DM, modl + 5 * DM, in[I_GPRE_MIX] + (l + 1) * DM, modl + BATCH * NMOD + DM, modl + BATCH * NMOD, Hb, gw, NGW, lane);
            else norm_rows<true, false>(xout, xout, YB, in[I_GPOST_FFN] + l * DM, modl + 5 * DM, nullptr, nullptr, nullptr, nullptr, gw, NGW, lane);
            PH_SEAM(pb + 10);
        }
    }
#undef PH_IN
#undef PH_SEAM
}


#ifndef DBG_STOP
#define DBG_STOP -1
#endif
#ifndef DBG_BUF
#define DBG_BUF 0
#endif
__global__ void __launch_bounds__(256) dbg_dump(const bf16* src, int ld, int col0, int ncol, int outc0, float* out) {
    for (size_t i = (size_t)blockIdx.x * 256 + threadIdx.x; i < (size_t)M * ncol; i += (size_t)gridDim.x * 256) { const size_t m = i / ncol; const int c = (int)(i % ncol);
        out[m * DM + outc0 + c] = __uint_as_float(((unsigned)src[m * ld + col0 + c]) << 16); }
}
extern "C" void kernel_launch(void* const* d_in, const int* in_sizes, int n_in, void* d_out, int out_size, void* d_ws, size_t ws_size, hipStream_t stream) {
    static int grid = 0;
    if (grid == 0) {
        if (n_in != N_INPUTS || in_sizes[0] != M * DM || out_size != M * DM || ws_size < WS_END) { fprintf(stderr, "kernel_launch: unexpected shapes (n_in %d, in0 %d, out %d, ws %zu < %zu); nothing launched\n", n_in, n_in > 0 ? in_sizes[0] : -1, out_size, ws_size, (size_t)WS_END); grid = -1; return; }
        int dev = 0, cus = 0, per_cu = 0;
        if (hipGetDevice(&dev) != hipSuccess || hipDeviceGetAttribute(&cus, hipDeviceAttributeMultiprocessorCount, dev) != hipSuccess) { fprintf(stderr, "kernel_launch: device query failed\n"); grid = -1; return; }
        if (hipFuncSetAttribute((const void*)trunk_fwd, hipFuncAttributeMaxDynamicSharedMemorySize, LDS_BYTES) != hipSuccess) { fprintf(stderr, "kernel_launch: hipFuncSetAttribute failed\n"); grid = -1; return; }
        if (hipOccupancyMaxActiveBlocksPerMultiprocessor(&per_cu, (const void*)trunk_fwd, NWAVES * 64, LDS_BYTES) != hipSuccess || per_cu < 1) { fprintf(stderr, "kernel_launch: occupancy query reports %d blocks per CU\n", per_cu); }
        (void)hipGetLastError();
        grid = cus;
    }
    if (grid < 0) return;
    if (hipMemsetAsync((char*)d_ws + WS_CTL, 0, CTL_ZERO_BYTES, stream) != hipSuccess) { fprintf(stderr, "kernel_launch: memset failed\n"); return; }
    Args a{};
    for (int i = 0; i < N_INPUTS; ++i) a.in[i] = (const float*)d_in[i];
    a.out = (float*)d_out; a.ws = (unsigned char*)d_ws;
#if MK_PER_PHASE
    for (int p = 0; p < N_PHASES; ++p) {
        if (p > 0 && ((p - 1) % PH_PER_LAYER) == 0 && p != 1) continue;
        a.ph_lo = p; a.ph_hi = p + 1;
        hipLaunchKernelGGL(trunk_fwd, dim3(grid), dim3(NWAVES * 64), LDS_BYTES, stream, a);
        if (p == DBG_STOP) {
            unsigned char* w = (unsigned char*)d_ws; float* o = (float*)d_out;
            if (DBG_BUF == 0) hipLaunchKernelGGL(dbg_dump, dim3(2048), dim3(256), 0, stream, (const bf16*)(w + WS_H), DM, 0, DM, 0, o);
            if (DBG_BUF == 1) hipLaunchKernelGGL(dbg_dump, dim3(2048), dim3(256), 0, stream, (const bf16*)(w + WS_PROJ), N_IN, 0, DM, 0, o);
            if (DBG_BUF == 2) hipLaunchKernelGGL(dbg_dump, dim3(2048), dim3(256), 0, stream, (const bf16*)(w + WS_PROJ), N_IN, N_IN - DM, DM, 0, o);
            if (DBG_BUF == 3) { hipLaunchKernelGGL(dbg_dump, dim3(2048), dim3(256), 0, stream, (const bf16*)(w + WS_G), SSMW, 0, SSMW, 0, o);
                                hipLaunchKernelGGL(dbg_dump, dim3(2048), dim3(256), 0, stream, (const bf16*)(w + WS_A3), SSMW, 0, SSMW, 512, o);
                                hipLaunchKernelGGL(dbg_dump, dim3(2048), dim3(256), 0, stream, (const bf16*)(w + WS_A3) + (size_t)M * SSMW, SSMW, 0, SSMW, 1024, o);
                                hipLaunchKernelGGL(dbg_dump, dim3(2048), dim3(256), 0, stream, (const bf16*)(w + WS_A3) + (size_t)2 * M * SSMW, SSMW, 0, SSMW, 1536, o); }
            if (DBG_BUF == 4) hipLaunchKernelGGL(dbg_dump, dim3(2048), dim3(256), 0, stream, (const bf16*)(w + WS_MG), DM, 0, DM, 0, o);
            if (DBG_BUF == 5) hipLaunchKernelGGL(dbg_dump, dim3(2048), dim3(256), 0, stream, (const bf16*)(w + WS_Y), DM, 0, DM, 0, o);
            if (DBG_BUF == 6) hipLaunchKernelGGL(dbg_dump, dim3(2048), dim3(256), 0, stream, (const bf16*)(w + WS_ACT), DFF, 0, DM, 0, o);
            break;
        }
    }
#else
    a.ph_lo = 0; a.ph_hi = N_PHASES;
    hipLaunchKernelGGL(trunk_fwd, dim3(grid), dim3(NWAVES * 64), LDS_BYTES, stream, a);
#endif
    const hipError_t le = hipPeekAtLastError();
    if (le != hipSuccess) fprintf(stderr, "kernel_launch: launch failed: %s\n", hipGetErrorName(le));
}
```

```cpp
#include <hip/hip_runtime.h>
#include <cstdio>
#include <cstdint>
namespace pg8 {
#define PG8_LAS __attribute__((address_space(3)))
typedef unsigned short bf16_t;
typedef short bf16x8 __attribute__((ext_vector_type(8)));
typedef float f32x4 __attribute__((ext_vector_type(4)));
typedef unsigned u32x4 __attribute__((ext_vector_type(4)));
constexpr int BM = 256, BK = 64, HALF = 128, HTB = HALF * BK * 2  , STAGE_BYTES = 8 * HTB, NXCD = 8, WGM = 8;

__host__ __device__ __forceinline__ int lds_byte(int r, int c) { const int st = (r >> 4) * 2 + (c >> 5), rr = r & 15, cc = c & 31, ob = rr * 64 + cc * 2; return st * 1024 + (ob ^ (((ob >> 9) & 1) << 5)); }
__host__ __device__ __forceinline__ void stage_rc(int b, int& R, int& C) { const int st = b / 1024, sb = b % 1024, swz = sb ^ (((sb >> 9) & 1) << 5); R = (st >> 1) * 16 + swz / 64; C = (st & 1) * 32 + (swz % 64) / 2; }
__host__ __device__ __forceinline__ int perm32(int rho) { const int n = rho >> 4, i = rho & 15; return 8 * (i >> 2) + 4 * n + (i & 3); }

struct Unit { int pm, pn; };
struct Gemm { const bf16_t* A; const bf16_t* Bt; int M, N, K; };

struct StaticOrder {
    int nM, nN, nwg, G, c;
    __host__ __device__ void init(int M, int N, int G_, int c_) { nM = M / BM; nN = N / BM; nwg = nM * nN; G = G_; c = c_; }
    __host__ __device__ bool next(int i, Unit& u) const {
        const long L = (long)i * G + c; if (L >= nwg) return false;
        int wgid = (int)L; { const int q = nwg / NXCD, r = nwg % NXCD, xcd = wgid % NXCD, off = wgid / NXCD; wgid = (xcd < r ? xcd * (q + 1) : r * (q + 1) + (xcd - r) * q) + off; }
        const int nig = WGM * nN, gid = wgid / nig, fm = gid * WGM, gsz = (nM - fm) < WGM ? (nM - fm) : WGM;
        u.pm = fm + ((wgid % nig) % gsz); u.pn = (wgid % nig) / gsz; return true;
    }
    __device__ __forceinline__ void a_ready(const Unit&) const {}
    __device__ __forceinline__ void done(const Unit&) const {}
};

typedef float cvt_f32x2 __attribute__((ext_vector_type(2))); typedef __bf16 cvt_bf16x2 __attribute__((ext_vector_type(2)));
__device__ __forceinline__ unsigned cvt_pk_bf16(float lo, float hi) { cvt_f32x2 v = {lo, hi}; cvt_bf16x2 b = __builtin_convertvector(v, cvt_bf16x2); return __builtin_bit_cast(unsigned, b); }
__device__ __forceinline__ float sigm(float x) { return __builtin_amdgcn_rcpf(1.0f + __expf(-x)); }
__device__ __forceinline__ float bflo(unsigned w) { return __uint_as_float(w << 16); }
__device__ __forceinline__ float bfhi(unsigned w) { return __uint_as_float(w & 0xffff0000u); }
__device__ __forceinline__ u32x4 pack8(const f32x4& v0, const f32x4& v1) { u32x4 w; w.x = cvt_pk_bf16(v0[0], v0[1]); w.y = cvt_pk_bf16(v0[2], v0[3]); w.z = cvt_pk_bf16(v1[0], v1[1]); w.w = cvt_pk_bf16(v1[2], v1[3]); return w; }
#ifndef OUT_NT
#define OUT_NT 1
#endif
__device__ __forceinline__ void st_out(u32x4* p, const u32x4 v) { if (OUT_NT) __builtin_nontemporal_store(v, p); else *p = v; }
struct EpiStore {
    static constexpr bool PERM = true, AFTER_DRAIN = false, ASWAP = false;
    bf16_t* O; int ldc;
    __device__ __forceinline__ void operator()(const f32x4 (&acc)[2][2][4][2], const Unit& u, int wr, int wc, int fr, int fq) const {
        const int row0 = u.pm * BM + wr * 64 + fr, col0 = u.pn * BM + wc * 32 + 8 * fq;
#pragma unroll
        for (int ai = 0; ai < 2; ++ai)
#pragma unroll
            for (int m = 0; m < 4; ++m) { bf16_t* rowp = O + (size_t)(row0 + ai * HALF + m * 16) * ldc + col0;
#pragma unroll
                for (int bj = 0; bj < 2; ++bj) st_out((u32x4*)(rowp + bj * HALF), pack8(acc[ai][bj][m][0], acc[ai][bj][m][1])); }
    }
};
struct EpiIn {
    static constexpr bool PERM = true, AFTER_DRAIN = false, ASWAP = false;
    bf16_t* O; int ldc; const float* bgate; int gate_tile0;
    __device__ __forceinline__ void operator()(const f32x4 (&acc)[2][2][4][2], const Unit& u, int wr, int wc, int fr, int fq) const {
        const int row0 = u.pm * BM + wr * 64 + fr, col0 = u.pn * BM + wc * 32 + 8 * fq;
        if (u.pn >= gate_tile0) {
            const float* bp = bgate + (col0 - gate_tile0 * BM);
            f32x4 bv[2][2];
#pragma unroll
            for (int bj = 0; bj < 2; ++bj)
#pragma unroll
                for (int n = 0; n < 2; ++n) bv[bj][n] = *(const f32x4*)(bp + bj * HALF + 4 * n);
#pragma unroll
            for (int ai = 0; ai < 2; ++ai)
#pragma unroll
                for (int m = 0; m < 4; ++m) { bf16_t* rowp = O + (size_t)(row0 + ai * HALF + m * 16) * ldc + col0;
#pragma unroll
                    for (int bj = 0; bj < 2; ++bj) { f32x4 v0 = acc[ai][bj][m][0] + bv[bj][0], v1 = acc[ai][bj][m][1] + bv[bj][1];
#pragma unroll
                        for (int j = 0; j < 4; ++j) { v0[j] = sigm(v0[j]); v1[j] = sigm(v1[j]); }
                        st_out((u32x4*)(rowp + bj * HALF), pack8(v0, v1)); } }
        } else {
#pragma unroll
            for (int ai = 0; ai < 2; ++ai)
#pragma unroll
                for (int m = 0; m < 4; ++m) { bf16_t* rowp = O + (size_t)(row0 + ai * HALF + m * 16) * ldc + col0;
#pragma unroll
                    for (int bj = 0; bj < 2; ++bj) st_out((u32x4*)(rowp + bj * HALF), pack8(acc[ai][bj][m][0], acc[ai][bj][m][1])); }
        }
    }
};
struct EpiGlu {
    static constexpr bool PERM = true, AFTER_DRAIN = false, ASWAP = false;
    const bf16_t* G; bf16_t* O; int ldc; const float* bias;
    __device__ __forceinline__ void operator()(const f32x4 (&acc)[2][2][4][2], const Unit& u, int wr, int wc, int fr, int fq) const {
        const int row0 = u.pm * BM + wr * 64 + fr, col0 = u.pn * BM + wc * 32 + 8 * fq;
        f32x4 bv[2][2];
#pragma unroll
        for (int bj = 0; bj < 2; ++bj)
#pragma unroll
            for (int n = 0; n < 2; ++n) bv[bj][n] = *(const f32x4*)(bias + col0 + bj * HALF + 4 * n);
#pragma unroll
        for (int ai = 0; ai < 2; ++ai) {
            u32x4 gw[4][2];
#pragma unroll
            for (int m = 0; m < 4; ++m)
#pragma unroll
                for (int bj = 0; bj < 2; ++bj) gw[m][bj] = *(const u32x4*)(G + (size_t)(row0 + ai * HALF + m * 16) * ldc + col0 + bj * HALF);
#pragma unroll
            for (int m = 0; m < 4; ++m) { const size_t off = (size_t)(row0 + ai * HALF + m * 16) * ldc + col0;
#pragma unroll
                for (int bj = 0; bj < 2; ++bj) { const u32x4 g4 = gw[m][bj];
                    f32x4 v0 = acc[ai][bj][m][0] + bv[bj][0], v1 = acc[ai][bj][m][1] + bv[bj][1];
                    v0[0] = bflo(g4.x) * sigm(v0[0]); v0[1] = bfhi(g4.x) * sigm(v0[1]); v0[2] = bflo(g4.y) * sigm(v0[2]); v0[3] = bfhi(g4.y) * sigm(v0[3]);
                    v1[0] = bflo(g4.z) * sigm(v1[0]); v1[1] = bfhi(g4.z) * sigm(v1[1]); v1[2] = bflo(g4.w) * sigm(v1[2]); v1[3] = bfhi(g4.w) * sigm(v1[3]);
                    *(u32x4*)(O + off + bj * HALF) = pack8(v0, v1); } }
        }
    }
};
struct EpiBr {
    static constexpr bool PERM = true, AFTER_DRAIN = false, ASWAP = false;
    const bf16_t* gates; int ldg; bf16_t* Mg; int ldm;
    __device__ __forceinline__ void operator()(const f32x4 (&acc)[2][2][4][2], const Unit& u, int wr, int wc, int fr, int fq) const {
        const int br = u.pm >> 6, pm = u.pm & 63, pn = u.pn & 7; const bool accum = (br != 1);
        const int row0 = pm * BM + wr * 64 + fr, col0 = pn * BM + wc * 32 + 8 * fq;
#pragma unroll
        for (int ai = 0; ai < 2; ++ai)
#pragma unroll
            for (int mp = 0; mp < 2; ++mp) {
                u32x4 gw[2][2], ow[2][2];
#pragma unroll
                for (int mm = 0; mm < 2; ++mm)
#pragma unroll
                    for (int bj = 0; bj < 2; ++bj) { const int row = row0 + ai * HALF + (2 * mp + mm) * 16;
                        gw[mm][bj] = *(const u32x4*)(gates + (size_t)row * ldg + br * ldm + col0 + bj * HALF);
                        if (accum) ow[mm][bj] = *(const u32x4*)(Mg + (size_t)row * ldm + col0 + bj * HALF); }
#pragma unroll
                for (int mm = 0; mm < 2; ++mm)
#pragma unroll
                    for (int bj = 0; bj < 2; ++bj) { const int m = 2 * mp + mm; const int row = row0 + ai * HALF + m * 16; const u32x4 g4 = gw[mm][bj];
                        f32x4 v0 = acc[ai][bj][m][0], v1 = acc[ai][bj][m][1];
                        v0[0] *= bflo(g4.x); v0[1] *= bfhi(g4.x); v0[2] *= bflo(g4.y); v0[3] *= bfhi(g4.y); v1[0] *= bflo(g4.z); v1[1] *= bfhi(g4.z); v1[2] *= bflo(g4.w); v1[3] *= bfhi(g4.w);
                        if (accum) { const u32x4 o4 = ow[mm][bj];
                            v0[0] += bflo(o4.x); v0[1] += bfhi(o4.x); v0[2] += bflo(o4.y); v0[3] += bfhi(o4.y); v1[0] += bflo(o4.z); v1[1] += bfhi(o4.z); v1[2] += bflo(o4.w); v1[3] += bfhi(o4.w); }
                        *(u32x4*)(Mg + (size_t)row * ldm + col0 + bj * HALF) = pack8(v0, v1); }
            }
    }
};
typedef float f32x2 __attribute__((ext_vector_type(2))); typedef unsigned u32x2 __attribute__((ext_vector_type(2)));
__device__ __forceinline__ unsigned dpp_shr1(unsigned old, unsigned v) { return (unsigned)__builtin_amdgcn_update_dpp((int)old, (int)v, 0x111, 0xF, 0xF, false); }
__device__ __forceinline__ unsigned dpp_shr2(unsigned old, unsigned v) { return (unsigned)__builtin_amdgcn_update_dpp((int)old, (int)v, 0x112, 0xF, 0xF, false); }
__device__ __forceinline__ unsigned dpp_ror1(unsigned v) { return (unsigned)__builtin_amdgcn_update_dpp(0, (int)v, 0x121, 0xF, 0xF, true); }
__device__ __forceinline__ unsigned dpp_ror2(unsigned v) { return (unsigned)__builtin_amdgcn_update_dpp(0, (int)v, 0x122, 0xF, 0xF, true); }
struct EpiUpAct {
    static constexpr bool PERM = true, AFTER_DRAIN = false, ASWAP = true;
    bf16_t* ACT; int dff; const float* cw; bf16_t* halo;
    __device__ __forceinline__ void operator()(const f32x4 (&acc)[2][2][4][2], const Unit& u, int wr_, int wc_, int fr_, int fq_) const {
        int tl = threadIdx.x; asm volatile("" : "+v"(tl));
        const int lane = tl & 63, wid = tl >> 6, wr = wid >> 2, wc = wid & 3, fr = lane & 15, fq = lane >> 4; (void)wr_; (void)wc_; (void)fr_; (void)fq_;
        const int nup = 2 * dff, j0 = u.pn * 128 + wc * 32 + 8 * fq;
        const int tok0 = u.pm * BM + wr * 128;
        unsigned pk[8][2][2][2];
#pragma unroll
        for (int q = 0; q < 8; ++q)
#pragma unroll
            for (int bj = 0; bj < 2; ++bj)
#pragma unroll
                for (int n = 0; n < 2; ++n) { const f32x4 v = acc[q >> 2][bj][q & 3][n]; pk[q][bj][n][0] = cvt_pk_bf16(v[0], v[1]); pk[q][bj][n][1] = cvt_pk_bf16(v[2], v[3]); }
        __builtin_amdgcn_sched_barrier(0);
        { const int blk = tok0 >> 7;
          if (fr < 2) {
#pragma unroll
              for (int bj = 0; bj < 2; ++bj) *(u32x4*)(halo + ((size_t)blk * 4 + fr) * nup + bj * dff + j0) = (u32x4){pk[0][bj][0][0], pk[0][bj][0][1], pk[0][bj][1][0], pk[0][bj][1][1]}; }
          if (fr >= 14) {
#pragma unroll
              for (int bj = 0; bj < 2; ++bj) *(u32x4*)(halo + ((size_t)blk * 4 + fr - 12) * nup + bj * dff + j0) = (u32x4){pk[7][bj][0][0], pk[7][bj][0][1], pk[7][bj][1][0], pk[7][bj][1][1]}; } }
        __builtin_amdgcn_sched_barrier(0);
        unsigned op[8][2][2];
#pragma unroll
        for (int n = 0; n < 2; ++n)
#pragma unroll
            for (int h = 0; h < 2; ++h) {
                f32x2 wa[3], wb[3];
                { int wo = j0 + 4 * n + 2 * h; asm volatile("" : "+v"(wo));
#pragma unroll
                  for (int k = 0; k < 3; ++k) { wa[k] = *(const __attribute__((address_space(1))) f32x2*)(cw + wo + k * nup); wb[k] = *(const __attribute__((address_space(1))) f32x2*)(cw + wo + k * nup + dff); } }
                unsigned ra1 = 0u, ra2 = 0u, rb1 = 0u, rb2 = 0u;
#pragma unroll
                for (int q = 0; q < 8; ++q) { unsigned a = pk[q][0][n][h], b = pk[q][1][n][h];
                    if (q > 0) asm volatile("" : "+v"(a), "+v"(b), "+v"(op[q - 1][n][h])); else asm volatile("" : "+v"(a), "+v"(b));
                    const unsigned pa1 = dpp_shr1(ra1, a), pa2 = dpp_shr2(ra2, a), pb1 = dpp_shr1(rb1, b), pb2 = dpp_shr2(rb2, b);
                    if (q < 7) { ra1 = dpp_ror1(a); ra2 = dpp_ror2(a); rb1 = dpp_ror1(b); rb2 = dpp_ror2(b); }
                    const float ca0 = wa[0][0] * bflo(a) + wa[1][0] * bflo(pa1) + wa[2][0] * bflo(pa2), ca1 = wa[0][1] * bfhi(a) + wa[1][1] * bfhi(pa1) + wa[2][1] * bfhi(pa2);
                    const float cb0 = wb[0][0] * bflo(b) + wb[1][0] * bflo(pb1) + wb[2][0] * bflo(pb2), cb1 = wb[0][1] * bfhi(b) + wb[1][1] * bfhi(pb1) + wb[2][1] * bfhi(pb2);
                    op[q][n][h] = cvt_pk_bf16(ca0 * sigm(ca0) * cb0, ca1 * sigm(ca1) * cb1);
                    __builtin_amdgcn_sched_barrier(0); }
            }
        size_t ao = (size_t)(tok0 + fr) * dff + j0;
#pragma unroll
        for (int q = 0; q < 8; ++q) { asm volatile("" : "+v"(ao));
            if (q > 0 || fr >= 2) *(__attribute__((address_space(1))) u32x4*)(ACT + ao) = (u32x4){op[q][0][0], op[q][0][1], op[q][1][0], op[q][1][1]};
            ao += (size_t)16 * dff; }
    }
};
struct BrTripleOrder {
    StaticOrder so;
    __host__ __device__ void init(int M, int N, int G_, int c_) { so.init(M, N, G_, c_); }
    __host__ __device__ bool next(int i, Unit& u) const { Unit t; const int j = i / 3, k = i - 3 * j; if (!so.next(j, t)) return false; const int br = (k == 2) ? 0 : k + 1; u.pm = t.pm + 64 * br; u.pn = t.pn + 8 * br; return true; }
    __device__ __forceinline__ void a_ready(const Unit&) const {}
    __device__ __forceinline__ void done(const Unit&) const {}
};
template <class Epi, class Sched, bool ALIGN_EPI = false, bool SP2 = false>
__device__ __forceinline__ void gemm_phase(PG8_LAS unsigned char* lds, const Gemm g, const Sched& S, const Epi& E) {
    int tid = threadIdx.x; asm volatile("" : "+v"(tid)); const int wid = __builtin_amdgcn_readfirstlane(tid >> 6), lane = tid & 63, wr = wid >> 2, wc = wid & 3, fr = lane & 15, fq = lane >> 4;
    const int K = g.K, nt = K / BK;
    unsigned voffA[2], voffB[2];
#pragma unroll
    for (int i = 0; i < 2; ++i) { int R, C; stage_rc(tid * 16 + i * 8192, R, C); const int Rb = Epi::PERM ? ((R & ~31) + perm32(R & 31)) : R;
        const int Ra = Epi::ASWAP ? ((R >> 6) * 128 + (R & 63)) : R;
        voffA[i] = (unsigned)(Ra * K + C) * 2u; voffB[i] = (unsigned)(Rb * K + C) * 2u; }
    const size_t kstep = (size_t)(BK * 2);
    const size_t hstep = (size_t)HALF * K * 2;
    const size_t hstepA = Epi::ASWAP ? (size_t)64 * K * 2 : hstep;
    const size_t tstep = 2 * hstep;
    const unsigned ldsw = (unsigned)wid * 1024u;
    const int aoff = lds_byte(wr * 64 + fr, fq * 8), boff = lds_byte(wc * 32 + fr, fq * 8);
#define PG8_SA(b, h) (((b) * 2 + (h)) * HTB)
#define PG8_SB(b, h) ((4 + (b) * 2 + (h)) * HTB)
#define PG8_STAGE(bufoff, gbase, voff) do { _Pragma("unroll") for (int _i = 0; _i < 2; ++_i) \
        __builtin_amdgcn_global_load_lds((const unsigned*)((const char*)(gbase) + (voff)[_i]), (PG8_LAS unsigned*)(lds + (bufoff) + ldsw + _i * 8192), 16, 0, 0); } while (0)
#define PG8_LDA(dst, b, h) do { _Pragma("unroll") for (int m = 0; m < 4; ++m) _Pragma("unroll") for (int k = 0; k < 2; ++k) dst[m][k] = *(const PG8_LAS bf16x8*)(lds + PG8_SA(b, h) + aoff + m * 2048 + k * 1024); } while (0)
#define PG8_LDB(dst, b, h) do { _Pragma("unroll") for (int n = 0; n < 2; ++n) _Pragma("unroll") for (int k = 0; k < 2; ++k) dst[n][k] = *(const PG8_LAS bf16x8*)(lds + PG8_SB(b, h) + boff + n * 2048 + k * 1024); } while (0)
#define PG8_MMA(ai, bj, At, Bt) do { __builtin_amdgcn_s_setprio(1); _Pragma("unroll") for (int m = 0; m < 4; ++m) _Pragma("unroll") for (int n = 0; n < 2; ++n) _Pragma("unroll") for (int k = 0; k < 2; ++k) \
        acc[ai][bj][m][n] = __builtin_amdgcn_mfma_f32_16x16x32_bf16(Bt[n][k], At[m][k], acc[ai][bj][m][n], 0, 0, 0); __builtin_amdgcn_s_setprio(0); } while (0)
#define PG8_WAIT_V(n) asm volatile("s_waitcnt vmcnt(" #n ")" ::: "memory")
#define PG8_WAIT_L(n) asm volatile("s_waitcnt lgkmcnt(" #n ")" ::: "memory")
#define PG8_BAR __builtin_amdgcn_s_barrier()
#define PG8_SCHED __builtin_amdgcn_sched_barrier(0)
    Unit cur, nxt; int ui = 0;
    if (!S.next(0, cur)) return;
    f32x4 acc[2][2][4][2];
#pragma unroll
    for (int a = 0; a < 2; ++a)
#pragma unroll
        for (int b = 0; b < 2; ++b)
#pragma unroll
            for (int m = 0; m < 4; ++m)
#pragma unroll
                for (int n = 0; n < 2; ++n) acc[a][b][m][n] = (f32x4){0.f, 0.f, 0.f, 0.f};
    bf16x8 At[4][2], B0[2][2], B1[2][2];
    const char* cA = (const char*)g.A + (size_t)cur.pm * tstep; const char* cB = (const char*)g.Bt + (size_t)cur.pn * tstep;
    S.a_ready(cur);
    if constexpr (SP2) {
        PG8_STAGE(PG8_SB(0, 0), cB, voffB); PG8_STAGE(PG8_SB(0, 1), cB + hstep, voffB); PG8_STAGE(PG8_SA(0, 0), cA, voffA); PG8_STAGE(PG8_SA(0, 1), cA + hstepA, voffA);
        if (wr == 1) PG8_BAR;
        PG8_WAIT_V(2); PG8_BAR;
        PG8_STAGE(PG8_SB(1, 0), cB + kstep, voffB); PG8_STAGE(PG8_SA(1, 0), cA + kstep, voffA); PG8_STAGE(PG8_SB(1, 1), cB + hstep + kstep, voffB);
        PG8_WAIT_V(6); PG8_BAR;
    } else {
        PG8_STAGE(PG8_SB(0, 0), cB, voffB); PG8_STAGE(PG8_SA(0, 0), cA, voffA); PG8_STAGE(PG8_SB(0, 1), cB + hstep, voffB); PG8_STAGE(PG8_SA(0, 1), cA + hstepA, voffA);
        if (wr == 1) PG8_BAR;
        PG8_WAIT_V(4); PG8_BAR;
        PG8_STAGE(PG8_SB(1, 0), cB + kstep, voffB); PG8_STAGE(PG8_SA(1, 0), cA + kstep, voffA); PG8_STAGE(PG8_SB(1, 1), cB + hstep + kstep, voffB);
        PG8_WAIT_V(6); PG8_BAR;
    }
    for (;;) {
        const bool has_next = S.next(ui + 1, nxt);
        const char* nA = has_next ? (const char*)g.A + (size_t)nxt.pm * tstep : cA; const char* nB = has_next ? (const char*)g.Bt + (size_t)nxt.pn * tstep : cB;
        for (int t = 0; t < nt; t += 2) {
            const bool last = (t == nt - 2);
            const char* a1 = cA + (size_t)(t + 1) * kstep;
            const char* a2 = last ? nA : cA + (size_t)(t + 2) * kstep; const char* b2 = last ? nB : cB + (size_t)(t + 2) * kstep;
            const char* a3 = a2 + kstep; const char* b3 = b2 + kstep;
            if (last && has_next) S.a_ready(nxt);
            if constexpr (SP2) {
            PG8_LDB(B0, 0, 0); PG8_LDB(B1, 0, 1); PG8_SCHED; PG8_LDA(At, 0, 0); PG8_STAGE(PG8_SA(1, 1), a1 + hstepA, voffA);
            PG8_WAIT_V(8); PG8_WAIT_L(0); PG8_BAR; PG8_MMA(0, 0, At, B0); PG8_MMA(0, 1, At, B1); PG8_BAR; PG8_SCHED;
            PG8_LDA(At, 0, 1); PG8_STAGE(PG8_SB(0, 0), b2, voffB); PG8_STAGE(PG8_SB(0, 1), b2 + hstep, voffB); PG8_STAGE(PG8_SA(0, 0), a2, voffA);
            PG8_WAIT_V(8); PG8_WAIT_L(0); PG8_BAR; PG8_MMA(1, 0, At, B0); PG8_MMA(1, 1, At, B1); PG8_BAR; PG8_SCHED;
            PG8_LDB(B0, 1, 0); PG8_LDB(B1, 1, 1); PG8_SCHED; PG8_LDA(At, 1, 0); PG8_STAGE(PG8_SA(0, 1), a2 + hstepA, voffA);
            PG8_WAIT_V(8); PG8_WAIT_L(0); PG8_BAR; PG8_MMA(0, 0, At, B0); PG8_MMA(0, 1, At, B1); PG8_BAR; PG8_SCHED;
            PG8_LDA(At, 1, 1); PG8_STAGE(PG8_SB(1, 0), b3, voffB); PG8_STAGE(PG8_SB(1, 1), b3 + hstep, voffB); PG8_STAGE(PG8_SA(1, 0), a3, voffA);
            PG8_WAIT_V(8); PG8_WAIT_L(0); PG8_BAR; PG8_MMA(1, 0, At, B0); PG8_MMA(1, 1, At, B1); PG8_BAR; PG8_SCHED;
            } else {
            PG8_LDB(B0, 0, 0); PG8_SCHED; PG8_LDA(At, 0, 0); PG8_STAGE(PG8_SA(1, 1), a1 + hstepA, voffA);
            PG8_WAIT_L(8); PG8_BAR; PG8_WAIT_L(0); PG8_MMA(0, 0, At, B0); PG8_BAR; PG8_SCHED;
            PG8_LDB(B1, 0, 1); PG8_STAGE(PG8_SB(0, 0), b2, voffB);
            PG8_BAR; PG8_WAIT_L(0); PG8_MMA(0, 1, At, B1); PG8_BAR;
            PG8_LDA(At, 0, 1); PG8_STAGE(PG8_SA(0, 0), a2, voffA);
            PG8_BAR; PG8_WAIT_L(0); PG8_MMA(1, 0, At, B0); PG8_BAR; PG8_SCHED;
            PG8_STAGE(PG8_SB(0, 1), b2 + hstep, voffB);
            PG8_WAIT_V(6); PG8_BAR; PG8_MMA(1, 1, At, B1); PG8_BAR;
            PG8_LDB(B0, 1, 0); PG8_SCHED; PG8_LDA(At, 1, 0); PG8_STAGE(PG8_SA(0, 1), a2 + hstepA, voffA);
            PG8_WAIT_L(8); PG8_BAR; PG8_WAIT_L(0); PG8_MMA(0, 0, At, B0); PG8_BAR; PG8_SCHED;
            PG8_LDB(B1, 1, 1); PG8_STAGE(PG8_SB(1, 0), b3, voffB);
            PG8_BAR; PG8_WAIT_L(0); PG8_MMA(0, 1, At, B1); PG8_BAR;
            PG8_LDA(At, 1, 1); PG8_STAGE(PG8_SA(1, 0), a3, voffA);
            PG8_BAR; PG8_WAIT_L(0); PG8_MMA(1, 0, At, B0); PG8_BAR; PG8_SCHED;
            PG8_STAGE(PG8_SB(1, 1), b3 + hstep, voffB);
            PG8_WAIT_V(6); PG8_BAR; PG8_MMA(1, 1, At, B1); PG8_BAR;
            }
        }
        if constexpr (ALIGN_EPI) { if (wr == 0) PG8_BAR; }
        if constexpr (!Epi::AFTER_DRAIN) { E(acc, cur, wr, wc, fr, fq); S.done(cur); }
        if (!has_next) break;
#pragma unroll
        for (int a = 0; a < 2; ++a)
#pragma unroll
            for (int b = 0; b < 2; ++b)
#pragma unroll
                for (int m = 0; m < 4; ++m)
#pragma unroll
                    for (int n = 0; n < 2; ++n) acc[a][b][m][n] = (f32x4){0.f, 0.f, 0.f, 0.f};
        cur = nxt; cA = nA; cB = nB; ++ui;
        if constexpr (ALIGN_EPI) { if (wr == 1) PG8_BAR; }
    }
    PG8_WAIT_V(0);
    if constexpr (!ALIGN_EPI) { if (wr == 0) PG8_BAR; }
    PG8_BAR;
    if constexpr (Epi::AFTER_DRAIN) { E.fused(acc, cur, wr, wc, fr, fq, lds, wid, lane); S.done(cur); }
#undef PG8_SA
#undef PG8_SB
#undef PG8_STAGE
#undef PG8_LDA
#undef PG8_LDB
#undef PG8_MMA
#undef PG8_WAIT_V
#undef PG8_WAIT_L
#undef PG8_BAR
#undef PG8_SCHED
}
}
constexpr int NWAVES = 8;
constexpr int DM = 2048, BATCH = 8, SEQ = 2048, DEPTH = 4, M = BATCH * SEQ;
constexpr int SSMW = 512, NGRP = 32, NST = 64, HD = 64;
constexpr int OFF_Q = 512, OFF_K = 2048, OFF_V = 3584, OFF_CB = 5120, OFF_CC = 5632, OFF_CH = 6144, OFF_GATE = 6656, N_IN = 12800;
constexpr int DFF = 5632, NUP = 2 * DFF;
constexpr int NMOD = 6 * DM;
constexpr float RMS_EPS = 1e-6f;
enum { I_X = 0, I_C, I_WMOD, I_BMOD, I_GPRE_MIX, I_GPOST_MIX, I_GPRE_FFN, I_GPOST_FFN, I_WIN, I_LOGDT, I_ARE, I_AIM, I_BRE, I_BIM, I_CRE, I_CIM, I_SSMD, I_WGLU, I_BGLU,
       I_CONVW, I_WSSM, I_WATT, I_WCNV, I_BGATE, I_WO, I_WUP, I_FCONVW, I_WDOWN, N_INPUTS };
constexpr size_t MiB = 1u << 20;
constexpr size_t WS_CTL = 0, CTL_ZERO_BYTES = 1 * MiB;
constexpr size_t WS_MOD = 1 * MiB;
constexpr size_t WS_W = 4 * MiB;
constexpr size_t WB_IN = 0, WB_GLU = WB_IN + (size_t)N_IN * DM * 2, WB_BR = WB_GLU + (size_t)SSMW * SSMW * 2, WB_O = WB_BR + (size_t)3 * DM * SSMW * 2,
                 WB_UP = WB_O + (size_t)DM * DM * 2, WB_DN = WB_UP + (size_t)NUP * DM * 2, WB_LAYER = WB_DN + (size_t)DM * DFF * 2;
static_assert(WB_LAYER == (size_t)(50 * MiB + MiB / 2 + 6 * MiB + 8 * MiB + 44 * MiB + 22 * MiB), "weights per layer");
constexpr size_t WS_H = 528 * MiB;
constexpr size_t WS_PROJ = 592 * MiB;
constexpr size_t WS_ACT = 992 * MiB;
constexpr size_t WS_G = 1168 * MiB;
constexpr size_t WS_A3 = 1184 * MiB;
constexpr size_t WS_MG = 1232 * MiB;
constexpr size_t WS_Y = 1296 * MiB;
constexpr size_t WS_MODP = 1424 * MiB;
constexpr size_t WS_XB = 1360 * MiB;
constexpr size_t WS_END = 1432 * MiB;
static_assert(WS_W + DEPTH * WB_LAYER <= WS_H && WS_PROJ + (size_t)M * N_IN * 2 <= WS_ACT && WS_ACT + (size_t)M * DFF * 2 <= WS_G, "ws map");
constexpr int CW_BAR = 4096;
constexpr int RING_BYTES = 131072, MISC_OFF = 143360, LDS_BYTES = 147456;

#define GAS __attribute__((address_space(1)))
#define LAS __attribute__((address_space(3)))
typedef unsigned short bf16;
typedef unsigned v4u __attribute__((ext_vector_type(4)));
typedef unsigned v2u __attribute__((ext_vector_type(2)));
typedef float f32x4 __attribute__((ext_vector_type(4)));
typedef short bf16x8 __attribute__((ext_vector_type(8)));
typedef short s16x4 __attribute__((ext_vector_type(4)));
#define LDS_WAIT() asm volatile("s_waitcnt lgkmcnt(0)" ::: "memory")
#define VM_WAIT() asm volatile("s_waitcnt vmcnt(0)" ::: "memory")
__device__ __forceinline__ unsigned f2bf(float f) { unsigned u = __builtin_bit_cast(unsigned, f); return (u + 0x7fffu + ((u >> 16) & 1u)) >> 16; }
__device__ __forceinline__ unsigned pk2(float lo, float hi) { return pg8::cvt_pk_bf16(lo, hi); }
__device__ __forceinline__ float bflo(unsigned w) { return __uint_as_float(w << 16); }
__device__ __forceinline__ float bfhi(unsigned w) { return __uint_as_float(w & 0xffff0000u); }
__device__ __forceinline__ void unpack8(const v4u w, float (&f)[8]) { f[0] = bflo(w.x); f[1] = bfhi(w.x); f[2] = bflo(w.y); f[3] = bfhi(w.y); f[4] = bflo(w.z); f[5] = bfhi(w.z); f[6] = bflo(w.w); f[7] = bfhi(w.w); }
__device__ __forceinline__ v4u pack8f(const float (&f)[8]) { v4u w; w.x = pk2(f[0], f[1]); w.y = pk2(f[2], f[3]); w.z = pk2(f[4], f[5]); w.w = pk2(f[6], f[7]); return w; }
__device__ __forceinline__ float wave_sum(float v) {
#pragma unroll
    for (int o = 1; o < 64; o <<= 1) v += __shfl_xor(v, o);
    return v;
}
#define XB_TMO      128
#define XB_XCNT(j)  (256  + 64 * (j))
#define XB_XSUB(j)  (1280 + 64 * (j))
#define XB_XGEN(j)  (2304 + 64 * (j))
#define XB_TOP      3328
#define XB_TOPGEN   3392
#define XCD_BAR_WORDS 3456
#define XB_SPIN_CAP (1u << 18)

__device__ __forceinline__ unsigned xb_ld(unsigned* p)              { return __hip_atomic_load(p, __ATOMIC_RELAXED, __HIP_MEMORY_SCOPE_AGENT); }
__device__ __forceinline__ unsigned xb_add(unsigned* p, unsigned v) { return __hip_atomic_fetch_add(p, v, __ATOMIC_RELAXED, __HIP_MEMORY_SCOPE_AGENT); }
__device__ __forceinline__ unsigned xb_xcc_id() { return (unsigned)__builtin_amdgcn_s_getreg((3 << 11) | 20) & 0xFu; }
#define XB_SPIN(cond, bar) do { unsigned _sp = 0; while (cond) { __builtin_amdgcn_s_sleep(1); \
    if ((++_sp & 255u) == 0u) { if (xb_ld(&(bar)[XB_TMO])) break; if (_sp > XB_SPIN_CAP) { atomicAdd(&(bar)[XB_TMO], 1u); break; } } } } while (0)

struct XcdBarrier {
    unsigned* bar; unsigned x;
    volatile LAS unsigned* st;
};

__device__ __forceinline__ XcdBarrier xcd_barrier_post(unsigned* bar, volatile LAS unsigned* st) {
    XcdBarrier b; b.bar = bar; b.x = xb_xcc_id(); b.st = st;
    if (threadIdx.x == 0) (void)xb_add(&bar[XB_XCNT(b.x)], 1u);
    return b;
}
__device__ __forceinline__ void xcd_barrier_complete(unsigned* bar, unsigned x, unsigned& nloc, unsigned& nx) {
    const unsigned G = gridDim.x * gridDim.y * gridDim.z;
    unsigned sum, cnt, mine, sp = 0u;
    for (;;) {
        sum = 0u; cnt = 0u; mine = 0u;
#pragma unroll
        for (unsigned j = 0; j < 16; ++j) { const unsigned c = xb_ld(&bar[XB_XCNT(j)]); sum += c; cnt += (c > 0u) ? 1u : 0u; mine = (j == x) ? c : mine; }
        if (sum == G) break;
        __builtin_amdgcn_s_sleep(1);
        if ((++sp & 255u) == 0u) { if (xb_ld(&bar[XB_TMO])) break; if (sp > XB_SPIN_CAP) { atomicAdd(&bar[XB_TMO], 1u); break; } }
    }
    nloc = mine > 0u ? mine : 1u; nx = cnt > 0u ? cnt : 1u;
}

__device__ __forceinline__ void xcd_barrier(const XcdBarrier& b) {
    asm volatile("s_waitcnt vmcnt(0)" ::: "memory");
    __syncthreads();
    if (threadIdx.x == 0) {
        unsigned* bar = b.bar;
        __builtin_amdgcn_s_waitcnt(0);
        unsigned nloc = b.st[0], nx = b.st[1];
        if (nloc == 0u) { xcd_barrier_complete(bar, b.x, nloc, nx); b.st[0] = nloc; b.st[1] = nx; }
        const unsigned old = xb_add(&bar[XB_XSUB(b.x)], 1u);
        const unsigned gen = old / nloc;
        if (old + 1u == (gen + 1u) * nloc) {
            __builtin_amdgcn_fence(__ATOMIC_RELEASE, "agent");
            asm volatile("s_waitcnt vmcnt(0)" ::: "memory");
            const unsigned og = xb_add(&bar[XB_TOP], 1u);
            const unsigned tg = og / nx;
            if (og + 1u == (tg + 1u) * nx) xb_add(&bar[XB_TOPGEN], 1u);
            else XB_SPIN(xb_ld(&bar[XB_TOPGEN]) == tg, bar);
            __builtin_amdgcn_fence(__ATOMIC_ACQUIRE, "agent");
            xb_add(&bar[XB_XGEN(b.x)], 1u);
            asm volatile("s_waitcnt vmcnt(0)" ::: "memory");
        } else {
            XB_SPIN(xb_ld(&bar[XB_XGEN(b.x)]) == gen, bar);
            __builtin_amdgcn_fence(__ATOMIC_ACQUIRE, "agent");
            asm volatile("s_waitcnt vmcnt(0)" ::: "memory");
        }
    }
    __syncthreads();
}
__device__ __forceinline__ void p0_transpose_item(const float* W, int K, int N, bf16* WT, int row_off, LAS float* scr, int item, int lane) {
    const int nblk = N / 32, kb = item / nblk, nb = item % nblk, k0 = 64 * kb, n0 = 32 * nb;
    float wv[32];
    const float* wp = W + (size_t)(k0 + (lane >> 5)) * N + n0 + (lane & 31);
#pragma unroll
    for (int i = 0; i < 32; ++i) wv[i] = __builtin_nontemporal_load(wp + (size_t)(2 * i) * N);
#pragma unroll
    for (int i = 0; i < 32; ++i) scr[(2 * i + (lane >> 5)) * 33 + (lane & 31)] = wv[i];
    LDS_WAIT(); asm volatile("" ::: "memory");
    const int c = lane & 7;
#pragma unroll
    for (int j = 0; j < 4; ++j) { const int n = (lane >> 3) + 8 * j; const LAS float* s = scr + (8 * c) * 33 + n;
        v4u o; o.x = pk2(s[0 * 33], s[1 * 33]); o.y = pk2(s[2 * 33], s[3 * 33]); o.z = pk2(s[4 * 33], s[5 * 33]); o.w = pk2(s[6 * 33], s[7 * 33]);
        *(GAS v4u*)(WT + (size_t)(row_off + n0 + n) * K + k0 + 8 * c) = o; }
    LDS_WAIT(); asm volatile("" ::: "memory");
}
constexpr int TI_IN = (DM / 64) * (N_IN / 32), TI_GLU = (SSMW / 64) * (SSMW / 32), TI_BR = (SSMW / 64) * (DM / 32), TI_O = (DM / 64) * (DM / 32), TI_UP = (DM / 64) * (NUP / 32), TI_DN = (DFF / 64) * (DM / 32);
constexpr int TI_LAYER = TI_IN + TI_GLU + 3 * TI_BR + TI_O + TI_UP + TI_DN, TI_ALL = DEPTH * TI_LAYER;
__device__ __forceinline__ void p0_transpose_any(const float* const* in, unsigned char* ws, LAS float* scr, int it, int lane) {
    const int l = it / TI_LAYER; int r = it % TI_LAYER;
    unsigned char* wl = ws + WS_W + (size_t)l * WB_LAYER;
    if (r < TI_IN) { p0_transpose_item(in[I_WIN] + (size_t)l * DM * N_IN, DM, N_IN, (bf16*)(wl + WB_IN), 0, scr, r, lane); return; } r -= TI_IN;
    if (r < TI_GLU) { p0_transpose_item(in[I_WGLU] + (size_t)l * SSMW * SSMW, SSMW, SSMW, (bf16*)(wl + WB_GLU), 0, scr, r, lane); return; } r -= TI_GLU;
    if (r < TI_BR) { p0_transpose_item(in[I_WSSM] + (size_t)l * SSMW * DM, SSMW, DM, (bf16*)(wl + WB_BR), 0, scr, r, lane); return; } r -= TI_BR;
    if (r < TI_BR) { p0_transpose_item(in[I_WATT] + (size_t)l * SSMW * DM, SSMW, DM, (bf16*)(wl + WB_BR), DM, scr, r, lane); return; } r -= TI_BR;
    if (r < TI_BR) { p0_transpose_item(in[I_WCNV] + (size_t)l * SSMW * DM, SSMW, DM, (bf16*)(wl + WB_BR), 2 * DM, scr, r, lane); return; } r -= TI_BR;
    if (r < TI_O) { p0_transpose_item(in[I_WO] + (size_t)l * DM * DM, DM, DM, (bf16*)(wl + WB_O), 0, scr, r, lane); return; } r -= TI_O;
    if (r < TI_UP) { const int n0 = 32 * (r % (NUP / 32));
        const int d0 = (n0 < DFF) ? 256 * (n0 / 128) + (n0 % 128) : 256 * ((n0 - DFF) / 128) + 128 + ((n0 - DFF) % 128);
        p0_transpose_item(in[I_WUP] + (size_t)l * DM * NUP, DM, NUP, (bf16*)(wl + WB_UP), d0 - n0, scr, r, lane); return; } r -= TI_UP;
    p0_transpose_item(in[I_WDOWN] + (size_t)l * DFF * DM, DFF, DM, (bf16*)(wl + WB_DN), 0, scr, r, lane);
}
constexpr int MOD_KS = 4, MOD_ITEMS = DEPTH * (NMOD / 64) * MOD_KS, MOD_PART = DEPTH * BATCH * NMOD;
__device__ __forceinline__ void p0_mod_item(const float* const* in, float* mod, const LAS float* condL, int item, int lane) {
    const int ks = item % MOD_KS, it2 = item / MOD_KS, l = it2 / (NMOD / 64), j = (it2 % (NMOD / 64)) * 64 + lane, kbeg = ks * (DM / MOD_KS);
    const float* wp = in[I_WMOD] + (size_t)l * DM * NMOD + (size_t)kbeg * NMOD + j;
    float acc[8];
#pragma unroll
    for (int b = 0; b < 8; ++b) acc[b] = 0.f;
    for (int k0 = 0; k0 < DM / MOD_KS; k0 += 16) {
        float w[16];
#pragma unroll
        for (int i = 0; i < 16; ++i) w[i] = __builtin_nontemporal_load(wp + (size_t)(k0 + i) * NMOD);
#pragma unroll
        for (int i = 0; i < 16; ++i) { const int k = kbeg + k0 + i; const f32x4 c0 = *(const LAS f32x4*)(condL + k * 8), c1 = *(const LAS f32x4*)(condL + k * 8 + 4);
            acc[0] += w[i] * c0[0]; acc[1] += w[i] * c0[1]; acc[2] += w[i] * c0[2]; acc[3] += w[i] * c0[3]; acc[4] += w[i] * c1[0]; acc[5] += w[i] * c1[1]; acc[6] += w[i] * c1[2]; acc[7] += w[i] * c1[3]; }
    }
#pragma unroll
    for (int b = 0; b < 8; ++b) mod[(size_t)ks * MOD_PART + (size_t)(l * BATCH + b) * NMOD + j] = acc[b];
}
__device__ __forceinline__ void p0_mod_reduce(const float* const* in, const float* part, float* mod, int gtid, int nthreads) {
    for (int i = gtid; i < DEPTH * BATCH * NMOD; i += nthreads) { const int j = i % NMOD, l = i / (BATCH * NMOD);
        mod[i] = ((part[i] + part[MOD_PART + i]) + (part[2 * (size_t)MOD_PART + i] + part[3 * (size_t)MOD_PART + i])) + in[I_BMOD][l * NMOD + j]; }
}
__device__ __forceinline__ void p0_prologue(const float* const* in, unsigned char* ws, LAS unsigned char* lds, int tid, int wave, int lane, int vcu, int G) {
    LAS float* condL = (LAS float*)lds;
    LAS float* scr = (LAS float*)(lds + 65536 + wave * 8448);
    for (int idx = tid; idx < BATCH * DM; idx += NWAVES * 64) { const int b = idx & 7, k = idx >> 3; const float cv = in[I_C][b * DM + k]; condL[idx] = cv / (1.0f + __expf(-cv)); }
    __syncthreads();
    const int gw2 = wave * G + vcu, NGW = G * NWAVES;
    for (int q = gw2; q < MOD_ITEMS; q += NGW) p0_mod_item(in, (float*)(ws + WS_MODP), condL, q, lane);
    for (int it = gw2; it < TI_ALL; it += NGW) p0_transpose_any(in, ws, scr, it, lane);
}

template <bool POST, bool XI_BF>
__device__ __forceinline__ void norm_load(const void* xi_, const bf16* y, int m, int lane, f32x4 (&xr)[4][2], v4u (&yr)[4]) {
#pragma unroll
    for (int j = 0; j < 4; ++j) { const int col = 8 * (lane + 64 * j);
        if (XI_BF) { const v4u w = *(const GAS v4u*)((const bf16*)xi_ + (size_t)m * DM + col); xr[j][0] = __builtin_bit_cast(f32x4, w); }
        else { const float* xi = (const float*)xi_; xr[j][0] = *(const GAS f32x4*)(xi + (size_t)m * DM + col); xr[j][1] = *(const GAS f32x4*)(xi + (size_t)m * DM + col + 4); }
        if (POST) yr[j] = *(const GAS v4u*)(y + (size_t)m * DM + col); }
}
template <bool POST, bool PRE, bool XI_BF, bool XO_BF>
__device__ __forceinline__ void norm_rows(const void* xi_, void* xo_, const bf16* y, const float* gpost, const float* gt, const float* gpre, const float* sc, const float* sh, bf16* h, int gw, int NGW, int lane) {
    constexpr int RPW = 8;
    for (int m0 = gw * RPW; m0 < M; m0 += NGW * RPW) {
        const int b = m0 / SEQ;
        f32x4 xr[4][2], xn[4][2]; v4u yr[4], yn[4];
        norm_load<POST, XI_BF>(xi_, y, m0, lane, xr, yr);
        for (int m = m0; m < m0 + RPW; ++m) {
            if (m + 1 < m0 + RPW) norm_load<POST, XI_BF>(xi_, y, m + 1, lane, xn, yn);
            float xv[4][8];
#pragma unroll
            for (int j = 0; j < 4; ++j) {
                if (XI_BF) unpack8(__builtin_bit_cast(v4u, xr[j][0]), xv[j]);
                else { xv[j][0] = xr[j][0][0]; xv[j][1] = xr[j][0][1]; xv[j][2] = xr[j][0][2]; xv[j][3] = xr[j][0][3]; xv[j][4] = xr[j][1][0]; xv[j][5] = xr[j][1][1]; xv[j][6] = xr[j][1][2]; xv[j][7] = xr[j][1][3]; } }
            if (POST) {
                float yv[4][8]; float ss = 0.f;
#pragma unroll
                for (int j = 0; j < 4; ++j) { unpack8(yr[j], yv[j]);
#pragma unroll
                    for (int e = 0; e < 8; ++e) ss += yv[j][e] * yv[j][e]; }
                const float rs = rsqrtf(wave_sum(ss) * (1.0f / DM) + RMS_EPS);
#pragma unroll
                for (int j = 0; j < 4; ++j) { const int col = 8 * (lane + 64 * j);
                    const f32x4 g0 = *(const GAS f32x4*)(gpost + col), g1 = *(const GAS f32x4*)(gpost + col + 4), t0 = *(const GAS f32x4*)(gt + (size_t)b * NMOD + col), t1 = *(const GAS f32x4*)(gt + (size_t)b * NMOD + col + 4);
#pragma unroll
                    for (int e = 0; e < 4; ++e) { xv[j][e] += t0[e] * (yv[j][e] * rs * g0[e]); xv[j][e + 4] += t1[e] * (yv[j][e + 4] * rs * g1[e]); }
                    if (XO_BF) { *(GAS v4u*)((bf16*)xo_ + (size_t)m * DM + col) = pack8f(xv[j]);
                        if (PRE) { float r[8]; unpack8(pack8f(xv[j]), r);
#pragma unroll
                            for (int e = 0; e < 8; ++e) xv[j][e] = r[e]; } }
                    else { float* xo = (float*)xo_; *(GAS f32x4*)(xo + (size_t)m * DM + col) = (f32x4){xv[j][0], xv[j][1], xv[j][2], xv[j][3]}; *(GAS f32x4*)(xo + (size_t)m * DM + col + 4) = (f32x4){xv[j][4], xv[j][5], xv[j][6], xv[j][7]}; } }
            }
            if (PRE) {
                float ss = 0.f;
#pragma unroll
                for (int j = 0; j < 4; ++j)
#pragma unroll
                    for (int e = 0; e < 8; ++e) ss += xv[j][e] * xv[j][e];
                const float rs = rsqrtf(wave_sum(ss) * (1.0f / DM) + RMS_EPS);
#pragma unroll
                for (int j = 0; j < 4; ++j) { const int col = 8 * (lane + 64 * j); float o[8];
                    const f32x4 g0 = *(const GAS f32x4*)(gpre + col), g1 = *(const GAS f32x4*)(gpre + col + 4), s0 = *(const GAS f32x4*)(sc + (size_t)b * NMOD + col), s1 = *(const GAS f32x4*)(sc + (size_t)b * NMOD + col + 4),
                                h0 = *(const GAS f32x4*)(sh + (size_t)b * NMOD + col), h1 = *(const GAS f32x4*)(sh + (size_t)b * NMOD + col + 4);
#pragma unroll
                    for (int e = 0; e < 4; ++e) { o[e] = xv[j][e] * rs * g0[e] * (1.0f + s0[e]) + h0[e]; o[e + 4] = xv[j][e + 4] * rs * g1[e] * (1.0f + s1[e]) + h1[e]; }
                    *(GAS v4u*)(h + (size_t)m * DM + col) = pack8f(o); }
            }
#pragma unroll
            for (int j = 0; j < 4; ++j) { xr[j][0] = xn[j][0]; xr[j][1] = xn[j][1]; yr[j] = yn[j]; }
        }
    }
}
__device__ __forceinline__ void ffn_fix_phase(const bf16* halo, bf16* act, const float* cw  , int gw, int NGW, int lane) {
    constexpr int NCH = DFF / 512, NBLK = M / 128;
    for (int it = gw; it < NCH * NBLK; it += NGW) {
        const int blk = it / NCH, ch = it % NCH, t0 = blk * 128, col = ch * 512 + lane * 8;
        float wa[3][8], wb[3][8];
#pragma unroll
        for (int k = 0; k < 3; ++k) { const f32x4 a0 = *(const GAS f32x4*)(cw + k * NUP + col), a1 = *(const GAS f32x4*)(cw + k * NUP + col + 4), b0 = *(const GAS f32x4*)(cw + k * NUP + DFF + col), b1 = *(const GAS f32x4*)(cw + k * NUP + DFF + col + 4);
#pragma unroll
            for (int e = 0; e < 4; ++e) { wa[k][e] = a0[e]; wa[k][e + 4] = a1[e]; wb[k][e] = b0[e]; wb[k][e + 4] = b1[e]; } }
        float am1[8], am2[8], bm1[8], bm2[8], a0[8], a1[8], b0[8], b1[8];
        if ((t0 % SEQ) == 0) {
#pragma unroll
            for (int e = 0; e < 8; ++e) { am1[e] = 0.f; am2[e] = 0.f; bm1[e] = 0.f; bm2[e] = 0.f; }
        } else { const bf16* hp = halo + (size_t)(blk - 1) * 4 * NUP;
            unpack8(*(const GAS v4u*)(hp + 3 * NUP + col), am1); unpack8(*(const GAS v4u*)(hp + 2 * NUP + col), am2);
            unpack8(*(const GAS v4u*)(hp + 3 * NUP + DFF + col), bm1); unpack8(*(const GAS v4u*)(hp + 2 * NUP + DFF + col), bm2); }
        { const bf16* hp = halo + (size_t)blk * 4 * NUP;
          unpack8(*(const GAS v4u*)(hp + col), a0); unpack8(*(const GAS v4u*)(hp + NUP + col), a1);
          unpack8(*(const GAS v4u*)(hp + DFF + col), b0); unpack8(*(const GAS v4u*)(hp + NUP + DFF + col), b1); }
        float o0[8], o1[8];
#pragma unroll
        for (int e = 0; e < 8; ++e) {
            const float ca0 = wa[0][e] * a0[e] + wa[1][e] * am1[e] + wa[2][e] * am2[e], cb0 = wb[0][e] * b0[e] + wb[1][e] * bm1[e] + wb[2][e] * bm2[e];
            const float ca1 = wa[0][e] * a1[e] + wa[1][e] * a0[e] + wa[2][e] * am1[e], cb1 = wb[0][e] * b1[e] + wb[1][e] * b0[e] + wb[2][e] * bm1[e];
            o0[e] = ca0 * __builtin_amdgcn_rcpf(1.0f + __expf(-ca0)) * cb0; o1[e] = ca1 * __builtin_amdgcn_rcpf(1.0f + __expf(-ca1)) * cb1; }
        *(GAS v4u*)(act + (size_t)t0 * DFF + col) = pack8f(o0); *(GAS v4u*)(act + (size_t)(t0 + 1) * DFF + col) = pack8f(o1);
    }
}
__device__ __forceinline__ void conv_mix_items(const bf16* proj, bf16* outc, const float* cw  , int first, int step, int lane) {
    for (int run = first; run < M / 64; run += step) {
        const int m0 = run * 64, col = lane * 8;
        float w[3][8];
#pragma unroll
        for (int k = 0; k < 3; ++k) { const f32x4 a0 = *(const GAS f32x4*)(cw + k * 512 + col), a1 = *(const GAS f32x4*)(cw + k * 512 + col + 4);
#pragma unroll
            for (int e = 0; e < 4; ++e) { w[k][e] = a0[e]; w[k][e + 4] = a1[e]; } }
        float z1[8], z2[8];
        if ((m0 % SEQ) == 0) {
#pragma unroll
            for (int e = 0; e < 8; ++e) { z1[e] = 0.f; z2[e] = 0.f; }
        } else {
            float p[8], q[8];
            unpack8(*(const GAS v4u*)(proj + (size_t)(m0 - 1) * N_IN + OFF_CC + col), p); unpack8(*(const GAS v4u*)(proj + (size_t)(m0 - 1) * N_IN + OFF_CH + col), q);
#pragma unroll
            for (int e = 0; e < 8; ++e) z1[e] = p[e] * q[e];
            unpack8(*(const GAS v4u*)(proj + (size_t)(m0 - 2) * N_IN + OFF_CC + col), p); unpack8(*(const GAS v4u*)(proj + (size_t)(m0 - 2) * N_IN + OFF_CH + col), q);
#pragma unroll
            for (int e = 0; e < 8; ++e) z2[e] = p[e] * q[e];
        }
#pragma unroll 4
        for (int t = 0; t < 64; ++t) {
            float p[8], q[8], bb[8], o[8];
            const bf16* rp = proj + (size_t)(m0 + t) * N_IN;
            unpack8(*(const GAS v4u*)(rp + OFF_CC + col), p); unpack8(*(const GAS v4u*)(rp + OFF_CH + col), q); unpack8(*(const GAS v4u*)(rp + OFF_CB + col), bb);
#pragma unroll
            for (int e = 0; e < 8; ++e) { const float z0 = p[e] * q[e]; o[e] = bb[e] * (w[0][e] * z0 + w[1][e] * z1[e] + w[2][e] * z2[e]); z2[e] = z1[e]; z1[e] = z0; }
            *(GAS v4u*)(outc + (size_t)(m0 + t) * 512 + col) = pack8f(o);
        }
    }
}
constexpr int SSM_UF = 0, SSM_HS = 32768, SSM_E = 32768 + 8 * 4608, SSM_LDS_END = SSM_E + 4096;
constexpr int ATT_VLDS = 81920;
static_assert(SSM_LDS_END <= ATT_VLDS && ATT_VLDS + 8 * 4608 <= RING_BYTES, "mixer LDS map");
__device__ __forceinline__ float gelu_tanh(float y) { const float z = 0.7978845608028654f * (y + 0.044715f * y * y * y); const float e = __expf(2.0f * z); const float th = 1.0f - 2.0f * __builtin_amdgcn_rcpf(1.0f + e); return 0.5f * y * (1.0f + th); }
__device__ __forceinline__ void ssm_stage_u(const bf16* proj, LAS float* Uf, int b, int g, int T0, int lane) {
#pragma unroll
    for (int i = 0; i < 2; ++i) { const int piece = lane + 64 * i, tt = piece >> 1, half = piece & 1;
        const v4u w = *(const GAS v4u*)(proj + (size_t)(b * SEQ + T0 + tt) * N_IN + g * 16 + half * 8); float f[8]; unpack8(w, f);
        *(LAS f32x4*)(Uf + tt * 16 + half * 8) = (f32x4){f[0], f[1], f[2], f[3]}; *(LAS f32x4*)(Uf + tt * 16 + half * 8 + 4) = (f32x4){f[4], f[5], f[6], f[7]}; }
    LDS_WAIT();
}
__device__ __forceinline__ void ssm_unit(const float* const* in, int l, int b, int g, const bf16* proj, bf16* gbuf, LAS unsigned char* lds, int wave, int lane) {
    const int n = lane, lg = l * NGRP + g, gn = lg * NST + n;
    const float dt = expf(in[I_LOGDT][lg]);
    const float ar = in[I_ARE][gn], ai = in[I_AIM][gn];
    const float mag = expf(ar * dt), ang = ai * dt;
    const float kq2 = rintf(ang * 0.15915494309189535f); float red = fmaf(-kq2, 6.2831854820251465f, ang); red = fmaf(-kq2, -1.7484555e-7f, red);
    const float lr = mag * cosf(red), li = mag * sinf(red);
    const float den = ar * ar + ai * ai, fre = ((lr - 1.0f) * ar + li * ai) / den, fim = (li * ar - (lr - 1.0f) * ai) / den;
    float bbr[16], bbi[16];
    { const float* bre = in[I_BRE] + (size_t)gn * 16; const float* bim = in[I_BIM] + (size_t)gn * 16;
#pragma unroll
      for (int q = 0; q < 4; ++q) { const f32x4 r4 = *(const GAS f32x4*)(bre + 4 * q), i4 = *(const GAS f32x4*)(bim + 4 * q);
#pragma unroll
          for (int e = 0; e < 4; ++e) { bbr[4 * q + e] = fre * r4[e] - fim * i4[e]; bbi[4 * q + e] = fre * i4[e] + fim * r4[e]; } } }
    const int cc = lane & 15, kq = lane >> 4;
    bf16x8 Cf[4];
#pragma unroll
    for (int kb = 0; kb < 4; ++kb) { const float* src = (kb < 2 ? in[I_CRE] : in[I_CIM]) + (size_t)(lg * 16 + cc) * NST + (kb & 1) * 32 + 8 * kq; const float sg = kb < 2 ? 1.0f : -1.0f;
        const f32x4 a = *(const GAS f32x4*)src, c4 = *(const GAS f32x4*)(src + 4);
        const unsigned w0 = pk2(sg * a[0], sg * a[1]), w1 = pk2(sg * a[2], sg * a[3]), w2 = pk2(sg * c4[0], sg * c4[1]), w3 = pk2(sg * c4[2], sg * c4[3]);
        Cf[kb] = __builtin_bit_cast(bf16x8, (v4u){w0, w1, w2, w3}); }
    const float dsk = in[I_SSMD][l * SSMW + g * 16 + cc];
    LAS float* Uf = (LAS float*)(lds + SSM_UF + wave * 4096);
    LAS bf16* Hs = (LAS bf16*)(lds + SSM_HS + wave * 4608);
    LAS float* E = (LAS float*)(lds + SSM_E);
    float hr = 0.f, hi = 0.f;
    for (int s = 0; s < 4; ++s) {
        ssm_stage_u(proj, Uf, b, g, 256 * wave + 64 * s, lane);
        for (int tt = 0; tt < 64; ++tt) {
            const f32x4 u0 = *(const LAS f32x4*)(Uf + tt * 16), u1 = *(const LAS f32x4*)(Uf + tt * 16 + 4), u2 = *(const LAS f32x4*)(Uf + tt * 16 + 8), u3 = *(const LAS f32x4*)(Uf + tt * 16 + 12);
            float xr = 0.f, xi = 0.f;
#pragma unroll
            for (int e = 0; e < 4; ++e) { xr += bbr[e] * u0[e]; xi += bbi[e] * u0[e]; xr += bbr[4 + e] * u1[e]; xi += bbi[4 + e] * u1[e]; xr += bbr[8 + e] * u2[e]; xi += bbi[8 + e] * u2[e]; xr += bbr[12 + e] * u3[e]; xi += bbi[12 + e] * u3[e]; }
            const float nr = lr * hr - li * hi + xr, ni = lr * hi + li * hr + xi; hr = nr; hi = ni;
        }
        asm volatile("" ::: "memory");
    }
    E[(wave * 64 + n) * 2] = hr; E[(wave * 64 + n) * 2 + 1] = hi;
    float pr = lr, pi = li;
#pragma unroll
    for (int q = 0; q < 8; ++q) { const float t = pr * pr - pi * pi; pi = 2.0f * pr * pi; pr = t; }
    __syncthreads();
    hr = 0.f; hi = 0.f;
    for (int j = 0; j < wave; ++j) { const float er = E[(j * 64 + n) * 2], ei = E[(j * 64 + n) * 2 + 1]; const float nr = pr * hr - pi * hi + er, ni = pr * hi + pi * hr + ei; hr = nr; hi = ni; }
    for (int s = 0; s < 4; ++s) {
        const int T0 = 256 * wave + 64 * s;
        ssm_stage_u(proj, Uf, b, g, T0, lane);
        for (int bt = 0; bt < 4; ++bt) {
#pragma unroll 4
            for (int t16 = 0; t16 < 16; ++t16) { const int tt = bt * 16 + t16;
                const f32x4 u0 = *(const LAS f32x4*)(Uf + tt * 16), u1 = *(const LAS f32x4*)(Uf + tt * 16 + 4), u2 = *(const LAS f32x4*)(Uf + tt * 16 + 8), u3 = *(const LAS f32x4*)(Uf + tt * 16 + 12);
                float xr = 0.f, xi = 0.f;
#pragma unroll
                for (int e = 0; e < 4; ++e) { xr += bbr[e] * u0[e]; xi += bbi[e] * u0[e]; xr += bbr[4 + e] * u1[e]; xi += bbi[4 + e] * u1[e]; xr += bbr[8 + e] * u2[e]; xi += bbi[8 + e] * u2[e]; xr += bbr[12 + e] * u3[e]; xi += bbi[12 + e] * u3[e]; }
                const float nr = lr * hr - li * hi + xr, ni = lr * hi + li * hr + xi; hr = nr; hi = ni;
                Hs[t16 * 136 + n] = (bf16)f2bf(hr); Hs[t16 * 136 + 64 + n] = (bf16)f2bf(hi); }
            LDS_WAIT();
            f32x4 Y = (f32x4){0.f, 0.f, 0.f, 0.f};
#pragma unroll
            for (int kb = 0; kb < 4; ++kb) { const bf16x8 a = *(const LAS bf16x8*)(Hs + cc * 136 + kb * 32 + kq * 8); Y = __builtin_amdgcn_mfma_f32_16x16x32_bf16(a, Cf[kb], Y, 0, 0, 0); }
#pragma unroll
            for (int i = 0; i < 4; ++i) { const int tt = bt * 16 + 4 * kq + i; const float uval = Uf[tt * 16 + cc]; const float yv = gelu_tanh(Y[i] + dsk * uval);
                gbuf[(size_t)(b * SEQ + T0 + tt) * SSMW + g * 16 + cc] = (bf16)f2bf(yv); }
            LDS_WAIT(); asm volatile("" ::: "memory");
        }
    }
}

__device__ __forceinline__ s16x4 vtr(const LAS unsigned char* p) { return __builtin_bit_cast(s16x4, __builtin_amdgcn_ds_read_tr16_b64_v4i16((LAS s16x4*)p)); }
__device__ __forceinline__ float xmax16(float v) { const unsigned u = __float_as_uint(v); auto r = __builtin_amdgcn_permlane16_swap(u, u, false, false); return fmaxf(__uint_as_float(r[0]), __uint_as_float(r[1])); }
__device__ __forceinline__ float xmax32(float v) { const unsigned u = __float_as_uint(v); auto r = __builtin_amdgcn_permlane32_swap(u, u, false, false); return fmaxf(__uint_as_float(r[0]), __uint_as_float(r[1])); }
__device__ __forceinline__ float xsum16(float v) { const unsigned u = __float_as_uint(v); auto r = __builtin_amdgcn_permlane16_swap(u, u, false, false); return __uint_as_float(r[0]) + __uint_as_float(r[1]); }
__device__ __forceinline__ float xsum32(float v) { const unsigned u = __float_as_uint(v); auto r = __builtin_amdgcn_permlane32_swap(u, u, false, false); return __uint_as_float(r[0]) + __uint_as_float(r[1]); }
struct AttnKV { bf16x8 k[2][2]; v4u v[4]; };
__device__ __forceinline__ void attn_load(AttnKV& t, const bf16* kbase, const bf16* vbase, int kt0, int rg, int sh, int lane) {
    const int col = lane & 15;
#pragma unroll
    for (int half = 0; half < 2; ++half) { int kp = kt0 + 16 * half + col; kp = kp < 0 ? 0 : kp; const bf16* kr = kbase + (size_t)(rg + (kp << sh)) * N_IN;
        t.k[half][0] = *(const GAS bf16x8*)kr; t.k[half][1] = *(const GAS bf16x8*)(kr + 32); }
#pragma unroll
    for (int i = 0; i < 4; ++i) { const int chunk = lane + 64 * i, row = chunk >> 3, c16 = chunk & 7; int kp = kt0 + row; kp = kp < 0 ? 0 : kp;
        t.v[i] = *(const GAS v4u*)(vbase + (size_t)(rg + (kp << sh)) * N_IN + c16 * 8); }
}
__device__ __forceinline__ void attn_tile(const bf16* proj, bf16* aout, LAS unsigned char* vlds, int b, int h, int r, int i0, int lane) {
    const int col = lane & 15, grp = lane >> 4;
    const size_t rowb = (size_t)b * SEQ;
    const int tq = r + 16 * (i0 + col);
    const bf16* qrow = proj + (rowb + tq) * N_IN + OFF_Q + h * 64 + grp * 8;
    bf16x8 Qf[3][2];
#pragma unroll
    for (int g = 0; g < 3; ++g)
#pragma unroll
        for (int dh = 0; dh < 2; ++dh) Qf[g][dh] = *(const GAS bf16x8*)(qrow + g * 512 + dh * 32);
    f32x4 acc[4];
#pragma unroll
    for (int d = 0; d < 4; ++d) acc[d] = (f32x4){0.f, 0.f, 0.f, 0.f};
    float mrun = -1e30f, lrun = 0.f;
    const float L2E = 1.4426950408889634f;
    const int tq4 = (lane & 15) >> 2, tp4 = lane & 3;
    const LAS unsigned char* vrd = vlds + (4 * grp + tq4) * 144 + tp4 * 8;
    LAS unsigned char* vwr = vlds + (lane >> 3) * 144 + (lane & 7) * 16;
#pragma unroll
    for (int g = 0; g < 3; ++g) {
        const int sh = 2 * g, dil = 1 << sh, rg = r & (dil - 1);
        const int qp = (tq - rg) >> sh;
        const int kstart = (g == 0) ? (16 * i0 - 128) : (g == 1 ? 4 * i0 - 128 : i0 - 144), ntile = (g == 0) ? 12 : (g == 1 ? 6 : 5);
        const float c_qk = 0.125f * L2E, c_b = exp2f(-(float)(g * 8 + h + 1) * (1.0f / 3.0f)) * (float)dil * L2E;
        const bf16* kbase = proj + rowb * N_IN + OFF_K + g * 512 + h * 64 + grp * 8;
        const bf16* vbase = proj + rowb * N_IN + OFF_V + g * 512 + h * 64;
        int ti = 0;
        while (kstart + 32 * ti + 32 <= 0) ++ti;
        AttnKV cur, nxt;
        attn_load(cur, kbase, vbase, kstart + 32 * ti, rg, sh, lane);
        for (; ti < ntile; ++ti) {
            const int kt0 = kstart + 32 * ti;
            if (ti + 1 < ntile) attn_load(nxt, kbase, vbase, kt0 + 32, rg, sh, lane);
            f32x4 S[2];
#pragma unroll
            for (int half = 0; half < 2; ++half) {
                S[half] = __builtin_amdgcn_mfma_f32_16x16x32_bf16(cur.k[half][0], Qf[g][0], (f32x4){0.f, 0.f, 0.f, 0.f}, 0, 0, 0);
                S[half] = __builtin_amdgcn_mfma_f32_16x16x32_bf16(cur.k[half][1], Qf[g][1], S[half], 0, 0, 0); }
#pragma unroll
            for (int i = 0; i < 4; ++i) *(LAS v4u*)(vwr + i * 8 * 144) = cur.v[i];
            float sc[8]; float mx = -1e30f;
#pragma unroll
            for (int half = 0; half < 2; ++half)
#pragma unroll
                for (int i = 0; i < 4; ++i) { const int kp = kt0 + 16 * half + 4 * grp + i, dist = qp - kp; const bool valid = (dist >= 0) && (dist <= 128) && (kp >= 0);
                    const float s = valid ? (S[half][i] * c_qk - c_b * (float)dist) : -1e30f; sc[half * 4 + i] = s; mx = fmaxf(mx, s); }
            mx = xmax32(xmax16(mx));
            const float mnew = fmaxf(mrun, mx), alpha = __builtin_amdgcn_exp2f(mrun - mnew);
            float p[8], psum = 0.f;
#pragma unroll
            for (int j = 0; j < 8; ++j) { p[j] = (sc[j] > -1e29f) ? __builtin_amdgcn_exp2f(sc[j] - mnew) : 0.f; psum += p[j]; }
            psum = xsum32(xsum16(psum));
            lrun = lrun * alpha + psum; mrun = mnew;
#pragma unroll
            for (int d = 0; d < 4; ++d) acc[d] = acc[d] * alpha;
            const bf16x8 Pf = __builtin_bit_cast(bf16x8, (v4u){pk2(p[0], p[1]), pk2(p[2], p[3]), pk2(p[4], p[5]), pk2(p[6], p[7])});
            LDS_WAIT();
#pragma unroll
            for (int d = 0; d < 4; ++d) { const s16x4 lo = vtr(vrd + d * 32), hi = vtr(vrd + 16 * 144 + d * 32);
                const bf16x8 Vf = (bf16x8){lo[0], lo[1], lo[2], lo[3], hi[0], hi[1], hi[2], hi[3]};
                acc[d] = __builtin_amdgcn_mfma_f32_16x16x32_bf16(Vf, Pf, acc[d], 0, 0, 0); }
            LDS_WAIT(); asm volatile("" ::: "memory");
            cur = nxt;
        }
    }
    const float inv = 1.0f / lrun;
    bf16* orow = aout + (rowb + tq) * SSMW + h * 64 + 4 * grp;
#pragma unroll
    for (int d = 0; d < 4; ++d) { v2u w; w.x = pk2(acc[d][0] * inv, acc[d][1] * inv); w.y = pk2(acc[d][2] * inv, acc[d][3] * inv); *(GAS v2u*)(orow + d * 16) = w; }
}
#ifndef STAGGER_PB
#define STAGGER_PB 0
#endif
#ifndef UPACT_ALIGN
#define UPACT_ALIGN true
#endif
#ifndef MK_PER_PHASE
#define MK_PER_PHASE 0
#endif
__device__ __forceinline__ int launder(int v) { asm volatile("" : "+v"(v)); return v; }
#define PH_LOCALS const int tid = launder((int)threadIdx.x), lane = tid & 63, wave = __builtin_amdgcn_readfirstlane(tid >> 6), gw = vcu * NWAVES + wave; (void)tid; (void)lane; (void)wave; (void)gw;
constexpr int PH_PER_LAYER = 11, N_PHASES = 1 + DEPTH * PH_PER_LAYER;
struct Args { const float* in[N_INPUTS]; float* out; unsigned char* ws; int ph_lo, ph_hi; };
static_assert(sizeof(Args) == N_INPUTS * 8 + 8 + 8 + 8, "Args has no padding");
__global__ void __launch_bounds__(NWAVES * 64, 2) trunk_fwd(Args args) {
    extern __shared__ __attribute__((aligned(16))) unsigned char lds_raw[];
    LAS unsigned char* lds = (LAS unsigned char*)lds_raw;
    volatile LAS unsigned* MISC = (volatile LAS unsigned*)(lds + MISC_OFF);
    const int G = gridDim.x, bx = blockIdx.x, vcu = (G % 8 == 0) ? (bx % 8) * (G / 8) + bx / 8 : bx;
    const int NGW = G * NWAVES;
    unsigned char* ws = args.ws;
    const float* const* in = args.in;
    for (int u = threadIdx.x; u < (LDS_BYTES - MISC_OFF) / 4; u += NWAVES * 64) MISC[u] = 0u;
    __syncthreads();
    unsigned* barw = (unsigned*)(ws + WS_CTL) + CW_BAR;
    XcdBarrier bar; bar.bar = barw; bar.x = 0; bar.st = nullptr;
    if (!MK_PER_PHASE) bar = xcd_barrier_post(barw, MISC + 8);
    const int lo = args.ph_lo, hi = args.ph_hi;
#ifndef PH_MASK
#define PH_MASK 0xFFFF
#endif
#define EN(k) (((PH_MASK) >> (k)) & 1)
#ifndef REP_MASK
#define REP_MASK 0
#endif
#define NREP(k) (1 + (((REP_MASK) >> (k)) & 1))
#define PH_IN(id) (lo <= (id) && (id) < hi)
#define PH_SEAM(id) do { if ((id) + 1 < hi) { if (!MK_PER_PHASE) xcd_barrier(bar); } } while (0)
    float* mod = (float*)(ws + WS_MOD);
    bf16* Hb = (bf16*)(ws + WS_H); bf16* PJ = (bf16*)(ws + WS_PROJ); bf16* UP = (bf16*)(ws + WS_PROJ); bf16* ACT = (bf16*)(ws + WS_ACT);
    bf16* GB = (bf16*)(ws + WS_G); bf16* A3 = (bf16*)(ws + WS_A3); bf16* MG = (bf16*)(ws + WS_MG); bf16* YB = (bf16*)(ws + WS_Y);
    float* xout = args.out; bf16* XB = (bf16*)(ws + WS_XB);

    if (EN(0) && PH_IN(0)) for (int rp = 0; rp < NREP(0); ++rp) { PH_LOCALS; p0_prologue(in, ws, lds, tid, wave, lane, vcu, G); PH_SEAM(0); }

    for (int l = 0; l < DEPTH; ++l) {
        const int pb = 1 + l * PH_PER_LAYER;
        const unsigned char* wl = ws + WS_W + (size_t)l * WB_LAYER;
        const float* modl = mod + (size_t)l * BATCH * NMOD;
        if (l == 0 && PH_IN(pb + 0) && EN(1)) { PH_LOCALS;
            p0_mod_reduce(in, (const float*)(ws + WS_MODP), mod, bx * (NWAVES * 64) + tid, G * NWAVES * 64);
            if (!MK_PER_PHASE) xcd_barrier(bar); else {   }
            norm_rows<false, true, false, false>(in[I_X], nullptr, nullptr, nullptr, nullptr, in[I_GPRE_MIX] + l * DM, modl + DM, modl, Hb, gw, NGW, lane);
            PH_SEAM(pb + 0);
        }
        if (PH_IN(pb + 1) && EN(2)) for (int rp = 0; rp < NREP(2); ++rp) { PH_LOCALS;
#if STAGGER_PB
            if (bx >= G / 2) { for (int s = 0; s < STAGGER_PB; ++s) __builtin_amdgcn_s_sleep(127); }
#endif
            pg8::Gemm g{Hb, (const bf16*)(wl + WB_IN), M, N_IN, DM}; pg8::StaticOrder S; S.init(M, N_IN, G, bx);
            pg8::EpiIn E{PJ, N_IN, in[I_BGATE] + (size_t)l * 3 * DM, OFF_GATE / 256};
            pg8::gemm_phase<pg8::EpiIn, pg8::StaticOrder, true, true>(lds, g, S, E);
            PH_SEAM(pb + 1);
        }
        if (PH_IN(pb + 2) && EN(3)) { PH_LOCALS;
            for (int rep = 0; rep < NREP(12); ++rep)
            for (int uidx = vcu; uidx < BATCH * NGRP; uidx += G) { ssm_unit(in, l, uidx / NGRP, uidx % NGRP, PJ, GB, lds, wave, lane); __syncthreads(); }
            for (int rep = 0; rep < NREP(13); ++rep)
            { LAS unsigned char* vl = lds + ATT_VLDS + wave * 4608; int k = 0;
              for (int T = gw; T < BATCH * 8 * 16 * 8; T += NGW, ++k) { const int it = ((T & 7) + 2 * k) & 7, r = (T >> 3) & 15, bh = T >> 7;
                  attn_tile(PJ, A3 + (size_t)M * SSMW, vl, bh >> 3, bh & 7, r, 16 * it, lane); } }
            for (int rep = 0; rep < NREP(14); ++rep)
            conv_mix_items(PJ, A3 + (size_t)2 * M * SSMW, in[I_CONVW] + (size_t)l * 3 * SSMW, gw, NGW, lane);
            PH_SEAM(pb + 2);
        }
        if (PH_IN(pb + 3) && EN(4)) for (int rp = 0; rp < NREP(4); ++rp) { PH_LOCALS;
            pg8::Gemm g{GB, (const bf16*)(wl + WB_GLU), M, SSMW, SSMW}; pg8::StaticOrder S; S.init(M, SSMW, G, bx);
            pg8::EpiGlu E{GB, A3, SSMW, in[I_BGLU] + (size_t)l * SSMW};
            pg8::gemm_phase<pg8::EpiGlu, pg8::StaticOrder, true, true>(lds, g, S, E);
            PH_SEAM(pb + 3);
        }
        if (PH_IN(pb + 4) && EN(5)) for (int rp = 0; rp < NREP(5); ++rp) { PH_LOCALS;
            pg8::Gemm g{A3, (const bf16*)(wl + WB_BR), M, DM, SSMW}; pg8::BrTripleOrder S; S.init(M, DM, G, bx);
            pg8::EpiBr E{PJ + OFF_GATE, N_IN, MG, DM};
            pg8::gemm_phase<pg8::EpiBr, pg8::BrTripleOrder, true, true>(lds, g, S, E);
            PH_SEAM(pb + 4);
        }
        if (PH_IN(pb + 5) && EN(6)) for (int rp = 0; rp < NREP(6); ++rp) { PH_LOCALS;
            pg8::Gemm g{MG, (const bf16*)(wl + WB_O), M, DM, DM}; pg8::StaticOrder S; S.init(M, DM, G, bx);
            pg8::EpiStore E{YB, DM};
            pg8::gemm_phase<pg8::EpiStore, pg8::StaticOrder, true, true>(lds, g, S, E);
            PH_SEAM(pb + 5);
        }
        if (PH_IN(pb + 6) && EN(7)) { PH_LOCALS;
            if (l == 0) norm_rows<true, true, false, true>(in[I_X], XB, YB, in[I_GPOST_MIX] + l * DM, modl + 2 * DM, in[I_GPRE_FFN] + l * DM, modl + 4 * DM, modl + 3 * DM, Hb, gw, NGW, lane);
            else norm_rows<true, true, true, true>(XB, XB, YB, in[I_GPOST_MIX] + l * DM, modl + 2 * DM, in[I_GPRE_FFN] + l * DM, modl + 4 * DM, modl + 3 * DM, Hb, gw, NGW, lane);
            PH_SEAM(pb + 6);
        }
        if (PH_IN(pb + 7) && EN(8)) for (int rp = 0; rp < NREP(8); ++rp) { PH_LOCALS;
            pg8::Gemm g{Hb, (const bf16*)(wl + WB_UP), M, NUP, DM}; pg8::StaticOrder S; S.init(M, NUP, G, bx);
            pg8::EpiUpAct E{ACT, DFF, in[I_FCONVW] + (size_t)l * 3 * NUP, UP  };
            pg8::gemm_phase<pg8::EpiUpAct, pg8::StaticOrder, UPACT_ALIGN, true>(lds, g, S, E);
            PH_SEAM(pb + 7);
        }
        if (PH_IN(pb + 8) && EN(9)) for (int rp = 0; rp < NREP(9); ++rp) { PH_LOCALS; ffn_fix_phase(UP, ACT, in[I_FCONVW] + (size_t)l * 3 * NUP, gw, NGW, lane); PH_SEAM(pb + 8); }
        if (PH_IN(pb + 9) && EN(10)) for (int rp = 0; rp < NREP(10); ++rp) { PH_LOCALS;
            pg8::Gemm g{ACT, (const bf16*)(wl + WB_DN), M, DM, DFF}; pg8::StaticOrder S; S.init(M, DM, G, bx);
            pg8::EpiStore E{YB, DM};
            pg8::gemm_phase<pg8::EpiStore, pg8::StaticOrder, true, true>(lds, g, S, E);
            PH_SEAM(pb + 9);
        }
        if (PH_IN(pb + 10) && EN(11)) { PH_LOCALS;
            if (l + 1 < DEPTH) norm_rows<true, true, true, true>(XB, XB, YB, in[I_GPOST_FFN] + l * DM, modl + 5 * DM, in[I_GPRE_MIX] + (l + 1) * DM, modl + BATCH * NMOD + DM, modl + BATCH * NMOD, Hb, gw, NGW, lane);
            else norm_rows<true, false, true, false>(XB, xout, YB, in[I_GPOST_FFN] + l * DM, modl + 5 * DM, nullptr, nullptr, nullptr, nullptr, gw, NGW, lane);
            PH_SEAM(pb + 10);
        }
    }
#undef PH_IN
#undef PH_SEAM
}


#ifndef DBG_STOP
#define DBG_STOP -1
#endif
#ifndef DBG_BUF
#define DBG_BUF 0
#endif
__global__ void __launch_bounds__(256) dbg_dump(const bf16* src, int ld, int col0, int ncol, int outc0, float* out) {
    for (size_t i = (size_t)blockIdx.x * 256 + threadIdx.x; i < (size_t)M * ncol; i += (size_t)gridDim.x * 256) { const size_t m = i / ncol; const int c = (int)(i % ncol);
        out[m * DM + outc0 + c] = __uint_as_float(((unsigned)src[m * ld + col0 + c]) << 16); }
}
extern "C" void kernel_launch(void* const* d_in, const int* in_sizes, int n_in, void* d_out, int out_size, void* d_ws, size_t ws_size, hipStream_t stream) {
    static int grid = 0;
    if (grid == 0) {
        if (n_in != N_INPUTS || in_sizes[0] != M * DM || out_size != M * DM || ws_size < WS_END) { fprintf(stderr, "kernel_launch: unexpected shapes (n_in %d, in0 %d, out %d, ws %zu < %zu); nothing launched\n", n_in, n_in > 0 ? in_sizes[0] : -1, out_size, ws_size, (size_t)WS_END); grid = -1; return; }
        int dev = 0, cus = 0, per_cu = 0;
        if (hipGetDevice(&dev) != hipSuccess || hipDeviceGetAttribute(&cus, hipDeviceAttributeMultiprocessorCount, dev) != hipSuccess) { fprintf(stderr, "kernel_launch: device query failed\n"); grid = -1; return; }
        if (hipFuncSetAttribute((const void*)trunk_fwd, hipFuncAttributeMaxDynamicSharedMemorySize, LDS_BYTES) != hipSuccess) { fprintf(stderr, "kernel_launch: hipFuncSetAttribute failed\n"); grid = -1; return; }
        if (hipOccupancyMaxActiveBlocksPerMultiprocessor(&per_cu, (const void*)trunk_fwd, NWAVES * 64, LDS_BYTES) != hipSuccess || per_cu < 1) { fprintf(stderr, "kernel_launch: occupancy query reports %d blocks per CU\n", per_cu); }
        (void)hipGetLastError();
        grid = cus;
    }
    if (grid < 0) return;
    if (hipMemsetAsync((char*)d_ws + WS_CTL, 0, CTL_ZERO_BYTES, stream) != hipSuccess) { fprintf(stderr, "kernel_launch: memset failed\n"); return; }
    Args a{};
    for (int i = 0; i < N_INPUTS; ++i) a.in[i] = (const float*)d_in[i];
    a.out = (float*)d_out; a.ws = (unsigned char*)d_ws;
#if MK_PER_PHASE
    for (int p = 0; p < N_PHASES; ++p) {
        if (p > 0 && ((p - 1) % PH_PER_LAYER) == 0 && p != 1) continue;
        a.ph_lo = p; a.ph_hi = p + 1;
        hipLaunchKernelGGL(trunk_fwd, dim3(grid), dim3(NWAVES * 64), LDS_BYTES, stream, a);
        if (p == DBG_STOP) {
            unsigned char* w = (unsigned char*)d_ws; float* o = (float*)d_out;
            if (DBG_BUF == 0) hipLaunchKernelGGL(dbg_dump, dim3(2048), dim3(256), 0, stream, (const bf16*)(w + WS_H), DM, 0, DM, 0, o);
            if (DBG_BUF == 1) hipLaunchKernelGGL(dbg_dump, dim3(2048), dim3(256), 0, stream, (const bf16*)(w + WS_PROJ), N_IN, 0, DM, 0, o);
            if (DBG_BUF == 2) hipLaunchKernelGGL(dbg_dump, dim3(2048), dim3(256), 0, stream, (const bf16*)(w + WS_PROJ), N_IN, N_IN - DM, DM, 0, o);
            if (DBG_BUF == 3) { hipLaunchKernelGGL(dbg_dump, dim3(2048), dim3(256), 0, stream, (const bf16*)(w + WS_G), SSMW, 0, SSMW, 0, o);
                                hipLaunchKernelGGL(dbg_dump, dim3(2048), dim3(256), 0, stream, (const bf16*)(w + WS_A3), SSMW, 0, SSMW, 512, o);
                                hipLaunchKernelGGL(dbg_dump, dim3(2048), dim3(256), 0, stream, (const bf16*)(w + WS_A3) + (size_t)M * SSMW, SSMW, 0, SSMW, 1024, o);
                                hipLaunchKernelGGL(dbg_dump, dim3(2048), dim3(256), 0, stream, (const bf16*)(w + WS_A3) + (size_t)2 * M * SSMW, SSMW, 0, SSMW, 1536, o); }
            if (DBG_BUF == 4) hipLaunchKernelGGL(dbg_dump, dim3(2048), dim3(256), 0, stream, (const bf16*)(w + WS_MG), DM, 0, DM, 0, o);
            if (DBG_BUF == 5) hipLaunchKernelGGL(dbg_dump, dim3(2048), dim3(256), 0, stream, (const bf16*)(w + WS_Y), DM, 0, DM, 0, o);
            if (DBG_BUF == 6) hipLaunchKernelGGL(dbg_dump, dim3(2048), dim3(256), 0, stream, (const bf16*)(w + WS_ACT), DFF, 0, DM, 0, o);
            break;
        }
    }
#else
    a.ph_lo = 0; a.ph_hi = N_PHASES;
    hipLaunchKernelGGL(trunk_fwd, dim3(grid), dim3(NWAVES * 64), LDS_BYTES, stream, a);
#endif
    const hipError_t le = hipPeekAtLastError();
    if (le != hipSuccess) fprintf(stderr, "kernel_launch: launch failed: %s\n", hipGetErrorName(le));
}
```

```cpp
#include <hip/hip_runtime.h>
#include <cstdio>
#include <cstdint>
namespace pg8 {
#define PG8_LAS __attribute__((address_space(3)))
typedef unsigned short bf16_t;
typedef short bf16x8 __attribute__((ext_vector_type(8)));
typedef float f32x4 __attribute__((ext_vector_type(4)));
typedef unsigned u32x4 __attribute__((ext_vector_type(4)));
constexpr int BM = 256, BK = 64, HALF = 128, HTB = HALF * BK * 2  , STAGE_BYTES = 8 * HTB, NXCD = 8, WGM = 8;

__host__ __device__ __forceinline__ int lds_byte(int r, int c) { const int st = (r >> 4) * 2 + (c >> 5), rr = r & 15, cc = c & 31, ob = rr * 64 + cc * 2; return st * 1024 + (ob ^ (((ob >> 9) & 1) << 5)); }
__host__ __device__ __forceinline__ void stage_rc(int b, int& R, int& C) { const int st = b / 1024, sb = b % 1024, swz = sb ^ (((sb >> 9) & 1) << 5); R = (st >> 1) * 16 + swz / 64; C = (st & 1) * 32 + (swz % 64) / 2; }
__host__ __device__ __forceinline__ int perm32(int rho) { const int n = rho >> 4, i = rho & 15; return 8 * (i >> 2) + 4 * n + (i & 3); }

struct Unit { int pm, pn; };
struct Gemm { const bf16_t* A; const bf16_t* Bt; int M, N, K; };

struct StaticOrder {
    int nM, nN, nwg, G, c;
    __host__ __device__ void init(int M, int N, int G_, int c_) { nM = M / BM; nN = N / BM; nwg = nM * nN; G = G_; c = c_; }
    __host__ __device__ bool next(int i, Unit& u) const {
        const long L = (long)i * G + c; if (L >= nwg) return false;
        int wgid = (int)L; { const int q = nwg / NXCD, r = nwg % NXCD, xcd = wgid % NXCD, off = wgid / NXCD; wgid = (xcd < r ? xcd * (q + 1) : r * (q + 1) + (xcd - r) * q) + off; }
        const int nig = WGM * nN, gid = wgid / nig, fm = gid * WGM, gsz = (nM - fm) < WGM ? (nM - fm) : WGM;
        u.pm = fm + ((wgid % nig) % gsz); u.pn = (wgid % nig) / gsz; return true;
    }
    __device__ __forceinline__ void a_ready(const Unit&) const {}
    __device__ __forceinline__ void done(const Unit&) const {}
};

typedef float cvt_f32x2 __attribute__((ext_vector_type(2))); typedef __bf16 cvt_bf16x2 __attribute__((ext_vector_type(2)));
__device__ __forceinline__ unsigned cvt_pk_bf16(float lo, float hi) { cvt_f32x2 v = {lo, hi}; cvt_bf16x2 b = __builtin_convertvector(v, cvt_bf16x2); return __builtin_bit_cast(unsigned, b); }
__device__ __forceinline__ float sigm(float x) { return __builtin_amdgcn_rcpf(1.0f + __expf(-x)); }
__device__ __forceinline__ float bflo(unsigned w) { return __uint_as_float(w << 16); }
__device__ __forceinline__ float bfhi(unsigned w) { return __uint_as_float(w & 0xffff0000u); }
__device__ __forceinline__ u32x4 pack8(const f32x4& v0, const f32x4& v1) { u32x4 w; w.x = cvt_pk_bf16(v0[0], v0[1]); w.y = cvt_pk_bf16(v0[2], v0[3]); w.z = cvt_pk_bf16(v1[0], v1[1]); w.w = cvt_pk_bf16(v1[2], v1[3]); return w; }
#ifndef OUT_NT
#define OUT_NT 1
#endif
__device__ __forceinline__ void st_out(u32x4* p, const u32x4 v) { if (OUT_NT) __builtin_nontemporal_store(v, p); else *p = v; }
struct EpiStore {
    static constexpr bool PERM = true, AFTER_DRAIN = false, ASWAP = false;
    bf16_t* O; int ldc;
    __device__ __forceinline__ void operator()(const f32x4 (&acc)[2][2][4][2], const Unit& u, int wr, int wc, int fr, int fq) const {
        const int row0 = u.pm * BM + wr * 64 + fr, col0 = u.pn * BM + wc * 32 + 8 * fq;
#pragma unroll
        for (int ai = 0; ai < 2; ++ai)
#pragma unroll
            for (int m = 0; m < 4; ++m) { bf16_t* rowp = O + (size_t)(row0 + ai * HALF + m * 16) * ldc + col0;
#pragma unroll
                for (int bj = 0; bj < 2; ++bj) st_out((u32x4*)(rowp + bj * HALF), pack8(acc[ai][bj][m][0], acc[ai][bj][m][1])); }
    }
};
struct EpiIn {
    static constexpr bool PERM = true, AFTER_DRAIN = false, ASWAP = false;
    bf16_t* O; int ldc; const float* bgate; int gate_tile0;
    __device__ __forceinline__ void operator()(const f32x4 (&acc)[2][2][4][2], const Unit& u, int wr, int wc, int fr, int fq) const {
        const int row0 = u.pm * BM + wr * 64 + fr, col0 = u.pn * BM + wc * 32 + 8 * fq;
        if (u.pn >= gate_tile0) {
            const float* bp = bgate + (col0 - gate_tile0 * BM);
            f32x4 bv[2][2];
#pragma unroll
            for (int bj = 0; bj < 2; ++bj)
#pragma unroll
                for (int n = 0; n < 2; ++n) bv[bj][n] = *(const f32x4*)(bp + bj * HALF + 4 * n);
#pragma unroll
            for (int ai = 0; ai < 2; ++ai)
#pragma unroll
                for (int m = 0; m < 4; ++m) { bf16_t* rowp = O + (size_t)(row0 + ai * HALF + m * 16) * ldc + col0;
#pragma unroll
                    for (int bj = 0; bj < 2; ++bj) { f32x4 v0 = acc[ai][bj][m][0] + bv[bj][0], v1 = acc[ai][bj][m][1] + bv[bj][1];
#pragma unroll
                        for (int j = 0; j < 4; ++j) { v0[j] = sigm(v0[j]); v1[j] = sigm(v1[j]); }
                        st_out((u32x4*)(rowp + bj * HALF), pack8(v0, v1)); } }
        } else {
#pragma unroll
            for (int ai = 0; ai < 2; ++ai)
#pragma unroll
                for (int m = 0; m < 4; ++m) { bf16_t* rowp = O + (size_t)(row0 + ai * HALF + m * 16) * ldc + col0;
#pragma unroll
                    for (int bj = 0; bj < 2; ++bj) st_out((u32x4*)(rowp + bj * HALF), pack8(acc[ai][bj][m][0], acc[ai][bj][m][1])); }
        }
    }
};
struct EpiGlu {
    static constexpr bool PERM = true, AFTER_DRAIN = false, ASWAP = false;
    const bf16_t* G; bf16_t* O; int ldc; const float* bias;
    __device__ __forceinline__ void operator()(const f32x4 (&acc)[2][2][4][2], const Unit& u, int wr, int wc, int fr, int fq) const {
        const int row0 = u.pm * BM + wr * 64 + fr, col0 = u.pn * BM + wc * 32 + 8 * fq;
        f32x4 bv[2][2];
#pragma unroll
        for (int bj = 0; bj < 2; ++bj)
#pragma unroll
            for (int n = 0; n < 2; ++n) bv[bj][n] = *(const f32x4*)(bias + col0 + bj * HALF + 4 * n);
#pragma unroll
        for (int ai = 0; ai < 2; ++ai) {
            u32x4 gw[4][2];
#pragma unroll
            for (int m = 0; m < 4; ++m)
#pragma unroll
                for (int bj = 0; bj < 2; ++bj) gw[m][bj] = *(const u32x4*)(G + (size_t)(row0 + ai * HALF + m * 16) * ldc + col0 + bj * HALF);
#pragma unroll
            for (int m = 0; m < 4; ++m) { const size_t off = (size_t)(row0 + ai * HALF + m * 16) * ldc + col0;
#pragma unroll
                for (int bj = 0; bj < 2; ++bj) { const u32x4 g4 = gw[m][bj];
                    f32x4 v0 = acc[ai][bj][m][0] + bv[bj][0], v1 = acc[ai][bj][m][1] + bv[bj][1];
                    v0[0] = bflo(g4.x) * sigm(v0[0]); v0[1] = bfhi(g4.x) * sigm(v0[1]); v0[2] = bflo(g4.y) * sigm(v0[2]); v0[3] = bfhi(g4.y) * sigm(v0[3]);
                    v1[0] = bflo(g4.z) * sigm(v1[0]); v1[1] = bfhi(g4.z) * sigm(v1[1]); v1[2] = bflo(g4.w) * sigm(v1[2]); v1[3] = bfhi(g4.w) * sigm(v1[3]);
                    *(u32x4*)(O + off + bj * HALF) = pack8(v0, v1); } }
        }
    }
};
struct EpiBr {
    static constexpr bool PERM = true, AFTER_DRAIN = false, ASWAP = false;
    const bf16_t* gates; int ldg; bf16_t* Mg; int ldm;
    __device__ __forceinline__ void operator()(const f32x4 (&acc)[2][2][4][2], const Unit& u, int wr, int wc, int fr, int fq) const {
        const int br = u.pm >> 6, pm = u.pm & 63, pn = u.pn & 7; const bool accum = (br != 1);
        const int row0 = pm * BM + wr * 64 + fr, col0 = pn * BM + wc * 32 + 8 * fq;
#pragma unroll
        for (int ai = 0; ai < 2; ++ai) {
            u32x4 gw[4][2], ow[4][2];
#pragma unroll
            for (int m = 0; m < 4; ++m)
#pragma unroll
                for (int bj = 0; bj < 2; ++bj) { const int row = row0 + ai * HALF + m * 16;
                    gw[m][bj] = *(const u32x4*)(gates + (size_t)row * ldg + br * ldm + col0 + bj * HALF);
                    if (accum) ow[m][bj] = *(const u32x4*)(Mg + (size_t)row * ldm + col0 + bj * HALF); }
#pragma unroll
            for (int m = 0; m < 4; ++m)
#pragma unroll
                for (int bj = 0; bj < 2; ++bj) { const int row = row0 + ai * HALF + m * 16; const u32x4 g4 = gw[m][bj];
                    f32x4 v0 = acc[ai][bj][m][0], v1 = acc[ai][bj][m][1];
                    v0[0] *= bflo(g4.x); v0[1] *= bfhi(g4.x); v0[2] *= bflo(g4.y); v0[3] *= bfhi(g4.y); v1[0] *= bflo(g4.z); v1[1] *= bfhi(g4.z); v1[2] *= bflo(g4.w); v1[3] *= bfhi(g4.w);
                    if (accum) { const u32x4 o4 = ow[m][bj];
                        v0[0] += bflo(o4.x); v0[1] += bfhi(o4.x); v0[2] += bflo(o4.y); v0[3] += bfhi(o4.y); v1[0] += bflo(o4.z); v1[1] += bfhi(o4.z); v1[2] += bflo(o4.w); v1[3] += bfhi(o4.w); }
                    *(u32x4*)(Mg + (size_t)row * ldm + col0 + bj * HALF) = pack8(v0, v1); }
        }
    }
};
typedef float f32x2 __attribute__((ext_vector_type(2))); typedef unsigned u32x2 __attribute__((ext_vector_type(2)));
__device__ __forceinline__ unsigned dpp_shr1(unsigned old, unsigned v) { return (unsigned)__builtin_amdgcn_update_dpp((int)old, (int)v, 0x111, 0xF, 0xF, false); }
__device__ __forceinline__ unsigned dpp_shr2(unsigned old, unsigned v) { return (unsigned)__builtin_amdgcn_update_dpp((int)old, (int)v, 0x112, 0xF, 0xF, false); }
__device__ __forceinline__ unsigned dpp_ror1(unsigned v) { return (unsigned)__builtin_amdgcn_update_dpp(0, (int)v, 0x121, 0xF, 0xF, true); }
__device__ __forceinline__ unsigned dpp_ror2(unsigned v) { return (unsigned)__builtin_amdgcn_update_dpp(0, (int)v, 0x122, 0xF, 0xF, true); }
struct EpiUpAct {
    static constexpr bool PERM = true, AFTER_DRAIN = false, ASWAP = true;
    bf16_t* ACT; int dff; const float* cw; bf16_t* halo;
    __device__ __forceinline__ void operator()(const f32x4 (&acc)[2][2][4][2], const Unit& u, int wr_, int wc_, int fr_, int fq_) const {
        int tl = threadIdx.x; asm volatile("" : "+v"(tl));
        const int lane = tl & 63, wid = tl >> 6, wr = wid >> 2, wc = wid & 3, fr = lane & 15, fq = lane >> 4; (void)wr_; (void)wc_; (void)fr_; (void)fq_;
        const int nup = 2 * dff, j0 = u.pn * 128 + wc * 32 + 8 * fq;
        const int tok0 = u.pm * BM + wr * 128;
        unsigned pk[8][2][2][2];
#pragma unroll
        for (int q = 0; q < 8; ++q)
#pragma unroll
            for (int bj = 0; bj < 2; ++bj)
#pragma unroll
                for (int n = 0; n < 2; ++n) { const f32x4 v = acc[q >> 2][bj][q & 3][n]; pk[q][bj][n][0] = cvt_pk_bf16(v[0], v[1]); pk[q][bj][n][1] = cvt_pk_bf16(v[2], v[3]); }
        __builtin_amdgcn_sched_barrier(0);
        { const int blk = tok0 >> 7;
          if (fr < 2) {
#pragma unroll
              for (int bj = 0; bj < 2; ++bj) *(u32x4*)(halo + ((size_t)blk * 4 + fr) * nup + bj * dff + j0) = (u32x4){pk[0][bj][0][0], pk[0][bj][0][1], pk[0][bj][1][0], pk[0][bj][1][1]}; }
          if (fr >= 14) {
#pragma unroll
              for (int bj = 0; bj < 2; ++bj) *(u32x4*)(halo + ((size_t)blk * 4 + fr - 12) * nup + bj * dff + j0) = (u32x4){pk[7][bj][0][0], pk[7][bj][0][1], pk[7][bj][1][0], pk[7][bj][1][1]}; } }
        __builtin_amdgcn_sched_barrier(0);
        unsigned op[8][2][2];
#pragma unroll
        for (int n = 0; n < 2; ++n)
#pragma unroll
            for (int h = 0; h < 2; ++h) {
                f32x2 wa[3], wb[3];
                { int wo = j0 + 4 * n + 2 * h; asm volatile("" : "+v"(wo));
#pragma unroll
                  for (int k = 0; k < 3; ++k) { wa[k] = *(const __attribute__((address_space(1))) f32x2*)(cw + wo + k * nup); wb[k] = *(const __attribute__((address_space(1))) f32x2*)(cw + wo + k * nup + dff); } }
                unsigned ra1 = 0u, ra2 = 0u, rb1 = 0u, rb2 = 0u;
#pragma unroll
                for (int q = 0; q < 8; ++q) { unsigned a = pk[q][0][n][h], b = pk[q][1][n][h];
                    if (q > 0) asm volatile("" : "+v"(a), "+v"(b), "+v"(op[q - 1][n][h])); else asm volatile("" : "+v"(a), "+v"(b));
                    const unsigned pa1 = dpp_shr1(ra1, a), pa2 = dpp_shr2(ra2, a), pb1 = dpp_shr1(rb1, b), pb2 = dpp_shr2(rb2, b);
                    if (q < 7) { ra1 = dpp_ror1(a); ra2 = dpp_ror2(a); rb1 = dpp_ror1(b); rb2 = dpp_ror2(b); }
                    const float ca0 = wa[0][0] * bflo(a) + wa[1][0] * bflo(pa1) + wa[2][0] * bflo(pa2), ca1 = wa[0][1] * bfhi(a) + wa[1][1] * bfhi(pa1) + wa[2][1] * bfhi(pa2);
                    const float cb0 = wb[0][0] * bflo(b) + wb[1][0] * bflo(pb1) + wb[2][0] * bflo(pb2), cb1 = wb[0][1] * bfhi(b) + wb[1][1] * bfhi(pb1) + wb[2][1] * bfhi(pb2);
                    op[q][n][h] = cvt_pk_bf16(ca0 * sigm(ca0) * cb0, ca1 * sigm(ca1) * cb1);
                    __builtin_amdgcn_sched_barrier(0); }
            }
        size_t ao = (size_t)(tok0 + fr) * dff + j0;
#pragma unroll
        for (int q = 0; q < 8; ++q) { asm volatile("" : "+v"(ao));
            if (q > 0 || fr >= 2) *(__attribute__((address_space(1))) u32x4*)(ACT + ao) = (u32x4){op[q][0][0], op[q][0][1], op[q][1][0], op[q][1][1]};
            ao += (size_t)16 * dff; }
    }
};
struct BrTripleOrder {
    StaticOrder so;
    __host__ __device__ void init(int M, int N, int G_, int c_) { so.init(M, N, G_, c_); }
    __host__ __device__ bool next(int i, Unit& u) const { Unit t; const int j = i / 3, k = i - 3 * j; if (!so.next(j, t)) return false; const int br = (k == 2) ? 0 : k + 1; u.pm = t.pm + 64 * br; u.pn = t.pn + 8 * br; return true; }
    __device__ __forceinline__ void a_ready(const Unit&) const {}
    __device__ __forceinline__ void done(const Unit&) const {}
};
template <class Epi, class Sched, bool ALIGN_EPI = false, bool SP2 = false>
__device__ __forceinline__ void gemm_phase(PG8_LAS unsigned char* lds, const Gemm g, const Sched& S, const Epi& E) {
    int tid = threadIdx.x; asm volatile("" : "+v"(tid)); const int wid = __builtin_amdgcn_readfirstlane(tid >> 6), lane = tid & 63, wr = wid >> 2, wc = wid & 3, fr = lane & 15, fq = lane >> 4;
    const int K = g.K, nt = K / BK;
    unsigned voffA[2], voffB[2];
#pragma unroll
    for (int i = 0; i < 2; ++i) { int R, C; stage_rc(tid * 16 + i * 8192, R, C); const int Rb = Epi::PERM ? ((R & ~31) + perm32(R & 31)) : R;
        const int Ra = Epi::ASWAP ? ((R >> 6) * 128 + (R & 63)) : R;
        voffA[i] = (unsigned)(Ra * K + C) * 2u; voffB[i] = (unsigned)(Rb * K + C) * 2u; }
    const size_t kstep = (size_t)(BK * 2);
    const size_t hstep = (size_t)HALF * K * 2;
    const size_t hstepA = Epi::ASWAP ? (size_t)64 * K * 2 : hstep;
    const size_t tstep = 2 * hstep;
    const unsigned ldsw = (unsigned)wid * 1024u;
    const int aoff = lds_byte(wr * 64 + fr, fq * 8), boff = lds_byte(wc * 32 + fr, fq * 8);
#define PG8_SA(b, h) (((b) * 2 + (h)) * HTB)
#define PG8_SB(b, h) ((4 + (b) * 2 + (h)) * HTB)
#define PG8_STAGE(bufoff, gbase, voff) do { _Pragma("unroll") for (int _i = 0; _i < 2; ++_i) \
        __builtin_amdgcn_global_load_lds((const unsigned*)((const char*)(gbase) + (voff)[_i]), (PG8_LAS unsigned*)(lds + (bufoff) + ldsw + _i * 8192), 16, 0, 0); } while (0)
#define PG8_LDA(dst, b, h) do { _Pragma("unroll") for (int m = 0; m < 4; ++m) _Pragma("unroll") for (int k = 0; k < 2; ++k) dst[m][k] = *(const PG8_LAS bf16x8*)(lds + PG8_SA(b, h) + aoff + m * 2048 + k * 1024); } while (0)
#define PG8_LDB(dst, b, h) do { _Pragma("unroll") for (int n = 0; n < 2; ++n) _Pragma("unroll") for (int k = 0; k < 2; ++k) dst[n][k] = *(const PG8_LAS bf16x8*)(lds + PG8_SB(b, h) + boff + n * 2048 + k * 1024); } while (0)
#define PG8_MMA(ai, bj, At, Bt) do { __builtin_amdgcn_s_setprio(1); _Pragma("unroll") for (int m = 0; m < 4; ++m) _Pragma("unroll") for (int n = 0; n < 2; ++n) _Pragma("unroll") for (int k = 0; k < 2; ++k) \
        acc[ai][bj][m][n] = __builtin_amdgcn_mfma_f32_16x16x32_bf16(Bt[n][k], At[m][k], acc[ai][bj][m][n], 0, 0, 0); __builtin_amdgcn_s_setprio(0); } while (0)
#define PG8_WAIT_V(n) asm volatile("s_waitcnt vmcnt(" #n ")" ::: "memory")
#define PG8_WAIT_L(n) asm volatile("s_waitcnt lgkmcnt(" #n ")" ::: "memory")
#define PG8_BAR __builtin_amdgcn_s_barrier()
#define PG8_SCHED __builtin_amdgcn_sched_barrier(0)
    Unit cur, nxt; int ui = 0;
    if (!S.next(0, cur)) return;
    f32x4 acc[2][2][4][2];
#pragma unroll
    for (int a = 0; a < 2; ++a)
#pragma unroll
        for (int b = 0; b < 2; ++b)
#pragma unroll
            for (int m = 0; m < 4; ++m)
#pragma unroll
                for (int n = 0; n < 2; ++n) acc[a][b][m][n] = (f32x4){0.f, 0.f, 0.f, 0.f};
    bf16x8 At[4][2], B0[2][2], B1[2][2];
    const char* cA = (const char*)g.A + (size_t)cur.pm * tstep; const char* cB = (const char*)g.Bt + (size_t)cur.pn * tstep;
    S.a_ready(cur);
    if constexpr (SP2) {
        PG8_STAGE(PG8_SB(0, 0), cB, voffB); PG8_STAGE(PG8_SB(0, 1), cB + hstep, voffB); PG8_STAGE(PG8_SA(0, 0), cA, voffA); PG8_STAGE(PG8_SA(0, 1), cA + hstepA, voffA);
        if (wr == 1) PG8_BAR;
        PG8_WAIT_V(2); PG8_BAR;
        PG8_STAGE(PG8_SB(1, 0), cB + kstep, voffB); PG8_STAGE(PG8_SA(1, 0), cA + kstep, voffA); PG8_STAGE(PG8_SB(1, 1), cB + hstep + kstep, voffB);
        PG8_WAIT_V(6); PG8_BAR;
    } else {
        PG8_STAGE(PG8_SB(0, 0), cB, voffB); PG8_STAGE(PG8_SA(0, 0), cA, voffA); PG8_STAGE(PG8_SB(0, 1), cB + hstep, voffB); PG8_STAGE(PG8_SA(0, 1), cA + hstepA, voffA);
        if (wr == 1) PG8_BAR;
        PG8_WAIT_V(4); PG8_BAR;
        PG8_STAGE(PG8_SB(1, 0), cB + kstep, voffB); PG8_STAGE(PG8_SA(1, 0), cA + kstep, voffA); PG8_STAGE(PG8_SB(1, 1), cB + hstep + kstep, voffB);
        PG8_WAIT_V(6); PG8_BAR;
    }
    for (;;) {
        const bool has_next = S.next(ui + 1, nxt);
        const char* nA = has_next ? (const char*)g.A + (size_t)nxt.pm * tstep : cA; const char* nB = has_next ? (const char*)g.Bt + (size_t)nxt.pn * tstep : cB;
        for (int t = 0; t < nt; t += 2) {
            const bool last = (t == nt - 2);
            const char* a1 = cA + (size_t)(t + 1) * kstep;
            const char* a2 = last ? nA : cA + (size_t)(t + 2) * kstep; const char* b2 = last ? nB : cB + (size_t)(t + 2) * kstep;
            const char* a3 = a2 + kstep; const char* b3 = b2 + kstep;
            if (last && has_next) S.a_ready(nxt);
            if constexpr (SP2) {
            PG8_LDB(B0, 0, 0); PG8_LDB(B1, 0, 1); PG8_SCHED; PG8_LDA(At, 0, 0); PG8_STAGE(PG8_SA(1, 1), a1 + hstepA, voffA);
            PG8_WAIT_V(8); PG8_WAIT_L(0); PG8_BAR; PG8_MMA(0, 0, At, B0); PG8_MMA(0, 1, At, B1); PG8_BAR; PG8_SCHED;
            PG8_LDA(At, 0, 1); PG8_STAGE(PG8_SB(0, 0), b2, voffB); PG8_STAGE(PG8_SB(0, 1), b2 + hstep, voffB); PG8_STAGE(PG8_SA(0, 0), a2, voffA);
            PG8_WAIT_V(8); PG8_WAIT_L(0); PG8_BAR; PG8_MMA(1, 0, At, B0); PG8_MMA(1, 1, At, B1); PG8_BAR; PG8_SCHED;
            PG8_LDB(B0, 1, 0); PG8_LDB(B1, 1, 1); PG8_SCHED; PG8_LDA(At, 1, 0); PG8_STAGE(PG8_SA(0, 1), a2 + hstepA, voffA);
            PG8_WAIT_V(8); PG8_WAIT_L(0); PG8_BAR; PG8_MMA(0, 0, At, B0); PG8_MMA(0, 1, At, B1); PG8_BAR; PG8_SCHED;
            PG8_LDA(At, 1, 1); PG8_STAGE(PG8_SB(1, 0), b3, voffB); PG8_STAGE(PG8_SB(1, 1), b3 + hstep, voffB); PG8_STAGE(PG8_SA(1, 0), a3, voffA);
            PG8_WAIT_V(8); PG8_WAIT_L(0); PG8_BAR; PG8_MMA(1, 0, At, B0); PG8_MMA(1, 1, At, B1); PG8_BAR; PG8_SCHED;
            } else {
            PG8_LDB(B0, 0, 0); PG8_SCHED; PG8_LDA(At, 0, 0); PG8_STAGE(PG8_SA(1, 1), a1 + hstepA, voffA);
            PG8_WAIT_L(8); PG8_BAR; PG8_WAIT_L(0); PG8_MMA(0, 0, At, B0); PG8_BAR; PG8_SCHED;
            PG8_LDB(B1, 0, 1); PG8_STAGE(PG8_SB(0, 0), b2, voffB);
            PG8_BAR; PG8_WAIT_L(0); PG8_MMA(0, 1, At, B1); PG8_BAR;
            PG8_LDA(At, 0, 1); PG8_STAGE(PG8_SA(0, 0), a2, voffA);
            PG8_BAR; PG8_WAIT_L(0); PG8_MMA(1, 0, At, B0); PG8_BAR; PG8_SCHED;
            PG8_STAGE(PG8_SB(0, 1), b2 + hstep, voffB);
            PG8_WAIT_V(6); PG8_BAR; PG8_MMA(1, 1, At, B1); PG8_BAR;
            PG8_LDB(B0, 1, 0); PG8_SCHED; PG8_LDA(At, 1, 0); PG8_STAGE(PG8_SA(0, 1), a2 + hstepA, voffA);
            PG8_WAIT_L(8); PG8_BAR; PG8_WAIT_L(0); PG8_MMA(0, 0, At, B0); PG8_BAR; PG8_SCHED;
            PG8_LDB(B1, 1, 1); PG8_STAGE(PG8_SB(1, 0), b3, voffB);
            PG8_BAR; PG8_WAIT_L(0); PG8_MMA(0, 1, At, B1); PG8_BAR;
            PG8_LDA(At, 1, 1); PG8_STAGE(PG8_SA(1, 0), a3, voffA);
            PG8_BAR; PG8_WAIT_L(0); PG8_MMA(1, 0, At, B0); PG8_BAR; PG8_SCHED;
            PG8_STAGE(PG8_SB(1, 1), b3 + hstep, voffB);
            PG8_WAIT_V(6); PG8_BAR; PG8_MMA(1, 1, At, B1); PG8_BAR;
            }
        }
        if constexpr (ALIGN_EPI) { if (wr == 0) PG8_BAR; }
        if constexpr (!Epi::AFTER_DRAIN) { E(acc, cur, wr, wc, fr, fq); S.done(cur); }
        if (!has_next) break;
#pragma unroll
        for (int a = 0; a < 2; ++a)
#pragma unroll
            for (int b = 0; b < 2; ++b)
#pragma unroll
                for (int m = 0; m < 4; ++m)
#pragma unroll
                    for (int n = 0; n < 2; ++n) acc[a][b][m][n] = (f32x4){0.f, 0.f, 0.f, 0.f};
        cur = nxt; cA = nA; cB = nB; ++ui;
        if constexpr (ALIGN_EPI) { if (wr == 1) PG8_BAR; }
    }
    PG8_WAIT_V(0);
    if constexpr (!ALIGN_EPI) { if (wr == 0) PG8_BAR; }
    PG8_BAR;
    if constexpr (Epi::AFTER_DRAIN) { E.fused(acc, cur, wr, wc, fr, fq, lds, wid, lane); S.done(cur); }
#undef PG8_SA
#undef PG8_SB
#undef PG8_STAGE
#undef PG8_LDA
#undef PG8_LDB
#undef PG8_MMA
#undef PG8_WAIT_V
#undef PG8_WAIT_L
#undef PG8_BAR
#undef PG8_SCHED
}
}
constexpr int NWAVES = 8;
constexpr int DM = 2048, BATCH = 8, SEQ = 2048, DEPTH = 4, M = BATCH * SEQ;
constexpr int SSMW = 512, NGRP = 32, NST = 64, HD = 64;
constexpr int OFF_Q = 512, OFF_K = 2048, OFF_V = 3584, OFF_CB = 5120, OFF_CC = 5632, OFF_CH = 6144, OFF_GATE = 6656, N_IN = 12800;
constexpr int DFF = 5632, NUP = 2 * DFF;
constexpr int NMOD = 6 * DM;
constexpr float RMS_EPS = 1e-6f;
enum { I_X = 0, I_C, I_WMOD, I_BMOD, I_GPRE_MIX, I_GPOST_MIX, I_GPRE_FFN, I_GPOST_FFN, I_WIN, I_LOGDT, I_ARE, I_AIM, I_BRE, I_BIM, I_CRE, I_CIM, I_SSMD, I_WGLU, I_BGLU,
       I_CONVW, I_WSSM, I_WATT, I_WCNV, I_BGATE, I_WO, I_WUP, I_FCONVW, I_WDOWN, N_INPUTS };
constexpr size_t MiB = 1u << 20;
constexpr size_t WS_CTL = 0, CTL_ZERO_BYTES = 1 * MiB;
constexpr size_t WS_MOD = 1 * MiB;
constexpr size_t WS_W = 4 * MiB;
constexpr size_t WB_IN = 0, WB_GLU = WB_IN + (size_t)N_IN * DM * 2, WB_BR = WB_GLU + (size_t)SSMW * SSMW * 2, WB_O = WB_BR + (size_t)3 * DM * SSMW * 2,
                 WB_UP = WB_O + (size_t)DM * DM * 2, WB_DN = WB_UP + (size_t)NUP * DM * 2, WB_LAYER = WB_DN + (size_t)DM * DFF * 2;
static_assert(WB_LAYER == (size_t)(50 * MiB + MiB / 2 + 6 * MiB + 8 * MiB + 44 * MiB + 22 * MiB), "weights per layer");
constexpr size_t WS_H = 528 * MiB;
constexpr size_t WS_PROJ = 592 * MiB;
constexpr size_t WS_ACT = 992 * MiB;
constexpr size_t WS_G = 1168 * MiB;
constexpr size_t WS_A3 = 1184 * MiB;
constexpr size_t WS_MG = 1232 * MiB;
constexpr size_t WS_Y = 1296 * MiB;
constexpr size_t WS_MODP = 1424 * MiB;
constexpr size_t WS_XB = 1360 * MiB;
constexpr size_t WS_PART = 1432 * MiB;
constexpr size_t WS_PARTML = 1464 * MiB;
constexpr size_t WS_END = 1466 * MiB;
static_assert(WS_W + DEPTH * WB_LAYER <= WS_H && WS_PROJ + (size_t)M * N_IN * 2 <= WS_ACT && WS_ACT + (size_t)M * DFF * 2 <= WS_G, "ws map");
constexpr int CW_BAR = 4096;
constexpr int RING_BYTES = 131072, MISC_OFF = 143360, LDS_BYTES = 147456;

#define GAS __attribute__((address_space(1)))
#define LAS __attribute__((address_space(3)))
typedef unsigned short bf16;
typedef unsigned v4u __attribute__((ext_vector_type(4)));
typedef unsigned v2u __attribute__((ext_vector_type(2)));
typedef float f32x4 __attribute__((ext_vector_type(4)));
typedef short bf16x8 __attribute__((ext_vector_type(8)));
typedef short s16x4 __attribute__((ext_vector_type(4)));
#define LDS_WAIT() asm volatile("s_waitcnt lgkmcnt(0)" ::: "memory")
#define VM_WAIT() asm volatile("s_waitcnt vmcnt(0)" ::: "memory")
__device__ __forceinline__ unsigned f2bf(float f) { unsigned u = __builtin_bit_cast(unsigned, f); return (u + 0x7fffu + ((u >> 16) & 1u)) >> 16; }
__device__ __forceinline__ unsigned pk2(float lo, float hi) { return pg8::cvt_pk_bf16(lo, hi); }
__device__ __forceinline__ float bflo(unsigned w) { return __uint_as_float(w << 16); }
__device__ __forceinline__ float bfhi(unsigned w) { return __uint_as_float(w & 0xffff0000u); }
__device__ __forceinline__ void unpack8(const v4u w, float (&f)[8]) { f[0] = bflo(w.x); f[1] = bfhi(w.x); f[2] = bflo(w.y); f[3] = bfhi(w.y); f[4] = bflo(w.z); f[5] = bfhi(w.z); f[6] = bflo(w.w); f[7] = bfhi(w.w); }
__device__ __forceinline__ v4u pack8f(const float (&f)[8]) { v4u w; w.x = pk2(f[0], f[1]); w.y = pk2(f[2], f[3]); w.z = pk2(f[4], f[5]); w.w = pk2(f[6], f[7]); return w; }
__device__ __forceinline__ float wave_sum(float v) {
#pragma unroll
    for (int o = 1; o < 64; o <<= 1) v += __shfl_xor(v, o);
    return v;
}
#define XB_TMO      128
#define XB_XCNT(j)  (256  + 64 * (j))
#define XB_XSUB(j)  (1280 + 64 * (j))
#define XB_XGEN(j)  (2304 + 64 * (j))
#define XB_TOP      3328
#define XB_TOPGEN   3392
#define XCD_BAR_WORDS 3456
#define XB_SPIN_CAP (1u << 18)

__device__ __forceinline__ unsigned xb_ld(unsigned* p)              { return __hip_atomic_load(p, __ATOMIC_RELAXED, __HIP_MEMORY_SCOPE_AGENT); }
__device__ __forceinline__ unsigned xb_add(unsigned* p, unsigned v) { return __hip_atomic_fetch_add(p, v, __ATOMIC_RELAXED, __HIP_MEMORY_SCOPE_AGENT); }
__device__ __forceinline__ unsigned xb_xcc_id() { return (unsigned)__builtin_amdgcn_s_getreg((3 << 11) | 20) & 0xFu; }
#define XB_SPIN(cond, bar) do { unsigned _sp = 0; while (cond) { __builtin_amdgcn_s_sleep(1); \
    if ((++_sp & 255u) == 0u) { if (xb_ld(&(bar)[XB_TMO])) break; if (_sp > XB_SPIN_CAP) { atomicAdd(&(bar)[XB_TMO], 1u); break; } } } } while (0)

struct XcdBarrier {
    unsigned* bar; unsigned x;
    volatile LAS unsigned* st;
};

__device__ __forceinline__ XcdBarrier xcd_barrier_post(unsigned* bar, volatile LAS unsigned* st) {
    XcdBarrier b; b.bar = bar; b.x = xb_xcc_id(); b.st = st;
    if (threadIdx.x == 0) (void)xb_add(&bar[XB_XCNT(b.x)], 1u);
    return b;
}
__device__ __forceinline__ void xcd_barrier_complete(unsigned* bar, unsigned x, unsigned& nloc, unsigned& nx) {
    const unsigned G = gridDim.x * gridDim.y * gridDim.z;
    unsigned sum, cnt, mine, sp = 0u;
    for (;;) {
        sum = 0u; cnt = 0u; mine = 0u;
#pragma unroll
        for (unsigned j = 0; j < 16; ++j) { const unsigned c = xb_ld(&bar[XB_XCNT(j)]); sum += c; cnt += (c > 0u) ? 1u : 0u; mine = (j == x) ? c : mine; }
        if (sum == G) break;
        __builtin_amdgcn_s_sleep(1);
        if ((++sp & 255u) == 0u) { if (xb_ld(&bar[XB_TMO])) break; if (sp > XB_SPIN_CAP) { atomicAdd(&bar[XB_TMO], 1u); break; } }
    }
    nloc = mine > 0u ? mine : 1u; nx = cnt > 0u ? cnt : 1u;
}

__device__ __forceinline__ void xcd_barrier(const XcdBarrier& b) {
    asm volatile("s_waitcnt vmcnt(0)" ::: "memory");
    __syncthreads();
    if (threadIdx.x == 0) {
        unsigned* bar = b.bar;
        __builtin_amdgcn_s_waitcnt(0);
        unsigned nloc = b.st[0], nx = b.st[1];
        if (nloc == 0u) { xcd_barrier_complete(bar, b.x, nloc, nx); b.st[0] = nloc; b.st[1] = nx; }
        const unsigned old = xb_add(&bar[XB_XSUB(b.x)], 1u);
        const unsigned gen = old / nloc;
        if (old + 1u == (gen + 1u) * nloc) {
            __builtin_amdgcn_fence(__ATOMIC_RELEASE, "agent");
            asm volatile("s_waitcnt vmcnt(0)" ::: "memory");
            const unsigned og = xb_add(&bar[XB_TOP], 1u);
            const unsigned tg = og / nx;
            if (og + 1u == (tg + 1u) * nx) xb_add(&bar[XB_TOPGEN], 1u);
            else XB_SPIN(xb_ld(&bar[XB_TOPGEN]) == tg, bar);
            __builtin_amdgcn_fence(__ATOMIC_ACQUIRE, "agent");
            xb_add(&bar[XB_XGEN(b.x)], 1u);
            asm volatile("s_waitcnt vmcnt(0)" ::: "memory");
        } else {
            XB_SPIN(xb_ld(&bar[XB_XGEN(b.x)]) == gen, bar);
            __builtin_amdgcn_fence(__ATOMIC_ACQUIRE, "agent");
            asm volatile("s_waitcnt vmcnt(0)" ::: "memory");
        }
    }
    __syncthreads();
}
constexpr int TI_IN = (DM / 64) * (N_IN / 32), TI_GLU = (SSMW / 64) * (SSMW / 32), TI_BR = (SSMW / 64) * (DM / 32), TI_O = (DM / 64) * (DM / 32), TI_UP = (DM / 64) * (NUP / 32), TI_DN = (DFF / 64) * (DM / 32);
constexpr int TI_LAYER = TI_IN + TI_GLU + 3 * TI_BR + TI_O + TI_UP + TI_DN, TI_ALL = DEPTH * TI_LAYER;
struct TItem { const float* src; bf16* dst; int N, K; };
__device__ __forceinline__ TItem titem_of(const float* W, int K, int N, bf16* WT, int row_off, int item, int lane) {
    const int nblk = N / 32, kb = item / nblk, nb = item % nblk, k0 = 64 * kb, n0 = 32 * nb;
    TItem t; t.src = W + (size_t)(k0 + (lane >> 5)) * N + n0 + (lane & 31); t.dst = WT + (size_t)(row_off + n0) * K + k0; t.N = N; t.K = K; return t;
}
__device__ __forceinline__ TItem titem_any(const float* const* in, unsigned char* ws, int it, int lane) {
    const int l = it / TI_LAYER; int r = it % TI_LAYER;
    unsigned char* wl = ws + WS_W + (size_t)l * WB_LAYER;
    if (r < TI_IN) return titem_of(in[I_WIN] + (size_t)l * DM * N_IN, DM, N_IN, (bf16*)(wl + WB_IN), 0, r, lane); r -= TI_IN;
    if (r < TI_GLU) return titem_of(in[I_WGLU] + (size_t)l * SSMW * SSMW, SSMW, SSMW, (bf16*)(wl + WB_GLU), 0, r, lane); r -= TI_GLU;
    if (r < TI_BR) return titem_of(in[I_WSSM] + (size_t)l * SSMW * DM, SSMW, DM, (bf16*)(wl + WB_BR), 0, r, lane); r -= TI_BR;
    if (r < TI_BR) return titem_of(in[I_WATT] + (size_t)l * SSMW * DM, SSMW, DM, (bf16*)(wl + WB_BR), DM, r, lane); r -= TI_BR;
    if (r < TI_BR) return titem_of(in[I_WCNV] + (size_t)l * SSMW * DM, SSMW, DM, (bf16*)(wl + WB_BR), 2 * DM, r, lane); r -= TI_BR;
    if (r < TI_O) return titem_of(in[I_WO] + (size_t)l * DM * DM, DM, DM, (bf16*)(wl + WB_O), 0, r, lane); r -= TI_O;
    if (r < TI_UP) { const int n0 = 32 * (r % (NUP / 32));
        const int d0 = (n0 < DFF) ? 256 * (n0 / 128) + (n0 % 128) : 256 * ((n0 - DFF) / 128) + 128 + ((n0 - DFF) % 128);
        return titem_of(in[I_WUP] + (size_t)l * DM * NUP, DM, NUP, (bf16*)(wl + WB_UP), d0 - n0, r, lane); } r -= TI_UP;
    return titem_of(in[I_WDOWN] + (size_t)l * DFF * DM, DFF, DM, (bf16*)(wl + WB_DN), 0, r, lane);
}
__device__ __forceinline__ void titem_load(const TItem& t, float (&wv)[32]) {
#pragma unroll
    for (int i = 0; i < 32; ++i) wv[i] = __builtin_nontemporal_load(t.src + (size_t)(2 * i) * t.N);
}
__device__ __forceinline__ void titem_store(const TItem& t, const float (&wv)[32], LAS float* scr, int lane) {
#pragma unroll
    for (int i = 0; i < 32; ++i) scr[(2 * i + (lane >> 5)) * 33 + (lane & 31)] = wv[i];
    LDS_WAIT(); asm volatile("" ::: "memory");
    const int c = lane & 7;
#pragma unroll
    for (int j = 0; j < 4; ++j) { const int n = (lane >> 3) + 8 * j; const LAS float* s = scr + (8 * c) * 33 + n;
        v4u o; o.x = pk2(s[0 * 33], s[1 * 33]); o.y = pk2(s[2 * 33], s[3 * 33]); o.z = pk2(s[4 * 33], s[5 * 33]); o.w = pk2(s[6 * 33], s[7 * 33]);
        *(GAS v4u*)(t.dst + (size_t)n * t.K + 8 * c) = o; }
    LDS_WAIT(); asm volatile("" ::: "memory");
}
__device__ __forceinline__ void convert_items(const float* const* in, unsigned char* ws, LAS float* scr, int first, int end, int step, int lane) {
    if (first >= end) return;
    float wa[32], wb[32];
    TItem cur = titem_any(in, ws, first, lane); titem_load(cur, wa);
    for (int it = first; it < end; it += step) {
        const bool more = it + step < end; TItem nx = cur;
        if (more) { nx = titem_any(in, ws, it + step, lane); titem_load(nx, wb); }
        titem_store(cur, wa, scr, lane);
        if (more) {
#pragma unroll
            for (int i = 0; i < 32; ++i) wa[i] = wb[i];
            cur = nx; }
    }
}
constexpr int MOD_KS = 4, MOD_ITEMS = DEPTH * (NMOD / 64) * MOD_KS, MOD_PART = DEPTH * BATCH * NMOD;
__device__ __forceinline__ void p0_mod_item(const float* const* in, float* mod, const LAS float* condL, int item, int lane) {
    const int ks = item % MOD_KS, it2 = item / MOD_KS, l = it2 / (NMOD / 64), j = (it2 % (NMOD / 64)) * 64 + lane, kbeg = ks * (DM / MOD_KS);
    const float* wp = in[I_WMOD] + (size_t)l * DM * NMOD + (size_t)kbeg * NMOD + j;
    float acc[8];
#pragma unroll
    for (int b = 0; b < 8; ++b) acc[b] = 0.f;
    for (int k0 = 0; k0 < DM / MOD_KS; k0 += 16) {
        float w[16];
#pragma unroll
        for (int i = 0; i < 16; ++i) w[i] = __builtin_nontemporal_load(wp + (size_t)(k0 + i) * NMOD);
#pragma unroll
        for (int i = 0; i < 16; ++i) { const int k = kbeg + k0 + i; const f32x4 c0 = *(const LAS f32x4*)(condL + k * 8), c1 = *(const LAS f32x4*)(condL + k * 8 + 4);
            acc[0] += w[i] * c0[0]; acc[1] += w[i] * c0[1]; acc[2] += w[i] * c0[2]; acc[3] += w[i] * c0[3]; acc[4] += w[i] * c1[0]; acc[5] += w[i] * c1[1]; acc[6] += w[i] * c1[2]; acc[7] += w[i] * c1[3]; }
    }
#pragma unroll
    for (int b = 0; b < 8; ++b) mod[(size_t)ks * MOD_PART + (size_t)(l * BATCH + b) * NMOD + j] = acc[b];
}
__device__ __forceinline__ void p0_mod_reduce(const float* const* in, const float* part, float* mod, int gtid, int nthreads) {
    for (int i = gtid; i < DEPTH * BATCH * NMOD; i += nthreads) { const int j = i % NMOD, l = i / (BATCH * NMOD);
        mod[i] = ((part[i] + part[MOD_PART + i]) + (part[2 * (size_t)MOD_PART + i] + part[3 * (size_t)MOD_PART + i])) + in[I_BMOD][l * NMOD + j]; }
}
__device__ __forceinline__ void p0_prologue(const float* const* in, unsigned char* ws, LAS unsigned char* lds, int tid, int wave, int lane, int vcu, int G) {
    LAS float* condL = (LAS float*)lds;
    LAS float* scr = (LAS float*)(lds + 65536 + wave * 8448);
    for (int idx = tid; idx < BATCH * DM; idx += NWAVES * 64) { const int b = idx & 7, k = idx >> 3; const float cv = in[I_C][b * DM + k]; condL[idx] = cv / (1.0f + __expf(-cv)); }
    __syncthreads();
    const int gw2 = wave * G + vcu, NGW = G * NWAVES;
    for (int q = gw2; q < MOD_ITEMS; q += NGW) p0_mod_item(in, (float*)(ws + WS_MODP), condL, q, lane);
    convert_items(in, ws, scr, gw2, TI_LAYER, NGW, lane);
}

__device__ __forceinline__ void convert_layer_share(const float* const* in, unsigned char* ws, LAS float* scr, int l, int gw2, int NGW, int lane) {
    convert_items(in, ws, scr, l * TI_LAYER + gw2, (l + 1) * TI_LAYER, NGW, lane);
}

template <bool POST, bool XI_BF>
__device__ __forceinline__ void norm_load(const void* xi_, const bf16* y, int m, int lane, f32x4 (&xr)[4][2], v4u (&yr)[4]) {
#pragma unroll
    for (int j = 0; j < 4; ++j) { const int col = 8 * (lane + 64 * j);
        if (XI_BF) { const v4u w = *(const GAS v4u*)((const bf16*)xi_ + (size_t)m * DM + col); xr[j][0] = __builtin_bit_cast(f32x4, w); }
        else { const float* xi = (const float*)xi_; xr[j][0] = *(const GAS f32x4*)(xi + (size_t)m * DM + col); xr[j][1] = *(const GAS f32x4*)(xi + (size_t)m * DM + col + 4); }
        if (POST) yr[j] = *(const GAS v4u*)(y + (size_t)m * DM + col); }
}
template <bool POST, bool PRE, bool XI_BF, bool XO_BF>
__device__ __forceinline__ void norm_rows(const void* xi_, void* xo_, const bf16* y, const float* gpost, const float* gt, const float* gpre, const float* sc, const float* sh, bf16* h, int gw, int NGW, int lane) {
    constexpr int RPW = 8;
    for (int m0 = gw * RPW; m0 < M; m0 += NGW * RPW) {
        const int b = m0 / SEQ;
        f32x4 xr[4][2], xn[4][2]; v4u yr[4], yn[4];
        norm_load<POST, XI_BF>(xi_, y, m0, lane, xr, yr);
        for (int m = m0; m < m0 + RPW; ++m) {
            if (m + 1 < m0 + RPW) norm_load<POST, XI_BF>(xi_, y, m + 1, lane, xn, yn);
            float xv[4][8];
#pragma unroll
            for (int j = 0; j < 4; ++j) {
                if (XI_BF) unpack8(__builtin_bit_cast(v4u, xr[j][0]), xv[j]);
                else { xv[j][0] = xr[j][0][0]; xv[j][1] = xr[j][0][1]; xv[j][2] = xr[j][0][2]; xv[j][3] = xr[j][0][3]; xv[j][4] = xr[j][1][0]; xv[j][5] = xr[j][1][1]; xv[j][6] = xr[j][1][2]; xv[j][7] = xr[j][1][3]; } }
            if (POST) {
                float yv[4][8]; float ss = 0.f;
#pragma unroll
                for (int j = 0; j < 4; ++j) { unpack8(yr[j], yv[j]);
#pragma unroll
                    for (int e = 0; e < 8; ++e) ss += yv[j][e] * yv[j][e]; }
                const float rs = rsqrtf(wave_sum(ss) * (1.0f / DM) + RMS_EPS);
#pragma unroll
                for (int j = 0; j < 4; ++j) { const int col = 8 * (lane + 64 * j);
                    const f32x4 g0 = *(const GAS f32x4*)(gpost + col), g1 = *(const GAS f32x4*)(gpost + col + 4), t0 = *(const GAS f32x4*)(gt + (size_t)b * NMOD + col), t1 = *(const GAS f32x4*)(gt + (size_t)b * NMOD + col + 4);
#pragma unroll
                    for (int e = 0; e < 4; ++e) { xv[j][e] += t0[e] * (yv[j][e] * rs * g0[e]); xv[j][e + 4] += t1[e] * (yv[j][e + 4] * rs * g1[e]); }
                    if (XO_BF) { *(GAS v4u*)((bf16*)xo_ + (size_t)m * DM + col) = pack8f(xv[j]);
                        if (PRE) { float r[8]; unpack8(pack8f(xv[j]), r);
#pragma unroll
                            for (int e = 0; e < 8; ++e) xv[j][e] = r[e]; } }
                    else { float* xo = (float*)xo_; *(GAS f32x4*)(xo + (size_t)m * DM + col) = (f32x4){xv[j][0], xv[j][1], xv[j][2], xv[j][3]}; *(GAS f32x4*)(xo + (size_t)m * DM + col + 4) = (f32x4){xv[j][4], xv[j][5], xv[j][6], xv[j][7]}; } }
            }
            if (PRE) {
                float ss = 0.f;
#pragma unroll
                for (int j = 0; j < 4; ++j)
#pragma unroll
                    for (int e = 0; e < 8; ++e) ss += xv[j][e] * xv[j][e];
                const float rs = rsqrtf(wave_sum(ss) * (1.0f / DM) + RMS_EPS);
#pragma unroll
                for (int j = 0; j < 4; ++j) { const int col = 8 * (lane + 64 * j); float o[8];
                    const f32x4 g0 = *(const GAS f32x4*)(gpre + col), g1 = *(const GAS f32x4*)(gpre + col + 4), s0 = *(const GAS f32x4*)(sc + (size_t)b * NMOD + col), s1 = *(const GAS f32x4*)(sc + (size_t)b * NMOD + col + 4),
                                h0 = *(const GAS f32x4*)(sh + (size_t)b * NMOD + col), h1 = *(const GAS f32x4*)(sh + (size_t)b * NMOD + col + 4);
#pragma unroll
                    for (int e = 0; e < 4; ++e) { o[e] = xv[j][e] * rs * g0[e] * (1.0f + s0[e]) + h0[e]; o[e + 4] = xv[j][e + 4] * rs * g1[e] * (1.0f + s1[e]) + h1[e]; }
                    *(GAS v4u*)(h + (size_t)m * DM + col) = pack8f(o); }
            }
#pragma unroll
            for (int j = 0; j < 4; ++j) { xr[j][0] = xn[j][0]; xr[j][1] = xn[j][1]; yr[j] = yn[j]; }
        }
    }
}
__device__ __forceinline__ void ffn_fix_phase(const bf16* halo, bf16* act, const float* cw  , int gw, int NGW, int lane) {
    constexpr int NCH = DFF / 512, NBLK = M / 128;
    for (int it = gw; it < NCH * NBLK; it += NGW) {
        const int blk = it / NCH, ch = it % NCH, t0 = blk * 128, col = ch * 512 + lane * 8;
        float wa[3][8], wb[3][8];
#pragma unroll
        for (int k = 0; k < 3; ++k) { const f32x4 a0 = *(const GAS f32x4*)(cw + k * NUP + col), a1 = *(const GAS f32x4*)(cw + k * NUP + col + 4), b0 = *(const GAS f32x4*)(cw + k * NUP + DFF + col), b1 = *(const GAS f32x4*)(cw + k * NUP + DFF + col + 4);
#pragma unroll
            for (int e = 0; e < 4; ++e) { wa[k][e] = a0[e]; wa[k][e + 4] = a1[e]; wb[k][e] = b0[e]; wb[k][e + 4] = b1[e]; } }
        float am1[8], am2[8], bm1[8], bm2[8], a0[8], a1[8], b0[8], b1[8];
        if ((t0 % SEQ) == 0) {
#pragma unroll
            for (int e = 0; e < 8; ++e) { am1[e] = 0.f; am2[e] = 0.f; bm1[e] = 0.f; bm2[e] = 0.f; }
        } else { const bf16* hp = halo + (size_t)(blk - 1) * 4 * NUP;
            unpack8(*(const GAS v4u*)(hp + 3 * NUP + col), am1); unpack8(*(const GAS v4u*)(hp + 2 * NUP + col), am2);
            unpack8(*(const GAS v4u*)(hp + 3 * NUP + DFF + col), bm1); unpack8(*(const GAS v4u*)(hp + 2 * NUP + DFF + col), bm2); }
        { const bf16* hp = halo + (size_t)blk * 4 * NUP;
          unpack8(*(const GAS v4u*)(hp + col), a0); unpack8(*(const GAS v4u*)(hp + NUP + col), a1);
          unpack8(*(const GAS v4u*)(hp + DFF + col), b0); unpack8(*(const GAS v4u*)(hp + NUP + DFF + col), b1); }
        float o0[8], o1[8];
#pragma unroll
        for (int e = 0; e < 8; ++e) {
            const float ca0 = wa[0][e] * a0[e] + wa[1][e] * am1[e] + wa[2][e] * am2[e], cb0 = wb[0][e] * b0[e] + wb[1][e] * bm1[e] + wb[2][e] * bm2[e];
            const float ca1 = wa[0][e] * a1[e] + wa[1][e] * a0[e] + wa[2][e] * am1[e], cb1 = wb[0][e] * b1[e] + wb[1][e] * b0[e] + wb[2][e] * bm1[e];
            o0[e] = ca0 * __builtin_amdgcn_rcpf(1.0f + __expf(-ca0)) * cb0; o1[e] = ca1 * __builtin_amdgcn_rcpf(1.0f + __expf(-ca1)) * cb1; }
        *(GAS v4u*)(act + (size_t)t0 * DFF + col) = pack8f(o0); *(GAS v4u*)(act + (size_t)(t0 + 1) * DFF + col) = pack8f(o1);
    }
}
constexpr int CONV_RUN = 16;
__device__ __forceinline__ void conv_mix_items(const bf16* proj, bf16* outc, const float* cw  , int first, int step, int lane) {
    for (int run = first; run < M / CONV_RUN; run += step) {
        const int m0 = run * CONV_RUN, col = lane * 8;
        float w[3][8];
#pragma unroll
        for (int k = 0; k < 3; ++k) { const f32x4 a0 = *(const GAS f32x4*)(cw + k * 512 + col), a1 = *(const GAS f32x4*)(cw + k * 512 + col + 4);
#pragma unroll
            for (int e = 0; e < 4; ++e) { w[k][e] = a0[e]; w[k][e + 4] = a1[e]; } }
        float z1[8], z2[8];
        if ((m0 % SEQ) == 0) {
#pragma unroll
            for (int e = 0; e < 8; ++e) { z1[e] = 0.f; z2[e] = 0.f; }
        } else {
            float p[8], q[8];
            unpack8(*(const GAS v4u*)(proj + (size_t)(m0 - 1) * N_IN + OFF_CC + col), p); unpack8(*(const GAS v4u*)(proj + (size_t)(m0 - 1) * N_IN + OFF_CH + col), q);
#pragma unroll
            for (int e = 0; e < 8; ++e) z1[e] = p[e] * q[e];
            unpack8(*(const GAS v4u*)(proj + (size_t)(m0 - 2) * N_IN + OFF_CC + col), p); unpack8(*(const GAS v4u*)(proj + (size_t)(m0 - 2) * N_IN + OFF_CH + col), q);
#pragma unroll
            for (int e = 0; e < 8; ++e) z2[e] = p[e] * q[e];
        }
#pragma unroll 4
        for (int t = 0; t < CONV_RUN; ++t) {
            float p[8], q[8], bb[8], o[8];
            const bf16* rp = proj + (size_t)(m0 + t) * N_IN;
            unpack8(*(const GAS v4u*)(rp + OFF_CC + col), p); unpack8(*(const GAS v4u*)(rp + OFF_CH + col), q); unpack8(*(const GAS v4u*)(rp + OFF_CB + col), bb);
#pragma unroll
            for (int e = 0; e < 8; ++e) { const float z0 = p[e] * q[e]; o[e] = bb[e] * (w[0][e] * z0 + w[1][e] * z1[e] + w[2][e] * z2[e]); z2[e] = z1[e]; z1[e] = z0; }
            *(GAS v4u*)(outc + (size_t)(m0 + t) * 512 + col) = pack8f(o);
        }
    }
}
constexpr int SSM_XS = 0, SSM_XS_W = 10240, SSM_HS = 8 * SSM_XS_W, SSM_E = SSM_HS + 8 * 4608, SSM_BB = SSM_E + 4096, SSM_LDS_END = SSM_BB + 4096;
constexpr int ATT_NP = 2, ATT_VLDS = 0;
static_assert(SSM_LDS_END <= RING_BYTES && ATT_VLDS + 8 * ATT_NP * 4608 <= 73728 && 73728 + 8 * 8448 <= MISC_OFF, "mixer LDS map");
__device__ __forceinline__ float gelu_tanh(float y) { const float z = 0.7978845608028654f * (y + 0.044715f * y * y * y); const float e = __expf(2.0f * z); const float th = 1.0f - 2.0f * __builtin_amdgcn_rcpf(1.0f + e); return 0.5f * y * (1.0f + th); }
__device__ __forceinline__ void ssm_unit(const float* const* in, int l, int b, int g, const bf16* proj, bf16* gbuf, LAS unsigned char* lds, int wave, int lane) {
    const int n = lane, lg = l * NGRP + g, gn = lg * NST + n;
    const int cc = lane & 15, kq = lane >> 4;
    LAS float* Xre = (LAS float*)(lds + SSM_XS + wave * SSM_XS_W);
    LAS float* Xim = Xre + 64 * 20;
    LAS bf16* Hs = (LAS bf16*)(lds + SSM_HS + wave * 4608);
    LAS float* E = (LAS float*)(lds + SSM_E);
    LAS bf16* BBre = (LAS bf16*)(lds + SSM_BB); LAS bf16* BBim = BBre + 64 * 16;
    float lr, li;
    { const float dt = expf(in[I_LOGDT][lg]);
      const float ar = in[I_ARE][gn], ai = in[I_AIM][gn];
      const float mag = expf(ar * dt), ang = ai * dt;
      const float kq2 = rintf(ang * 0.15915494309189535f); float red = fmaf(-kq2, 6.2831854820251465f, ang); red = fmaf(-kq2, -1.7484555e-7f, red);
      lr = mag * cosf(red); li = mag * sinf(red);
      const float den = ar * ar + ai * ai, fre = ((lr - 1.0f) * ar + li * ai) / den, fim = (li * ar - (lr - 1.0f) * ai) / den;
      const float* bre = in[I_BRE] + (size_t)gn * 16; const float* bim = in[I_BIM] + (size_t)gn * 16;
      if (wave == 0) {
#pragma unroll
          for (int q = 0; q < 4; ++q) { const f32x4 r4 = *(const GAS f32x4*)(bre + 4 * q), i4 = *(const GAS f32x4*)(bim + 4 * q);
              v2u wr2, wi2; wr2.x = pk2(fre * r4[0] - fim * i4[0], fre * r4[1] - fim * i4[1]); wr2.y = pk2(fre * r4[2] - fim * i4[2], fre * r4[3] - fim * i4[3]);
              wi2.x = pk2(fre * i4[0] + fim * r4[0], fre * i4[1] + fim * r4[1]); wi2.y = pk2(fre * i4[2] + fim * r4[2], fre * i4[3] + fim * r4[3]);
              *(LAS v2u*)(BBre + n * 16 + 4 * q) = wr2; *(LAS v2u*)(BBim + n * 16 + 4 * q) = wi2; } } }
    bf16x8 Cf[4];
#pragma unroll
    for (int kb = 0; kb < 4; ++kb) { const float* src = (kb < 2 ? in[I_CRE] : in[I_CIM]) + (size_t)(lg * 16 + cc) * NST + (kb & 1) * 32 + 8 * kq; const float sg = kb < 2 ? 1.0f : -1.0f;
        const f32x4 a = *(const GAS f32x4*)src, c4 = *(const GAS f32x4*)(src + 4);
        Cf[kb] = __builtin_bit_cast(bf16x8, (v4u){pk2(sg * a[0], sg * a[1]), pk2(sg * a[2], sg * a[3]), pk2(sg * c4[0], sg * c4[1]), pk2(sg * c4[2], sg * c4[3])}); }
    const float dsk = in[I_SSMD][l * SSMW + g * 16 + cc];
    __syncthreads();
    bf16x8 Bre[4], Bim[4];
    const bf16x8 zf = (bf16x8){0, 0, 0, 0, 0, 0, 0, 0};
#pragma unroll
    for (int nb = 0; nb < 4; ++nb) { Bre[nb] = (kq < 2) ? *(const LAS bf16x8*)(BBre + (nb * 16 + cc) * 16 + kq * 8) : zf; Bim[nb] = (kq < 2) ? *(const LAS bf16x8*)(BBim + (nb * 16 + cc) * 16 + kq * 8) : zf; }
    const bf16* urow = proj + (size_t)(b * SEQ + 256 * wave + cc) * N_IN + g * 16 + (kq & 1) * 8;
    const f32x4 z4 = (f32x4){0.f, 0.f, 0.f, 0.f};
    float hr = 0.f, hi = 0.f;
    { bf16x8 an = *(const GAS bf16x8*)urow;
      for (int bt = 0; bt < 16; ++bt) {
          const bf16x8 a = (kq < 2) ? an : zf;
          if (bt + 1 < 16) an = *(const GAS bf16x8*)(urow + (size_t)(bt + 1) * 16 * N_IN);
#pragma unroll
          for (int nb = 0; nb < 4; ++nb) { const f32x4 dr = __builtin_amdgcn_mfma_f32_16x16x32_bf16(a, Bre[nb], z4, 0, 0, 0), di = __builtin_amdgcn_mfma_f32_16x16x32_bf16(a, Bim[nb], z4, 0, 0, 0);
              *(LAS f32x4*)(Xre + (nb * 16 + cc) * 20 + 4 * kq) = dr; *(LAS f32x4*)(Xim + (nb * 16 + cc) * 20 + 4 * kq) = di; }
          LDS_WAIT();
#pragma unroll
          for (int q4 = 0; q4 < 4; ++q4) { const f32x4 xr = *(const LAS f32x4*)(Xre + n * 20 + 4 * q4), xi = *(const LAS f32x4*)(Xim + n * 20 + 4 * q4);
#pragma unroll
              for (int i = 0; i < 4; ++i) { const float nr = lr * hr - li * hi + xr[i], ni = lr * hi + li * hr + xi[i]; hr = nr; hi = ni; } }
          LDS_WAIT(); asm volatile("" ::: "memory");
      } }
    E[(wave * 64 + n) * 2] = hr; E[(wave * 64 + n) * 2 + 1] = hi;
    float pr = lr, pi = li;
#pragma unroll
    for (int q = 0; q < 8; ++q) { const float t = pr * pr - pi * pi; pi = 2.0f * pr * pi; pr = t; }
    __syncthreads();
    hr = 0.f; hi = 0.f;
    for (int j = 0; j < wave; ++j) { const float er = E[(j * 64 + n) * 2], ei = E[(j * 64 + n) * 2 + 1]; const float nr = pr * hr - pi * hi + er, ni = pr * hi + pi * hr + ei; hr = nr; hi = ni; }
    { bf16x8 an = *(const GAS bf16x8*)urow;
      for (int bt = 0; bt < 16; ++bt) {
          const bf16x8 a = (kq < 2) ? an : zf;
          if (bt + 1 < 16) an = *(const GAS bf16x8*)(urow + (size_t)(bt + 1) * 16 * N_IN);
#pragma unroll
          for (int nb = 0; nb < 4; ++nb) { const f32x4 dr = __builtin_amdgcn_mfma_f32_16x16x32_bf16(a, Bre[nb], z4, 0, 0, 0), di = __builtin_amdgcn_mfma_f32_16x16x32_bf16(a, Bim[nb], z4, 0, 0, 0);
              *(LAS f32x4*)(Xre + (nb * 16 + cc) * 20 + 4 * kq) = dr; *(LAS f32x4*)(Xim + (nb * 16 + cc) * 20 + 4 * kq) = di; }
          LDS_WAIT();
#pragma unroll
          for (int q4 = 0; q4 < 4; ++q4) { const f32x4 xr = *(const LAS f32x4*)(Xre + n * 20 + 4 * q4), xi = *(const LAS f32x4*)(Xim + n * 20 + 4 * q4);
#pragma unroll
              for (int i = 0; i < 4; ++i) { const float nr = lr * hr - li * hi + xr[i], ni = lr * hi + li * hr + xi[i]; hr = nr; hi = ni;
                  const unsigned hp = pk2(hr, hi); Hs[(4 * q4 + i) * 136 + n] = (bf16)(hp & 0xffffu); Hs[(4 * q4 + i) * 136 + 64 + n] = (bf16)(hp >> 16); } }
          LDS_WAIT();
          f32x4 Y = z4;
#pragma unroll
          for (int kb = 0; kb < 4; ++kb) { const bf16x8 ha = *(const LAS bf16x8*)(Hs + cc * 136 + kb * 32 + kq * 8); Y = __builtin_amdgcn_mfma_f32_16x16x32_bf16(ha, Cf[kb], Y, 0, 0, 0); }
          const int tb = 256 * wave + 16 * bt + 4 * kq;
#pragma unroll
          for (int i = 0; i < 4; ++i) { const size_t row = (size_t)(b * SEQ + tb + i); const float uval = __uint_as_float(((unsigned)proj[row * N_IN + g * 16 + cc]) << 16);
              gbuf[row * SSMW + g * 16 + cc] = (bf16)f2bf(gelu_tanh(Y[i] + dsk * uval)); }
          LDS_WAIT(); asm volatile("" ::: "memory");
      } }
}

__device__ __forceinline__ s16x4 vtr(const LAS unsigned char* p) { return __builtin_bit_cast(s16x4, __builtin_amdgcn_ds_read_tr16_b64_v4i16((LAS s16x4*)p)); }
__device__ __forceinline__ float xmax16(float v) { const unsigned u = __float_as_uint(v); auto r = __builtin_amdgcn_permlane16_swap(u, u, false, false); return fmaxf(__uint_as_float(r[0]), __uint_as_float(r[1])); }
__device__ __forceinline__ float xmax32(float v) { const unsigned u = __float_as_uint(v); auto r = __builtin_amdgcn_permlane32_swap(u, u, false, false); return fmaxf(__uint_as_float(r[0]), __uint_as_float(r[1])); }
__device__ __forceinline__ float xsum16(float v) { const unsigned u = __float_as_uint(v); auto r = __builtin_amdgcn_permlane16_swap(u, u, false, false); return __uint_as_float(r[0]) + __uint_as_float(r[1]); }
__device__ __forceinline__ float xsum32(float v) { const unsigned u = __float_as_uint(v); auto r = __builtin_amdgcn_permlane32_swap(u, u, false, false); return __uint_as_float(r[0]) + __uint_as_float(r[1]); }
struct AttnKV { bf16x8 k[2][2]; v4u v[4]; };
__device__ __forceinline__ void attn_load(AttnKV& t, const bf16* kbase, const bf16* vbase, int kt0, int rg, int sh, int lane) {
    const int col = lane & 15;
#pragma unroll
    for (int half = 0; half < 2; ++half) { int kp = kt0 + 16 * half + col; kp = kp < 0 ? 0 : kp; const bf16* kr = kbase + (size_t)(rg + (kp << sh)) * N_IN;
        t.k[half][0] = *(const GAS bf16x8*)kr; t.k[half][1] = *(const GAS bf16x8*)(kr + 32); }
#pragma unroll
    for (int i = 0; i < 4; ++i) { const int chunk = lane + 64 * i, row = chunk >> 3, c16 = chunk & 7; int kp = kt0 + row; kp = kp < 0 ? 0 : kp;
        t.v[i] = *(const GAS v4u*)(vbase + (size_t)(rg + (kp << sh)) * N_IN + c16 * 8); }
}
template <int NP, int MODE>
__device__ __forceinline__ void attn_tile(const bf16* proj, bf16* aout, float* part, float* part_ml, LAS unsigned char* vlds0, int b, int h, int r0, int i0, int lane) {
    const int col = lane & 15, grp = lane >> 4;
    const size_t rowb = (size_t)b * SEQ;
    constexpr int GLO = MODE == 0 ? 1 : 0, GHI = MODE == 0 ? 3 : 1;
    int tq[NP]; bf16x8 Qf[NP][3][2]; f32x4 acc[NP][4]; float mrun[NP], lrun[NP];
#pragma unroll
    for (int p = 0; p < NP; ++p) { tq[p] = (MODE == 0) ? (r0 + 8 * p + 16 * (i0 + col)) : (16 * i0 + r0 + 16 * p + col);
        const bf16* qrow = proj + (rowb + tq[p]) * N_IN + OFF_Q + h * 64 + grp * 8;
#pragma unroll
        for (int g = GLO; g < GHI; ++g)
#pragma unroll
            for (int dh = 0; dh < 2; ++dh) Qf[p][g][dh] = *(const GAS bf16x8*)(qrow + g * 512 + dh * 32);
        if (MODE == 0) {
#pragma unroll
            for (int d = 0; d < 4; ++d) acc[p][d] = (f32x4){0.f, 0.f, 0.f, 0.f};
            mrun[p] = -1e30f; lrun[p] = 0.f;
        } else { const size_t pr = ((rowb + tq[p]) * 8 + h);
#pragma unroll
            for (int d = 0; d < 4; ++d) acc[p][d] = *(const GAS f32x4*)(part + pr * 64 + d * 16 + 4 * grp);
            mrun[p] = part_ml[pr * 2]; lrun[p] = part_ml[pr * 2 + 1]; } }
    const float L2E = 1.4426950408889634f;
    const int tq4 = (lane & 15) >> 2, tp4 = lane & 3;
    const int vrd_off = (4 * grp + tq4) * 144 + tp4 * 8, vwr_off = (lane >> 3) * 144 + (lane & 7) * 16;
#pragma unroll
    for (int g = GLO; g < GHI; ++g) {
        const int sh = 2 * g, dil = 1 << sh;
        const int kstart = (g == 0) ? (16 * i0 + r0 - 128) : (g == 1 ? 4 * i0 - 128 : i0 - 144), ntile = (g == 0) ? 5 : (g == 1 ? 6 : 5);
        const float c_qk = 0.125f * L2E, c_b = exp2f(-(float)(g * 8 + h + 1) * (1.0f / 3.0f)) * (float)dil * L2E;
        const bf16* kbase = proj + rowb * N_IN + OFF_K + g * 512 + h * 64 + grp * 8;
        const bf16* vbase = proj + rowb * N_IN + OFF_V + g * 512 + h * 64;
        int rg[NP], qp[NP];
#pragma unroll
        for (int p = 0; p < NP; ++p) { rg[p] = (g == 0) ? 0 : ((r0 + 8 * p) & (dil - 1)); qp[p] = (tq[p] - rg[p]) >> sh; }
        int ti = 0;
        while (kstart + 32 * ti + 32 <= 0) ++ti;
        const int NL = (g < 2) ? 1 : NP;
        AttnKV cur[NP], nxt[NP];
#pragma unroll
        for (int p = 0; p < NP; ++p) if (p < NL) attn_load(cur[p], kbase, vbase, kstart + 32 * ti, rg[p], sh, lane);
        for (; ti < ntile; ++ti) {
            const int kt0 = kstart + 32 * ti;
            if (ti + 1 < ntile) {
#pragma unroll
                for (int p = 0; p < NP; ++p) if (p < NL) attn_load(nxt[p], kbase, vbase, kt0 + 32, rg[p], sh, lane); }
            f32x4 S[NP][2]; bf16x8 Pf[NP];
#pragma unroll
            for (int p = 0; p < NP; ++p) {
                LAS unsigned char* vlds = vlds0 + p * 4608;
#pragma unroll
                for (int half = 0; half < 2; ++half) {
                    S[p][half] = __builtin_amdgcn_mfma_f32_16x16x32_bf16(cur[p < NL ? p : 0].k[half][0], Qf[p][g][0], (f32x4){0.f, 0.f, 0.f, 0.f}, 0, 0, 0);
                    S[p][half] = __builtin_amdgcn_mfma_f32_16x16x32_bf16(cur[p < NL ? p : 0].k[half][1], Qf[p][g][1], S[p][half], 0, 0, 0); }
                if (p < NL) {
#pragma unroll
                    for (int i = 0; i < 4; ++i) *(LAS v4u*)(vlds + vwr_off + i * 8 * 144) = cur[p].v[i]; } }
#pragma unroll
            for (int p = 0; p < NP; ++p) {
                const int D0 = qp[p] - kt0 - 4 * grp; const unsigned W = (unsigned)(qp[p] < 128 ? qp[p] : 128); const float nb0 = -c_b * (float)D0;
                float sc[8]; float mx = -3.0e38f;
#pragma unroll
                for (int half = 0; half < 2; ++half)
#pragma unroll
                    for (int i = 0; i < 4; ++i) { const bool valid = (unsigned)(D0 - (16 * half + i)) <= W;
                        const float sv = valid ? fmaf(S[p][half][i], c_qk, nb0 + c_b * (float)(16 * half + i)) : -3.0e38f; sc[half * 4 + i] = sv; mx = fmaxf(mx, sv); }
                mx = xmax32(xmax16(mx));
                const float mnew = fmaxf(mrun[p], mx), alpha = __builtin_amdgcn_exp2f(mrun[p] - mnew);
                float pv[8], psum = 0.f;
#pragma unroll
                for (int j = 0; j < 8; ++j) { pv[j] = __builtin_amdgcn_exp2f(sc[j] - mnew); psum += pv[j]; }
                psum = xsum32(xsum16(psum));
                lrun[p] = lrun[p] * alpha + psum; mrun[p] = mnew;
#pragma unroll
                for (int d = 0; d < 4; ++d) acc[p][d] = acc[p][d] * alpha;
                Pf[p] = __builtin_bit_cast(bf16x8, (v4u){pk2(pv[0], pv[1]), pk2(pv[2], pv[3]), pk2(pv[4], pv[5]), pk2(pv[6], pv[7])}); }
            LDS_WAIT();
#pragma unroll
            for (int p = 0; p < NP; ++p) {
                const LAS unsigned char* vlds = vlds0 + (p < NL ? p : 0) * 4608;
#pragma unroll
                for (int d = 0; d < 4; ++d) { const s16x4 lo = vtr(vlds + vrd_off + d * 32), hi = vtr(vlds + vrd_off + 16 * 144 + d * 32);
                    const bf16x8 Vf = (bf16x8){lo[0], lo[1], lo[2], lo[3], hi[0], hi[1], hi[2], hi[3]};
                    acc[p][d] = __builtin_amdgcn_mfma_f32_16x16x32_bf16(Vf, Pf[p], acc[p][d], 0, 0, 0); } }
            LDS_WAIT(); asm volatile("" ::: "memory");
#pragma unroll
            for (int p = 0; p < NP; ++p) if (p < NL) cur[p] = nxt[p];
        }
    }
#pragma unroll
    for (int p = 0; p < NP; ++p) {
        if (MODE == 0) { const size_t pr = ((rowb + tq[p]) * 8 + h);
#pragma unroll
            for (int d = 0; d < 4; ++d) *(GAS f32x4*)(part + pr * 64 + d * 16 + 4 * grp) = acc[p][d];
            if (grp == 0) { part_ml[pr * 2] = mrun[p]; part_ml[pr * 2 + 1] = lrun[p]; }
        } else { const float inv = 1.0f / lrun[p];
            bf16* orow = aout + (rowb + tq[p]) * SSMW + h * 64 + 4 * grp;
#pragma unroll
            for (int d = 0; d < 4; ++d) { v2u w; w.x = pk2(acc[p][d][0] * inv, acc[p][d][1] * inv); w.y = pk2(acc[p][d][2] * inv, acc[p][d][3] * inv); *(GAS v2u*)(orow + d * 16) = w; } }
    }
}
__device__ __forceinline__ void attn_item(const bf16* proj, bf16* aout, float* part, float* part_ml, LAS unsigned char* vl, int b, int h, int blk, int wave, int lane) {
    attn_tile<2, 0>(proj, aout, part, part_ml, vl, b, h, wave, 16 * blk, lane);
    VM_WAIT(); __syncthreads();
    attn_tile<2, 1>(proj, aout, part, part_ml, vl, b, h, 32 * wave, 16 * blk, lane);
}
#ifndef STAGGER_PB
#define STAGGER_PB 0
#endif
#ifndef UPACT_ALIGN
#define UPACT_ALIGN true
#endif
#ifndef MK_PER_PHASE
#define MK_PER_PHASE 0
#endif
__device__ __forceinline__ int launder(int v) { asm volatile("" : "+v"(v)); return v; }
#define PH_LOCALS const int tid = launder((int)threadIdx.x), lane = tid & 63, wave = __builtin_amdgcn_readfirstlane(tid >> 6), gw = vcu * NWAVES + wave; (void)tid; (void)lane; (void)wave; (void)gw;
constexpr int PH_PER_LAYER = 11, N_PHASES = 1 + DEPTH * PH_PER_LAYER;
struct Args { const float* in[N_INPUTS]; float* out; unsigned char* ws; int ph_lo, ph_hi; };
static_assert(sizeof(Args) == N_INPUTS * 8 + 8 + 8 + 8, "Args has no padding");
__global__ void __launch_bounds__(NWAVES * 64, 2) trunk_fwd(Args args) {
    extern __shared__ __attribute__((aligned(16))) unsigned char lds_raw[];
    LAS unsigned char* lds = (LAS unsigned char*)lds_raw;
    volatile LAS unsigned* MISC = (volatile LAS unsigned*)(lds + MISC_OFF);
    const int G = gridDim.x, bx = blockIdx.x, vcu = (G % 8 == 0) ? (bx % 8) * (G / 8) + bx / 8 : bx;
    const int NGW = G * NWAVES;
    unsigned char* ws = args.ws;
    const float* const* in = args.in;
    for (int u = threadIdx.x; u < (LDS_BYTES - MISC_OFF) / 4; u += NWAVES * 64) MISC[u] = 0u;
    __syncthreads();
    unsigned* barw = (unsigned*)(ws + WS_CTL) + CW_BAR;
    XcdBarrier bar; bar.bar = barw; bar.x = 0; bar.st = nullptr;
    if (!MK_PER_PHASE) bar = xcd_barrier_post(barw, MISC + 8);
    const int lo = args.ph_lo, hi = args.ph_hi;
#ifndef PH_MASK
#define PH_MASK 0xFFFF
#endif
#define EN(k) (((PH_MASK) >> (k)) & 1)
#ifndef REP_MASK
#define REP_MASK 0
#endif
#define NREP(k) (1 + (((REP_MASK) >> (k)) & 1))
#define PH_IN(id) (lo <= (id) && (id) < hi)
#define PH_SEAM(id) do { if ((id) + 1 < hi) { if (!MK_PER_PHASE) xcd_barrier(bar); } } while (0)
    float* mod = (float*)(ws + WS_MOD);
    bf16* Hb = (bf16*)(ws + WS_H); bf16* PJ = (bf16*)(ws + WS_PROJ); bf16* UP = (bf16*)(ws + WS_PROJ); bf16* ACT = (bf16*)(ws + WS_ACT);
    bf16* GB = (bf16*)(ws + WS_G); bf16* A3 = (bf16*)(ws + WS_A3); bf16* MG = (bf16*)(ws + WS_MG); bf16* YB = (bf16*)(ws + WS_Y);
    float* xout = args.out; bf16* XB = (bf16*)(ws + WS_XB);

    if (EN(0) && PH_IN(0)) for (int rp = 0; rp < NREP(0); ++rp) { PH_LOCALS; p0_prologue(in, ws, lds, tid, wave, lane, vcu, G); PH_SEAM(0); }

    for (int l = 0; l < DEPTH; ++l) {
        const int pb = 1 + l * PH_PER_LAYER;
        const unsigned char* wl = ws + WS_W + (size_t)l * WB_LAYER;
        const float* modl = mod + (size_t)l * BATCH * NMOD;
        if (l == 0 && PH_IN(pb + 0) && EN(1)) { PH_LOCALS;
            p0_mod_reduce(in, (const float*)(ws + WS_MODP), mod, bx * (NWAVES * 64) + tid, G * NWAVES * 64);
            if (!MK_PER_PHASE) xcd_barrier(bar); else {   }
            norm_rows<false, true, false, false>(in[I_X], nullptr, nullptr, nullptr, nullptr, in[I_GPRE_MIX] + l * DM, modl + DM, modl, Hb, gw, NGW, lane);
            PH_SEAM(pb + 0);
        }
        if (PH_IN(pb + 1) && EN(2)) for (int rp = 0; rp < NREP(2); ++rp) { PH_LOCALS;
#if STAGGER_PB
            if (bx >= G / 2) { for (int s = 0; s < STAGGER_PB; ++s) __builtin_amdgcn_s_sleep(127); }
#endif
            pg8::Gemm g{Hb, (const bf16*)(wl + WB_IN), M, N_IN, DM}; pg8::StaticOrder S; S.init(M, N_IN, G, bx);
            pg8::EpiIn E{PJ, N_IN, in[I_BGATE] + (size_t)l * 3 * DM, OFF_GATE / 256};
            pg8::gemm_phase<pg8::EpiIn, pg8::StaticOrder, false, true>(lds, g, S, E);
            if (l + 1 < DEPTH && 2 * bx >= G) { LAS float* cscr = (LAS float*)(lds + wave * 8448); const int nidle = G - (G + 1) / 2;
                convert_layer_share(in, ws, cscr, l + 1, wave * nidle + (bx - (G + 1) / 2), nidle * NWAVES, lane); }
            PH_SEAM(pb + 1);
        }
        if (PH_IN(pb + 2) && EN(3)) { PH_LOCALS;
            for (int rep = 0; rep < NREP(12); ++rep)
            for (int uidx = vcu; uidx < BATCH * NGRP; uidx += G) { ssm_unit(in, l, uidx / NGRP, uidx % NGRP, PJ, GB, lds, wave, lane); __syncthreads(); }
            LAS float* cscr = (LAS float*)(lds + 73728 + wave * 8448);
            for (int rep = 0; rep < NREP(13); ++rep)
            { LAS unsigned char* vl = lds + ATT_VLDS + wave * (ATT_NP * 4608);
              for (int T = vcu; T < BATCH * 8 * 8; T += G) attn_item(PJ, A3 + (size_t)M * SSMW, (float*)(ws + WS_PART), (float*)(ws + WS_PARTML), vl, T >> 6, (T >> 3) & 7, (T + (T >> 3)) & 7, wave, lane); }
            (void)cscr;
            for (int rep = 0; rep < NREP(14); ++rep)
            conv_mix_items(PJ, A3 + (size_t)2 * M * SSMW, in[I_CONVW] + (size_t)l * 3 * SSMW, gw, NGW, lane);
            PH_SEAM(pb + 2);
        }
        if (PH_IN(pb + 3) && EN(4)) for (int rp = 0; rp < NREP(4); ++rp) { PH_LOCALS;
            pg8::Gemm g{GB, (const bf16*)(wl + WB_GLU), M, SSMW, SSMW}; pg8::StaticOrder S; S.init(M, SSMW, G, bx);
            pg8::EpiGlu E{GB, A3, SSMW, in[I_BGLU] + (size_t)l * SSMW};
            pg8::gemm_phase<pg8::EpiGlu, pg8::StaticOrder, true, true>(lds, g, S, E);
            PH_SEAM(pb + 3);
        }
        if (PH_IN(pb + 4) && EN(5)) for (int rp = 0; rp < NREP(5); ++rp) { PH_LOCALS;
            pg8::Gemm g{A3, (const bf16*)(wl + WB_BR), M, DM, SSMW}; pg8::BrTripleOrder S; S.init(M, DM, G, bx);
            pg8::EpiBr E{PJ + OFF_GATE, N_IN, MG, DM};
            pg8::gemm_phase<pg8::EpiBr, pg8::BrTripleOrder, true, true>(lds, g, S, E);
            PH_SEAM(pb + 4);
        }
        if (PH_IN(pb + 5) && EN(6)) for (int rp = 0; rp < NREP(6); ++rp) { PH_LOCALS;
            pg8::Gemm g{MG, (const bf16*)(wl + WB_O), M, DM, DM}; pg8::StaticOrder S; S.init(M, DM, G, bx);
            pg8::EpiStore E{YB, DM};
            pg8::gemm_phase<pg8::EpiStore, pg8::StaticOrder, false, true>(lds, g, S, E);
            PH_SEAM(pb + 5);
        }
        if (PH_IN(pb + 6) && EN(7)) { PH_LOCALS;
            if (l == 0) norm_rows<true, true, false, true>(in[I_X], XB, YB, in[I_GPOST_MIX] + l * DM, modl + 2 * DM, in[I_GPRE_FFN] + l * DM, modl + 4 * DM, modl + 3 * DM, Hb, gw, NGW, lane);
            else norm_rows<true, true, true, true>(XB, XB, YB, in[I_GPOST_MIX] + l * DM, modl + 2 * DM, in[I_GPRE_FFN] + l * DM, modl + 4 * DM, modl + 3 * DM, Hb, gw, NGW, lane);
            PH_SEAM(pb + 6);
        }
        if (PH_IN(pb + 7) && EN(8)) for (int rp = 0; rp < NREP(8); ++rp) { PH_LOCALS;
            pg8::Gemm g{Hb, (const bf16*)(wl + WB_UP), M, NUP, DM}; pg8::StaticOrder S; S.init(M, NUP, G, bx);
            pg8::EpiUpAct E{ACT, DFF, in[I_FCONVW] + (size_t)l * 3 * NUP, UP  };
            pg8::gemm_phase<pg8::EpiUpAct, pg8::StaticOrder, UPACT_ALIGN, true>(lds, g, S, E);
            PH_SEAM(pb + 7);
        }
        if (PH_IN(pb + 8) && EN(9)) for (int rp = 0; rp < NREP(9); ++rp) { PH_LOCALS; ffn_fix_phase(UP, ACT, in[I_FCONVW] + (size_t)l * 3 * NUP, gw, NGW, lane); PH_SEAM(pb + 8); }
        if (PH_IN(pb + 9) && EN(10)) for (int rp = 0; rp < NREP(10); ++rp) { PH_LOCALS;
            pg8::Gemm g{ACT, (const bf16*)(wl + WB_DN), M, DM, DFF}; pg8::StaticOrder S; S.init(M, DM, G, bx);
            pg8::EpiStore E{YB, DM};
            pg8::gemm_phase<pg8::EpiStore, pg8::StaticOrder, false, true>(lds, g, S, E);
            PH_SEAM(pb + 9);
        }
        if (PH_IN(pb + 10) && EN(11)) { PH_LOCALS;
            if (l + 1 < DEPTH) norm_rows<true, true, true, true>(XB, XB, YB, in[I_GPOST_FFN] + l * DM, modl + 5 * DM, in[I_GPRE_MIX] + (l + 1) * DM, modl + BATCH * NMOD + DM, modl + BATCH * NMOD, Hb, gw, NGW, lane);
            else norm_rows<true, false, true, false>(XB, xout, YB, in[I_GPOST_FFN] + l * DM, modl + 5 * DM, nullptr, nullptr, nullptr, nullptr, gw, NGW, lane);
            PH_SEAM(pb + 10);
        }
    }
#undef PH_IN
#undef PH_SEAM
}


#ifndef DBG_STOP
#define DBG_STOP -1
#endif
#ifndef DBG_BUF
#define DBG_BUF 0
#endif
__global__ void __launch_bounds__(256) dbg_dump(const bf16* src, int ld, int col0, int ncol, int outc0, float* out) {
    for (size_t i = (size_t)blockIdx.x * 256 + threadIdx.x; i < (size_t)M * ncol; i += (size_t)gridDim.x * 256) { const size_t m = i / ncol; const int c = (int)(i % ncol);
        out[m * DM + outc0 + c] = __uint_as_float(((unsigned)src[m * ld + col0 + c]) << 16); }
}
extern "C" void kernel_launch(void* const* d_in, const int* in_sizes, int n_in, void* d_out, int out_size, void* d_ws, size_t ws_size, hipStream_t stream) {
    static int grid = 0;
    if (grid == 0) {
        if (n_in != N_INPUTS || in_sizes[0] != M * DM || out_size != M * DM || ws_size < WS_END) { fprintf(stderr, "kernel_launch: unexpected shapes (n_in %d, in0 %d, out %d, ws %zu < %zu); nothing launched\n", n_in, n_in > 0 ? in_sizes[0] : -1, out_size, ws_size, (size_t)WS_END); grid = -1; return; }
        int dev = 0, cus = 0, per_cu = 0;
        if (hipGetDevice(&dev) != hipSuccess || hipDeviceGetAttribute(&cus, hipDeviceAttributeMultiprocessorCount, dev) != hipSuccess) { fprintf(stderr, "kernel_launch: device query failed\n"); grid = -1; return; }
        if (hipFuncSetAttribute((const void*)trunk_fwd, hipFuncAttributeMaxDynamicSharedMemorySize, LDS_BYTES) != hipSuccess) { fprintf(stderr, "kernel_launch: hipFuncSetAttribute failed\n"); grid = -1; return; }
        if (hipOccupancyMaxActiveBlocksPerMultiprocessor(&per_cu, (const void*)trunk_fwd, NWAVES * 64, LDS_BYTES) != hipSuccess || per_cu < 1) { fprintf(stderr, "kernel_launch: occupancy query reports %d blocks per CU\n", per_cu); }
        (void)hipGetLastError();
        grid = cus;
    }
    if (grid < 0) return;
    if (hipMemsetAsync((char*)d_ws + WS_CTL, 0, CTL_ZERO_BYTES, stream) != hipSuccess) { fprintf(stderr, "kernel_launch: memset failed\n"); return; }
    Args a{};
    for (int i = 0; i < N_INPUTS; ++i) a.in[i] = (const float*)d_in[i];
    a.out = (float*)d_out; a.ws = (unsigned char*)d_ws;
#if MK_PER_PHASE
    for (int p = 0; p < N_PHASES; ++p) {
        if (p > 0 && ((p - 1) % PH_PER_LAYER) == 0 && p != 1) continue;
        a.ph_lo = p; a.ph_hi = p + 1;
        hipLaunchKernelGGL(trunk_fwd, dim3(grid), dim3(NWAVES * 64), LDS_BYTES, stream, a);
        if (p == DBG_STOP) {
            unsigned char* w = (unsigned char*)d_ws; float* o = (float*)d_out;
            if (DBG_BUF == 0) hipLaunchKernelGGL(dbg_dump, dim3(2048), dim3(256), 0, stream, (const bf16*)(w + WS_H), DM, 0, DM, 0, o);
            if (DBG_BUF == 1) hipLaunchKernelGGL(dbg_dump, dim3(2048), dim3(256), 0, stream, (const bf16*)(w + WS_PROJ), N_IN, 0, DM, 0, o);
            if (DBG_BUF == 2) hipLaunchKernelGGL(dbg_dump, dim3(2048), dim3(256), 0, stream, (const bf16*)(w + WS_PROJ), N_IN, N_IN - DM, DM, 0, o);
            if (DBG_BUF == 3) { hipLaunchKernelGGL(dbg_dump, dim3(2048), dim3(256), 0, stream, (const bf16*)(w + WS_G), SSMW, 0, SSMW, 0, o);
                                hipLaunchKernelGGL(dbg_dump, dim3(2048), dim3(256), 0, stream, (const bf16*)(w + WS_A3), SSMW, 0, SSMW, 512, o);
                                hipLaunchKernelGGL(dbg_dump, dim3(2048), dim3(256), 0, stream, (const bf16*)(w + WS_A3) + (size_t)M * SSMW, SSMW, 0, SSMW, 1024, o);
                                hipLaunchKernelGGL(dbg_dump, dim3(2048), dim3(256), 0, stream, (const bf16*)(w + WS_A3) + (size_t)2 * M * SSMW, SSMW, 0, SSMW, 1536, o); }
            if (DBG_BUF == 4) hipLaunchKernelGGL(dbg_dump, dim3(2048), dim3(256), 0, stream, (const bf16*)(w + WS_MG), DM, 0, DM, 0, o);
            if (DBG_BUF == 5) hipLaunchKernelGGL(dbg_dump, dim3(2048), dim3(256), 0, stream, (const bf16*)(w + WS_Y), DM, 0, DM, 0, o);
            if (DBG_BUF == 6) hipLaunchKernelGGL(dbg_dump, dim3(2048), dim3(256), 0, stream, (const bf16*)(w + WS_ACT), DFF, 0, DM, 0, o);
            break;
        }
    }
#else
    a.ph_lo = 0; a.ph_hi = N_PHASES;
    hipLaunchKernelGGL(trunk_fwd, dim3(grid), dim3(NWAVES * 64), LDS_BYTES, stream, a);
#endif
    const hipError_t le = hipPeekAtLastError();
    if (le != hipSuccess) fprintf(stderr, "kernel_launch: launch failed: %s\n", hipGetErrorName(le));
}
```

```cpp
#include <hip/hip_runtime.h>
#include <cstdio>
#include <cstdint>
namespace pg8 {
#define PG8_LAS __attribute__((address_space(3)))
typedef unsigned short bf16_t;
typedef short bf16x8 __attribute__((ext_vector_type(8)));
typedef float f32x4 __attribute__((ext_vector_type(4)));
typedef unsigned u32x4 __attribute__((ext_vector_type(4)));
constexpr int BM = 256, BK = 64, HALF = 128, HTB = HALF * BK * 2  , STAGE_BYTES = 8 * HTB, NXCD = 8, WGM = 4;

__host__ __device__ __forceinline__ int lds_byte(int r, int c) { const int st = (r >> 4) * 2 + (c >> 5), rr = r & 15, cc = c & 31, ob = rr * 64 + cc * 2; return st * 1024 + (ob ^ (((ob >> 9) & 1) << 5)); }
__host__ __device__ __forceinline__ void stage_rc(int b, int& R, int& C) { const int st = b / 1024, sb = b % 1024, swz = sb ^ (((sb >> 9) & 1) << 5); R = (st >> 1) * 16 + swz / 64; C = (st & 1) * 32 + (swz % 64) / 2; }
__host__ __device__ __forceinline__ int perm32(int rho) { const int n = rho >> 4, i = rho & 15; return 8 * (i >> 2) + 4 * n + (i & 3); }

struct Unit { int pm, pn; };
struct Gemm { const bf16_t* A; const bf16_t* Bt; int M, N, K; };

struct StaticOrder {
    int nM, nN, nwg, G, c;
    __host__ __device__ void init(int M, int N, int G_, int c_) { nM = M / BM; nN = N / BM; nwg = nM * nN; G = G_; c = c_; }
    __host__ __device__ bool next(int i, Unit& u) const {
        const long L = (long)i * G + c; if (L >= nwg) return false;
        int wgid = (int)L; { const int q = nwg / NXCD, r = nwg % NXCD, xcd = wgid % NXCD, off = wgid / NXCD; wgid = (xcd < r ? xcd * (q + 1) : r * (q + 1) + (xcd - r) * q) + off; }
        const int nig = WGM * nN, gid = wgid / nig, fm = gid * WGM, gsz = (nM - fm) < WGM ? (nM - fm) : WGM;
        u.pm = fm + ((wgid % nig) % gsz); u.pn = (wgid % nig) / gsz; return true;
    }
    __device__ __forceinline__ void a_ready(const Unit&) const {}
    __device__ __forceinline__ void done(const Unit&) const {}
};

typedef float cvt_f32x2 __attribute__((ext_vector_type(2))); typedef __bf16 cvt_bf16x2 __attribute__((ext_vector_type(2)));
__device__ __forceinline__ unsigned cvt_pk_bf16(float lo, float hi) { cvt_f32x2 v = {lo, hi}; cvt_bf16x2 b = __builtin_convertvector(v, cvt_bf16x2); return __builtin_bit_cast(unsigned, b); }
__device__ __forceinline__ float sigm(float x) { return __builtin_amdgcn_rcpf(1.0f + __expf(-x)); }
__device__ __forceinline__ float bflo(unsigned w) { return __uint_as_float(w << 16); }
__device__ __forceinline__ float bfhi(unsigned w) { return __uint_as_float(w & 0xffff0000u); }
__device__ __forceinline__ u32x4 pack8(const f32x4& v0, const f32x4& v1) { u32x4 w; w.x = cvt_pk_bf16(v0[0], v0[1]); w.y = cvt_pk_bf16(v0[2], v0[3]); w.z = cvt_pk_bf16(v1[0], v1[1]); w.w = cvt_pk_bf16(v1[2], v1[3]); return w; }
#ifndef OUT_NT
#define OUT_NT 1
#endif
__device__ __forceinline__ void st_out(u32x4* p, const u32x4 v) { if (OUT_NT) __builtin_nontemporal_store(v, p); else *p = v; }
struct EpiStore {
    static constexpr bool PERM = true, AFTER_DRAIN = false, ASWAP = false;
    bf16_t* O; int ldc;
    __device__ __forceinline__ void operator()(const f32x4 (&acc)[2][2][4][2], const Unit& u, int wr, int wc, int fr, int fq) const {
        const int row0 = u.pm * BM + wr * 64 + fr, col0 = u.pn * BM + wc * 32 + 8 * fq;
#pragma unroll
        for (int ai = 0; ai < 2; ++ai)
#pragma unroll
            for (int m = 0; m < 4; ++m) { bf16_t* rowp = O + (size_t)(row0 + ai * HALF + m * 16) * ldc + col0;
#pragma unroll
                for (int bj = 0; bj < 2; ++bj) st_out((u32x4*)(rowp + bj * HALF), pack8(acc[ai][bj][m][0], acc[ai][bj][m][1])); }
    }
};
struct EpiIn {
    static constexpr bool PERM = true, AFTER_DRAIN = false, ASWAP = false;
    bf16_t* O; int ldc; const float* bgate; int gate_tile0;
    __device__ __forceinline__ void operator()(const f32x4 (&acc)[2][2][4][2], const Unit& u, int wr, int wc, int fr, int fq) const {
        const int row0 = u.pm * BM + wr * 64 + fr, col0 = u.pn * BM + wc * 32 + 8 * fq;
        if (u.pn >= gate_tile0) {
            const float* bp = bgate + (col0 - gate_tile0 * BM);
            f32x4 bv[2][2];
#pragma unroll
            for (int bj = 0; bj < 2; ++bj)
#pragma unroll
                for (int n = 0; n < 2; ++n) bv[bj][n] = *(const f32x4*)(bp + bj * HALF + 4 * n);
#pragma unroll
            for (int ai = 0; ai < 2; ++ai)
#pragma unroll
                for (int m = 0; m < 4; ++m) { bf16_t* rowp = O + (size_t)(row0 + ai * HALF + m * 16) * ldc + col0;
#pragma unroll
                    for (int bj = 0; bj < 2; ++bj) { f32x4 v0 = acc[ai][bj][m][0] + bv[bj][0], v1 = acc[ai][bj][m][1] + bv[bj][1];
#pragma unroll
                        for (int j = 0; j < 4; ++j) { v0[j] = sigm(v0[j]); v1[j] = sigm(v1[j]); }
                        st_out((u32x4*)(rowp + bj * HALF), pack8(v0, v1)); } }
        } else {
#pragma unroll
            for (int ai = 0; ai < 2; ++ai)
#pragma unroll
                for (int m = 0; m < 4; ++m) { bf16_t* rowp = O + (size_t)(row0 + ai * HALF + m * 16) * ldc + col0;
#pragma unroll
                    for (int bj = 0; bj < 2; ++bj) st_out((u32x4*)(rowp + bj * HALF), pack8(acc[ai][bj][m][0], acc[ai][bj][m][1])); }
        }
    }
};
struct EpiGlu {
    static constexpr bool PERM = true, AFTER_DRAIN = false, ASWAP = false;
    const bf16_t* G; bf16_t* O; int ldc; const float* bias;
    __device__ __forceinline__ void operator()(const f32x4 (&acc)[2][2][4][2], const Unit& u, int wr, int wc, int fr, int fq) const {
        const int row0 = u.pm * BM + wr * 64 + fr, col0 = u.pn * BM + wc * 32 + 8 * fq;
        f32x4 bv[2][2];
#pragma unroll
        for (int bj = 0; bj < 2; ++bj)
#pragma unroll
            for (int n = 0; n < 2; ++n) bv[bj][n] = *(const f32x4*)(bias + col0 + bj * HALF + 4 * n);
#pragma unroll
        for (int ai = 0; ai < 2; ++ai) {
            u32x4 gw[4][2];
#pragma unroll
            for (int m = 0; m < 4; ++m)
#pragma unroll
                for (int bj = 0; bj < 2; ++bj) gw[m][bj] = *(const u32x4*)(G + (size_t)(row0 + ai * HALF + m * 16) * ldc + col0 + bj * HALF);
#pragma unroll
            for (int m = 0; m < 4; ++m) { const size_t off = (size_t)(row0 + ai * HALF + m * 16) * ldc + col0;
#pragma unroll
                for (int bj = 0; bj < 2; ++bj) { const u32x4 g4 = gw[m][bj];
                    f32x4 v0 = acc[ai][bj][m][0] + bv[bj][0], v1 = acc[ai][bj][m][1] + bv[bj][1];
                    v0[0] = bflo(g4.x) * sigm(v0[0]); v0[1] = bfhi(g4.x) * sigm(v0[1]); v0[2] = bflo(g4.y) * sigm(v0[2]); v0[3] = bfhi(g4.y) * sigm(v0[3]);
                    v1[0] = bflo(g4.z) * sigm(v1[0]); v1[1] = bfhi(g4.z) * sigm(v1[1]); v1[2] = bflo(g4.w) * sigm(v1[2]); v1[3] = bfhi(g4.w) * sigm(v1[3]);
                    *(u32x4*)(O + off + bj * HALF) = pack8(v0, v1); } }
        }
    }
};
struct EpiBr {
    static constexpr bool PERM = true, AFTER_DRAIN = false, ASWAP = false;
    const bf16_t* gates; int ldg; bf16_t* Mg; int ldm;
    __device__ __forceinline__ void operator()(const f32x4 (&acc)[2][2][4][2], const Unit& u, int wr, int wc, int fr, int fq) const {
        const int br = u.pm >> 6, pm = u.pm & 63, pn = u.pn & 7; const bool accum = (br != 1);
        const int row0 = pm * BM + wr * 64 + fr, col0 = pn * BM + wc * 32 + 8 * fq;
#pragma unroll
        for (int ai = 0; ai < 2; ++ai) {
            u32x4 gw[4][2], ow[4][2];
#pragma unroll
            for (int m = 0; m < 4; ++m)
#pragma unroll
                for (int bj = 0; bj < 2; ++bj) { const int row = row0 + ai * HALF + m * 16;
                    gw[m][bj] = *(const u32x4*)(gates + (size_t)row * ldg + br * ldm + col0 + bj * HALF);
                    if (accum) ow[m][bj] = *(const u32x4*)(Mg + (size_t)row * ldm + col0 + bj * HALF); }
#pragma unroll
            for (int m = 0; m < 4; ++m)
#pragma unroll
                for (int bj = 0; bj < 2; ++bj) { const int row = row0 + ai * HALF + m * 16; const u32x4 g4 = gw[m][bj];
                    f32x4 v0 = acc[ai][bj][m][0], v1 = acc[ai][bj][m][1];
                    v0[0] *= bflo(g4.x); v0[1] *= bfhi(g4.x); v0[2] *= bflo(g4.y); v0[3] *= bfhi(g4.y); v1[0] *= bflo(g4.z); v1[1] *= bfhi(g4.z); v1[2] *= bflo(g4.w); v1[3] *= bfhi(g4.w);
                    if (accum) { const u32x4 o4 = ow[m][bj];
                        v0[0] += bflo(o4.x); v0[1] += bfhi(o4.x); v0[2] += bflo(o4.y); v0[3] += bfhi(o4.y); v1[0] += bflo(o4.z); v1[1] += bfhi(o4.z); v1[2] += bflo(o4.w); v1[3] += bfhi(o4.w); }
                    *(u32x4*)(Mg + (size_t)row * ldm + col0 + bj * HALF) = pack8(v0, v1); }
        }
    }
};
typedef float f32x2 __attribute__((ext_vector_type(2))); typedef unsigned u32x2 __attribute__((ext_vector_type(2)));
__device__ __forceinline__ unsigned dpp_shr1(unsigned old, unsigned v) { return (unsigned)__builtin_amdgcn_update_dpp((int)old, (int)v, 0x111, 0xF, 0xF, false); }
__device__ __forceinline__ unsigned dpp_shr2(unsigned old, unsigned v) { return (unsigned)__builtin_amdgcn_update_dpp((int)old, (int)v, 0x112, 0xF, 0xF, false); }
__device__ __forceinline__ unsigned dpp_ror1(unsigned v) { return (unsigned)__builtin_amdgcn_update_dpp(0, (int)v, 0x121, 0xF, 0xF, true); }
__device__ __forceinline__ unsigned dpp_ror2(unsigned v) { return (unsigned)__builtin_amdgcn_update_dpp(0, (int)v, 0x122, 0xF, 0xF, true); }
struct EpiUpAct {
    static constexpr bool PERM = true, AFTER_DRAIN = false, ASWAP = true;
    bf16_t* ACT; int dff; const float* cw; bf16_t* halo;
    __device__ __forceinline__ void operator()(const f32x4 (&acc)[2][2][4][2], const Unit& u, int wr_, int wc_, int fr_, int fq_) const {
        int tl = threadIdx.x; asm volatile("" : "+v"(tl));
        const int lane = tl & 63, wid = tl >> 6, wr = wid >> 2, wc = wid & 3, fr = lane & 15, fq = lane >> 4; (void)wr_; (void)wc_; (void)fr_; (void)fq_;
        const int nup = 2 * dff, j0 = u.pn * 128 + wc * 32 + 8 * fq;
        const int tok0 = u.pm * BM + wr * 128;
        unsigned pk[8][2][2][2];
#pragma unroll
        for (int q = 0; q < 8; ++q)
#pragma unroll
            for (int bj = 0; bj < 2; ++bj)
#pragma unroll
                for (int n = 0; n < 2; ++n) { const f32x4 v = acc[q >> 2][bj][q & 3][n]; pk[q][bj][n][0] = cvt_pk_bf16(v[0], v[1]); pk[q][bj][n][1] = cvt_pk_bf16(v[2], v[3]); }
        __builtin_amdgcn_sched_barrier(0);
        { const int blk = tok0 >> 7;
          if (fr < 2) {
#pragma unroll
              for (int bj = 0; bj < 2; ++bj) *(u32x4*)(halo + ((size_t)blk * 4 + fr) * nup + bj * dff + j0) = (u32x4){pk[0][bj][0][0], pk[0][bj][0][1], pk[0][bj][1][0], pk[0][bj][1][1]}; }
          if (fr >= 14) {
#pragma unroll
              for (int bj = 0; bj < 2; ++bj) *(u32x4*)(halo + ((size_t)blk * 4 + fr - 12) * nup + bj * dff + j0) = (u32x4){pk[7][bj][0][0], pk[7][bj][0][1], pk[7][bj][1][0], pk[7][bj][1][1]}; } }
        __builtin_amdgcn_sched_barrier(0);
        unsigned op[8][2][2];
#pragma unroll
        for (int n = 0; n < 2; ++n)
#pragma unroll
            for (int h = 0; h < 2; ++h) {
                f32x2 wa[3], wb[3];
                { int wo = j0 + 4 * n + 2 * h; asm volatile("" : "+v"(wo));
#pragma unroll
                  for (int k = 0; k < 3; ++k) { wa[k] = *(const __attribute__((address_space(1))) f32x2*)(cw + wo + k * nup); wb[k] = *(const __attribute__((address_space(1))) f32x2*)(cw + wo + k * nup + dff); } }
                unsigned ra1 = 0u, ra2 = 0u, rb1 = 0u, rb2 = 0u;
#pragma unroll
                for (int q = 0; q < 8; ++q) { unsigned a = pk[q][0][n][h], b = pk[q][1][n][h];
                    if (q > 0) asm volatile("" : "+v"(a), "+v"(b), "+v"(op[q - 1][n][h])); else asm volatile("" : "+v"(a), "+v"(b));
                    const unsigned pa1 = dpp_shr1(ra1, a), pa2 = dpp_shr2(ra2, a), pb1 = dpp_shr1(rb1, b), pb2 = dpp_shr2(rb2, b);
                    if (q < 7) { ra1 = dpp_ror1(a); ra2 = dpp_ror2(a); rb1 = dpp_ror1(b); rb2 = dpp_ror2(b); }
                    const float ca0 = wa[0][0] * bflo(a) + wa[1][0] * bflo(pa1) + wa[2][0] * bflo(pa2), ca1 = wa[0][1] * bfhi(a) + wa[1][1] * bfhi(pa1) + wa[2][1] * bfhi(pa2);
                    const float cb0 = wb[0][0] * bflo(b) + wb[1][0] * bflo(pb1) + wb[2][0] * bflo(pb2), cb1 = wb[0][1] * bfhi(b) + wb[1][1] * bfhi(pb1) + wb[2][1] * bfhi(pb2);
                    op[q][n][h] = cvt_pk_bf16(ca0 * sigm(ca0) * cb0, ca1 * sigm(ca1) * cb1);
                    __builtin_amdgcn_sched_barrier(0); }
            }
        size_t ao = (size_t)(tok0 + fr) * dff + j0;
#pragma unroll
        for (int q = 0; q < 8; ++q) { asm volatile("" : "+v"(ao));
            if (q > 0 || fr >= 2) *(__attribute__((address_space(1))) u32x4*)(ACT + ao) = (u32x4){op[q][0][0], op[q][0][1], op[q][1][0], op[q][1][1]};
            ao += (size_t)16 * dff; }
    }
};
struct BrTripleOrder {
    StaticOrder so;
    __host__ __device__ void init(int M, int N, int G_, int c_) { so.init(M, N, G_, c_); }
    __host__ __device__ bool next(int i, Unit& u) const { Unit t; const int j = i / 3, k = i - 3 * j; if (!so.next(j, t)) return false; const int br = (k == 2) ? 0 : k + 1; u.pm = t.pm + 64 * br; u.pn = t.pn + 8 * br; return true; }
    __device__ __forceinline__ void a_ready(const Unit&) const {}
    __device__ __forceinline__ void done(const Unit&) const {}
};
template <class Epi, class Sched, bool ALIGN_EPI = false, bool SP2 = false>
__device__ __forceinline__ void gemm_phase(PG8_LAS unsigned char* lds, const Gemm g, const Sched& S, const Epi& E) {
    int tid = threadIdx.x; asm volatile("" : "+v"(tid)); const int wid = __builtin_amdgcn_readfirstlane(tid >> 6), lane = tid & 63, wr = wid >> 2, wc = wid & 3, fr = lane & 15, fq = lane >> 4;
    const int K = g.K, nt = K / BK;
    unsigned voffA[2], voffB[2];
#pragma unroll
    for (int i = 0; i < 2; ++i) { int R, C; stage_rc(tid * 16 + i * 8192, R, C); const int Rb = Epi::PERM ? ((R & ~31) + perm32(R & 31)) : R;
        const int Ra = Epi::ASWAP ? ((R >> 6) * 128 + (R & 63)) : R;
        voffA[i] = (unsigned)(Ra * K + C) * 2u; voffB[i] = (unsigned)(Rb * K + C) * 2u; }
    const size_t kstep = (size_t)(BK * 2);
    const size_t hstep = (size_t)HALF * K * 2;
    const size_t hstepA = Epi::ASWAP ? (size_t)64 * K * 2 : hstep;
    const size_t tstep = 2 * hstep;
    const unsigned ldsw = (unsigned)wid * 1024u;
    const int aoff = lds_byte(wr * 64 + fr, fq * 8), boff = lds_byte(wc * 32 + fr, fq * 8);
#define PG8_SA(b, h) (((b) * 2 + (h)) * HTB)
#define PG8_SB(b, h) ((4 + (b) * 2 + (h)) * HTB)
#define PG8_STAGE(bufoff, gbase, voff) do { _Pragma("unroll") for (int _i = 0; _i < 2; ++_i) \
        __builtin_amdgcn_global_load_lds((const unsigned*)((const char*)(gbase) + (voff)[_i]), (PG8_LAS unsigned*)(lds + (bufoff) + ldsw + _i * 8192), 16, 0, 0); } while (0)
#define PG8_LDA(dst, b, h) do { _Pragma("unroll") for (int m = 0; m < 4; ++m) _Pragma("unroll") for (int k = 0; k < 2; ++k) dst[m][k] = *(const PG8_LAS bf16x8*)(lds + PG8_SA(b, h) + aoff + m * 2048 + k * 1024); } while (0)
#define PG8_LDB(dst, b, h) do { _Pragma("unroll") for (int n = 0; n < 2; ++n) _Pragma("unroll") for (int k = 0; k < 2; ++k) dst[n][k] = *(const PG8_LAS bf16x8*)(lds + PG8_SB(b, h) + boff + n * 2048 + k * 1024); } while (0)
#define PG8_MMA(ai, bj, At, Bt) do { __builtin_amdgcn_s_setprio(1); _Pragma("unroll") for (int m = 0; m < 4; ++m) _Pragma("unroll") for (int n = 0; n < 2; ++n) _Pragma("unroll") for (int k = 0; k < 2; ++k) \
        acc[ai][bj][m][n] = __builtin_amdgcn_mfma_f32_16x16x32_bf16(Bt[n][k], At[m][k], acc[ai][bj][m][n], 0, 0, 0); __builtin_amdgcn_s_setprio(0); } while (0)
#define PG8_WAIT_V(n) asm volatile("s_waitcnt vmcnt(" #n ")" ::: "memory")
#define PG8_WAIT_L(n) asm volatile("s_waitcnt lgkmcnt(" #n ")" ::: "memory")
#define PG8_BAR __builtin_amdgcn_s_barrier()
#define PG8_SCHED __builtin_amdgcn_sched_barrier(0)
    Unit cur, nxt; int ui = 0;
    if (!S.next(0, cur)) return;
    f32x4 acc[2][2][4][2];
#pragma unroll
    for (int a = 0; a < 2; ++a)
#pragma unroll
        for (int b = 0; b < 2; ++b)
#pragma unroll
            for (int m = 0; m < 4; ++m)
#pragma unroll
                for (int n = 0; n < 2; ++n) acc[a][b][m][n] = (f32x4){0.f, 0.f, 0.f, 0.f};
    bf16x8 At[4][2], B0[2][2], B1[2][2];
    const char* cA = (const char*)g.A + (size_t)cur.pm * tstep; const char* cB = (const char*)g.Bt + (size_t)cur.pn * tstep;
    S.a_ready(cur);
    if constexpr (SP2) {
        PG8_STAGE(PG8_SB(0, 0), cB, voffB); PG8_STAGE(PG8_SB(0, 1), cB + hstep, voffB); PG8_STAGE(PG8_SA(0, 0), cA, voffA); PG8_STAGE(PG8_SA(0, 1), cA + hstepA, voffA);
        if (wr == 1) PG8_BAR;
        PG8_WAIT_V(2); PG8_BAR;
        PG8_STAGE(PG8_SB(1, 0), cB + kstep, voffB); PG8_STAGE(PG8_SA(1, 0), cA + kstep, voffA); PG8_STAGE(PG8_SB(1, 1), cB + hstep + kstep, voffB);
        PG8_WAIT_V(6); PG8_BAR;
    } else {
        PG8_STAGE(PG8_SB(0, 0), cB, voffB); PG8_STAGE(PG8_SA(0, 0), cA, voffA); PG8_STAGE(PG8_SB(0, 1), cB + hstep, voffB); PG8_STAGE(PG8_SA(0, 1), cA + hstepA, voffA);
        if (wr == 1) PG8_BAR;
        PG8_WAIT_V(4); PG8_BAR;
        PG8_STAGE(PG8_SB(1, 0), cB + kstep, voffB); PG8_STAGE(PG8_SA(1, 0), cA + kstep, voffA); PG8_STAGE(PG8_SB(1, 1), cB + hstep + kstep, voffB);
        PG8_WAIT_V(6); PG8_BAR;
    }
    for (;;) {
        const bool has_next = S.next(ui + 1, nxt);
        const char* nA = has_next ? (const char*)g.A + (size_t)nxt.pm * tstep : cA; const char* nB = has_next ? (const char*)g.Bt + (size_t)nxt.pn * tstep : cB;
        for (int t = 0; t < nt; t += 2) {
            const bool last = (t == nt - 2);
            const char* a1 = cA + (size_t)(t + 1) * kstep;
            const char* a2 = last ? nA : cA + (size_t)(t + 2) * kstep; const char* b2 = last ? nB : cB + (size_t)(t + 2) * kstep;
            const char* a3 = a2 + kstep; const char* b3 = b2 + kstep;
            if (last && has_next) S.a_ready(nxt);
            if constexpr (SP2) {
            PG8_LDB(B0, 0, 0); PG8_LDB(B1, 0, 1); PG8_SCHED; PG8_LDA(At, 0, 0); PG8_STAGE(PG8_SA(1, 1), a1 + hstepA, voffA);
            PG8_WAIT_V(8); PG8_WAIT_L(0); PG8_BAR; PG8_MMA(0, 0, At, B0); PG8_MMA(0, 1, At, B1); PG8_BAR; PG8_SCHED;
            PG8_LDA(At, 0, 1); PG8_STAGE(PG8_SB(0, 0), b2, voffB); PG8_STAGE(PG8_SB(0, 1), b2 + hstep, voffB); PG8_STAGE(PG8_SA(0, 0), a2, voffA);
            PG8_WAIT_V(8); PG8_WAIT_L(0); PG8_BAR; PG8_MMA(1, 0, At, B0); PG8_MMA(1, 1, At, B1); PG8_BAR; PG8_SCHED;
            PG8_LDB(B0, 1, 0); PG8_LDB(B1, 1, 1); PG8_SCHED; PG8_LDA(At, 1, 0); PG8_STAGE(PG8_SA(0, 1), a2 + hstepA, voffA);
            PG8_WAIT_V(8); PG8_WAIT_L(0); PG8_BAR; PG8_MMA(0, 0, At, B0); PG8_MMA(0, 1, At, B1); PG8_BAR; PG8_SCHED;
            PG8_LDA(At, 1, 1); PG8_STAGE(PG8_SB(1, 0), b3, voffB); PG8_STAGE(PG8_SB(1, 1), b3 + hstep, voffB); PG8_STAGE(PG8_SA(1, 0), a3, voffA);
            PG8_WAIT_V(8); PG8_WAIT_L(0); PG8_BAR; PG8_MMA(1, 0, At, B0); PG8_MMA(1, 1, At, B1); PG8_BAR; PG8_SCHED;
            } else {
            PG8_LDB(B0, 0, 0); PG8_SCHED; PG8_LDA(At, 0, 0); PG8_STAGE(PG8_SA(1, 1), a1 + hstepA, voffA);
            PG8_WAIT_L(8); PG8_BAR; PG8_WAIT_L(0); PG8_MMA(0, 0, At, B0); PG8_BAR; PG8_SCHED;
            PG8_LDB(B1, 0, 1); PG8_STAGE(PG8_SB(0, 0), b2, voffB);
            PG8_BAR; PG8_WAIT_L(0); PG8_MMA(0, 1, At, B1); PG8_BAR;
            PG8_LDA(At, 0, 1); PG8_STAGE(PG8_SA(0, 0), a2, voffA);
            PG8_BAR; PG8_WAIT_L(0); PG8_MMA(1, 0, At, B0); PG8_BAR; PG8_SCHED;
            PG8_STAGE(PG8_SB(0, 1), b2 + hstep, voffB);
            PG8_WAIT_V(6); PG8_BAR; PG8_MMA(1, 1, At, B1); PG8_BAR;
            PG8_LDB(B0, 1, 0); PG8_SCHED; PG8_LDA(At, 1, 0); PG8_STAGE(PG8_SA(0, 1), a2 + hstepA, voffA);
            PG8_WAIT_L(8); PG8_BAR; PG8_WAIT_L(0); PG8_MMA(0, 0, At, B0); PG8_BAR; PG8_SCHED;
            PG8_LDB(B1, 1, 1); PG8_STAGE(PG8_SB(1, 0), b3, voffB);
            PG8_BAR; PG8_WAIT_L(0); PG8_MMA(0, 1, At, B1); PG8_BAR;
            PG8_LDA(At, 1, 1); PG8_STAGE(PG8_SA(1, 0), a3, voffA);
            PG8_BAR; PG8_WAIT_L(0); PG8_MMA(1, 0, At, B0); PG8_BAR; PG8_SCHED;
            PG8_STAGE(PG8_SB(1, 1), b3 + hstep, voffB);
            PG8_WAIT_V(6); PG8_BAR; PG8_MMA(1, 1, At, B1); PG8_BAR;
            }
        }
        if constexpr (ALIGN_EPI) { if (wr == 0) PG8_BAR; }
        if constexpr (!Epi::AFTER_DRAIN) { E(acc, cur, wr, wc, fr, fq); S.done(cur); }
        if (!has_next) break;
#pragma unroll
        for (int a = 0; a < 2; ++a)
#pragma unroll
            for (int b = 0; b < 2; ++b)
#pragma unroll
                for (int m = 0; m < 4; ++m)
#pragma unroll
                    for (int n = 0; n < 2; ++n) acc[a][b][m][n] = (f32x4){0.f, 0.f, 0.f, 0.f};
        cur = nxt; cA = nA; cB = nB; ++ui;
        if constexpr (ALIGN_EPI) { if (wr == 1) PG8_BAR; }
    }
    PG8_WAIT_V(0);
    if constexpr (!ALIGN_EPI) { if (wr == 0) PG8_BAR; }
    PG8_BAR;
    if constexpr (Epi::AFTER_DRAIN) { E.fused(acc, cur, wr, wc, fr, fq, lds, wid, lane); S.done(cur); }
#undef PG8_SA
#undef PG8_SB
#undef PG8_STAGE
#undef PG8_LDA
#undef PG8_LDB
#undef PG8_MMA
#undef PG8_WAIT_V
#undef PG8_WAIT_L
#undef PG8_BAR
#undef PG8_SCHED
}
}
constexpr int NWAVES = 8;
constexpr int DM = 2048, BATCH = 8, SEQ = 2048, DEPTH = 4, M = BATCH * SEQ;
constexpr int SSMW = 512, NGRP = 32, NST = 64, HD = 64;
constexpr int OFF_Q = 512, OFF_K = 2048, OFF_V = 3584, OFF_CB = 5120, OFF_CC = 5632, OFF_CH = 6144, OFF_GATE = 6656, N_IN = 12800;
constexpr int DFF = 5632, NUP = 2 * DFF;
constexpr int NMOD = 6 * DM;
constexpr float RMS_EPS = 1e-6f;
enum { I_X = 0, I_C, I_WMOD, I_BMOD, I_GPRE_MIX, I_GPOST_MIX, I_GPRE_FFN, I_GPOST_FFN, I_WIN, I_LOGDT, I_ARE, I_AIM, I_BRE, I_BIM, I_CRE, I_CIM, I_SSMD, I_WGLU, I_BGLU,
       I_CONVW, I_WSSM, I_WATT, I_WCNV, I_BGATE, I_WO, I_WUP, I_FCONVW, I_WDOWN, N_INPUTS };
constexpr size_t MiB = 1u << 20;
constexpr size_t WS_CTL = 0, CTL_ZERO_BYTES = 1 * MiB;
constexpr size_t WS_MOD = 1 * MiB;
constexpr size_t WS_W = 4 * MiB;
constexpr size_t WB_IN = 0, WB_GLU = WB_IN + (size_t)N_IN * DM * 2, WB_BR = WB_GLU + (size_t)SSMW * SSMW * 2, WB_O = WB_BR + (size_t)3 * DM * SSMW * 2,
                 WB_UP = WB_O + (size_t)DM * DM * 2, WB_DN = WB_UP + (size_t)NUP * DM * 2, WB_LAYER = WB_DN + (size_t)DM * DFF * 2;
static_assert(WB_LAYER == (size_t)(50 * MiB + MiB / 2 + 6 * MiB + 8 * MiB + 44 * MiB + 22 * MiB), "weights per layer");
constexpr size_t WS_H = 528 * MiB;
constexpr size_t WS_PROJ = 592 * MiB;
constexpr size_t WS_ACT = 992 * MiB;
constexpr size_t WS_G = 1168 * MiB;
constexpr size_t WS_A3 = 1184 * MiB;
constexpr size_t WS_MG = 1232 * MiB;
constexpr size_t WS_Y = 1296 * MiB;
constexpr size_t WS_MODP = 1424 * MiB;
constexpr size_t WS_XB = 1360 * MiB;
constexpr size_t WS_PART = 1432 * MiB;
constexpr size_t WS_PARTML = 1464 * MiB;
constexpr size_t WS_END = 1466 * MiB;
static_assert(WS_W + DEPTH * WB_LAYER <= WS_H && WS_PROJ + (size_t)M * N_IN * 2 <= WS_ACT && WS_ACT + (size_t)M * DFF * 2 <= WS_G, "ws map");
constexpr int CW_BAR = 4096;
constexpr int RING_BYTES = 131072, MISC_OFF = 143360, LDS_BYTES = 147456;

#define GAS __attribute__((address_space(1)))
#define LAS __attribute__((address_space(3)))
typedef unsigned short bf16;
typedef unsigned v4u __attribute__((ext_vector_type(4)));
typedef unsigned v2u __attribute__((ext_vector_type(2)));
typedef float f32x4 __attribute__((ext_vector_type(4)));
typedef short bf16x8 __attribute__((ext_vector_type(8)));
typedef short s16x4 __attribute__((ext_vector_type(4)));
#define LDS_WAIT() asm volatile("s_waitcnt lgkmcnt(0)" ::: "memory")
#define VM_WAIT() asm volatile("s_waitcnt vmcnt(0)" ::: "memory")
__device__ __forceinline__ unsigned f2bf(float f) { unsigned u = __builtin_bit_cast(unsigned, f); return (u + 0x7fffu + ((u >> 16) & 1u)) >> 16; }
__device__ __forceinline__ unsigned pk2(float lo, float hi) { return pg8::cvt_pk_bf16(lo, hi); }
__device__ __forceinline__ float bflo(unsigned w) { return __uint_as_float(w << 16); }
__device__ __forceinline__ float bfhi(unsigned w) { return __uint_as_float(w & 0xffff0000u); }
__device__ __forceinline__ void unpack8(const v4u w, float (&f)[8]) { f[0] = bflo(w.x); f[1] = bfhi(w.x); f[2] = bflo(w.y); f[3] = bfhi(w.y); f[4] = bflo(w.z); f[5] = bfhi(w.z); f[6] = bflo(w.w); f[7] = bfhi(w.w); }
__device__ __forceinline__ v4u pack8f(const float (&f)[8]) { v4u w; w.x = pk2(f[0], f[1]); w.y = pk2(f[2], f[3]); w.z = pk2(f[4], f[5]); w.w = pk2(f[6], f[7]); return w; }
__device__ __forceinline__ float wave_sum(float v) {
#pragma unroll
    for (int o = 1; o < 64; o <<= 1) v += __shfl_xor(v, o);
    return v;
}
#define XB_TMO      128
#define XB_XCNT(j)  (256  + 64 * (j))
#define XB_XSUB(j)  (1280 + 64 * (j))
#define XB_XGEN(j)  (2304 + 64 * (j))
#define XB_TOP      3328
#define XB_TOPGEN   3392
#define XCD_BAR_WORDS 3456
#define XB_SPIN_CAP (1u << 18)

__device__ __forceinline__ unsigned xb_ld(unsigned* p)              { return __hip_atomic_load(p, __ATOMIC_RELAXED, __HIP_MEMORY_SCOPE_AGENT); }
__device__ __forceinline__ unsigned xb_add(unsigned* p, unsigned v) { return __hip_atomic_fetch_add(p, v, __ATOMIC_RELAXED, __HIP_MEMORY_SCOPE_AGENT); }
__device__ __forceinline__ unsigned xb_xcc_id() { return (unsigned)__builtin_amdgcn_s_getreg((3 << 11) | 20) & 0xFu; }
#define XB_SPIN(cond, bar) do { unsigned _sp = 0; while (cond) { __builtin_amdgcn_s_sleep(1); \
    if ((++_sp & 255u) == 0u) { if (xb_ld(&(bar)[XB_TMO])) break; if (_sp > XB_SPIN_CAP) { atomicAdd(&(bar)[XB_TMO], 1u); break; } } } } while (0)

struct XcdBarrier {
    unsigned* bar; unsigned x;
    volatile LAS unsigned* st;
};

__device__ __forceinline__ XcdBarrier xcd_barrier_post(unsigned* bar, volatile LAS unsigned* st) {
    XcdBarrier b; b.bar = bar; b.x = xb_xcc_id(); b.st = st;
    if (threadIdx.x == 0) (void)xb_add(&bar[XB_XCNT(b.x)], 1u);
    return b;
}
__device__ __forceinline__ void xcd_barrier_complete(unsigned* bar, unsigned x, unsigned& nloc, unsigned& nx) {
    const unsigned G = gridDim.x * gridDim.y * gridDim.z;
    unsigned sum, cnt, mine, sp = 0u;
    for (;;) {
        sum = 0u; cnt = 0u; mine = 0u;
#pragma unroll
        for (unsigned j = 0; j < 16; ++j) { const unsigned c = xb_ld(&bar[XB_XCNT(j)]); sum += c; cnt += (c > 0u) ? 1u : 0u; mine = (j == x) ? c : mine; }
        if (sum == G) break;
        __builtin_amdgcn_s_sleep(1);
        if ((++sp & 255u) == 0u) { if (xb_ld(&bar[XB_TMO])) break; if (sp > XB_SPIN_CAP) { atomicAdd(&bar[XB_TMO], 1u); break; } }
    }
    nloc = mine > 0u ? mine : 1u; nx = cnt > 0u ? cnt : 1u;
}

__device__ __forceinline__ void xcd_barrier(const XcdBarrier& b) {
    asm volatile("s_waitcnt vmcnt(0)" ::: "memory");
    __syncthreads();
    if (threadIdx.x == 0) {
        unsigned* bar = b.bar;
        __builtin_amdgcn_s_waitcnt(0);
        unsigned nloc = b.st[0], nx = b.st[1];
        if (nloc == 0u) { xcd_barrier_complete(bar, b.x, nloc, nx); b.st[0] = nloc; b.st[1] = nx; }
        const unsigned old = xb_add(&bar[XB_XSUB(b.x)], 1u);
        const unsigned gen = old / nloc;
        if (old + 1u == (gen + 1u) * nloc) {
            __builtin_amdgcn_fence(__ATOMIC_RELEASE, "agent");
            asm volatile("s_waitcnt vmcnt(0)" ::: "memory");
            const unsigned og = xb_add(&bar[XB_TOP], 1u);
            const unsigned tg = og / nx;
            if (og + 1u == (tg + 1u) * nx) xb_add(&bar[XB_TOPGEN], 1u);
            else XB_SPIN(xb_ld(&bar[XB_TOPGEN]) == tg, bar);
            __builtin_amdgcn_fence(__ATOMIC_ACQUIRE, "agent");
            xb_add(&bar[XB_XGEN(b.x)], 1u);
            asm volatile("s_waitcnt vmcnt(0)" ::: "memory");
        } else {
            XB_SPIN(xb_ld(&bar[XB_XGEN(b.x)]) == gen, bar);
            __builtin_amdgcn_fence(__ATOMIC_ACQUIRE, "agent");
            asm volatile("s_waitcnt vmcnt(0)" ::: "memory");
        }
    }
    __syncthreads();
}
constexpr int TI_IN = (DM / 64) * (N_IN / 32), TI_GLU = (SSMW / 64) * (SSMW / 32), TI_BR = (SSMW / 64) * (DM / 32), TI_O = (DM / 64) * (DM / 32), TI_UP = (DM / 64) * (NUP / 32), TI_DN = (DFF / 64) * (DM / 32);
constexpr int TI_LAYER = TI_IN + TI_GLU + 3 * TI_BR + TI_O + TI_UP + TI_DN, TI_ALL = DEPTH * TI_LAYER;
struct TItem { const float* src; bf16* dst; int N, K; };
__device__ __forceinline__ TItem titem_of(const float* W, int K, int N, bf16* WT, int row_off, int item, int lane) {
    const int nblk = N / 32, kb = item / nblk, nb = item % nblk, k0 = 64 * kb, n0 = 32 * nb;
    TItem t; t.src = W + (size_t)(k0 + (lane >> 5)) * N + n0 + (lane & 31); t.dst = WT + (size_t)(row_off + n0) * K + k0; t.N = N; t.K = K; return t;
}
__device__ __forceinline__ TItem titem_any(const float* const* in, unsigned char* ws, int it, int lane) {
    const int l = it / TI_LAYER; int r = it % TI_LAYER;
    unsigned char* wl = ws + WS_W + (size_t)l * WB_LAYER;
    if (r < TI_IN) return titem_of(in[I_WIN] + (size_t)l * DM * N_IN, DM, N_IN, (bf16*)(wl + WB_IN), 0, r, lane); r -= TI_IN;
    if (r < TI_GLU) return titem_of(in[I_WGLU] + (size_t)l * SSMW * SSMW, SSMW, SSMW, (bf16*)(wl + WB_GLU), 0, r, lane); r -= TI_GLU;
    if (r < TI_BR) return titem_of(in[I_WSSM] + (size_t)l * SSMW * DM, SSMW, DM, (bf16*)(wl + WB_BR), 0, r, lane); r -= TI_BR;
    if (r < TI_BR) return titem_of(in[I_WATT] + (size_t)l * SSMW * DM, SSMW, DM, (bf16*)(wl + WB_BR), DM, r, lane); r -= TI_BR;
    if (r < TI_BR) return titem_of(in[I_WCNV] + (size_t)l * SSMW * DM, SSMW, DM, (bf16*)(wl + WB_BR), 2 * DM, r, lane); r -= TI_BR;
    if (r < TI_O) return titem_of(in[I_WO] + (size_t)l * DM * DM, DM, DM, (bf16*)(wl + WB_O), 0, r, lane); r -= TI_O;
    if (r < TI_UP) { const int n0 = 32 * (r % (NUP / 32));
        const int d0 = (n0 < DFF) ? 256 * (n0 / 128) + (n0 % 128) : 256 * ((n0 - DFF) / 128) + 128 + ((n0 - DFF) % 128);
        return titem_of(in[I_WUP] + (size_t)l * DM * NUP, DM, NUP, (bf16*)(wl + WB_UP), d0 - n0, r, lane); } r -= TI_UP;
    return titem_of(in[I_WDOWN] + (size_t)l * DFF * DM, DFF, DM, (bf16*)(wl + WB_DN), 0, r, lane);
}
__device__ __forceinline__ void titem_load(const TItem& t, float (&wv)[32]) {
#pragma unroll
    for (int i = 0; i < 32; ++i) wv[i] = __builtin_nontemporal_load(t.src + (size_t)(2 * i) * t.N);
}
__device__ __forceinline__ void titem_store(const TItem& t, const float (&wv)[32], LAS float* scr, int lane) {
#pragma unroll
    for (int i = 0; i < 32; ++i) scr[(2 * i + (lane >> 5)) * 33 + (lane & 31)] = wv[i];
    LDS_WAIT(); asm volatile("" ::: "memory");
    const int c = lane & 7;
#pragma unroll
    for (int j = 0; j < 4; ++j) { const int n = (lane >> 3) + 8 * j; const LAS float* s = scr + (8 * c) * 33 + n;
        v4u o; o.x = pk2(s[0 * 33], s[1 * 33]); o.y = pk2(s[2 * 33], s[3 * 33]); o.z = pk2(s[4 * 33], s[5 * 33]); o.w = pk2(s[6 * 33], s[7 * 33]);
        *(GAS v4u*)(t.dst + (size_t)n * t.K + 8 * c) = o; }
    LDS_WAIT(); asm volatile("" ::: "memory");
}
__device__ __forceinline__ void convert_items(const float* const* in, unsigned char* ws, LAS float* scr, int first, int end, int step, int lane) {
    if (first >= end) return;
    float wa[32], wb[32];
    TItem cur = titem_any(in, ws, first, lane); titem_load(cur, wa);
    for (int it = first; it < end; it += step) {
        const bool more = it + step < end; TItem nx = cur;
        if (more) { nx = titem_any(in, ws, it + step, lane); titem_load(nx, wb); }
        titem_store(cur, wa, scr, lane);
        if (more) {
#pragma unroll
            for (int i = 0; i < 32; ++i) wa[i] = wb[i];
            cur = nx; }
    }
}
constexpr int MOD_KS = 4, MOD_ITEMS = DEPTH * (NMOD / 64) * MOD_KS, MOD_PART = DEPTH * BATCH * NMOD;
__device__ __forceinline__ void p0_mod_item(const float* const* in, float* mod, const LAS float* condL, int item, int lane) {
    const int ks = item % MOD_KS, it2 = item / MOD_KS, l = it2 / (NMOD / 64), j = (it2 % (NMOD / 64)) * 64 + lane, kbeg = ks * (DM / MOD_KS);
    const float* wp = in[I_WMOD] + (size_t)l * DM * NMOD + (size_t)kbeg * NMOD + j;
    float acc[8];
#pragma unroll
    for (int b = 0; b < 8; ++b) acc[b] = 0.f;
    for (int k0 = 0; k0 < DM / MOD_KS; k0 += 16) {
        float w[16];
#pragma unroll
        for (int i = 0; i < 16; ++i) w[i] = __builtin_nontemporal_load(wp + (size_t)(k0 + i) * NMOD);
#pragma unroll
        for (int i = 0; i < 16; ++i) { const int k = kbeg + k0 + i; const f32x4 c0 = *(const LAS f32x4*)(condL + k * 8), c1 = *(const LAS f32x4*)(condL + k * 8 + 4);
            acc[0] += w[i] * c0[0]; acc[1] += w[i] * c0[1]; acc[2] += w[i] * c0[2]; acc[3] += w[i] * c0[3]; acc[4] += w[i] * c1[0]; acc[5] += w[i] * c1[1]; acc[6] += w[i] * c1[2]; acc[7] += w[i] * c1[3]; }
    }
#pragma unroll
    for (int b = 0; b < 8; ++b) mod[(size_t)ks * MOD_PART + (size_t)(l * BATCH + b) * NMOD + j] = acc[b];
}
__device__ __forceinline__ void p0_mod_reduce(const float* const* in, const float* part, float* mod, int gtid, int nthreads) {
    for (int i = gtid; i < DEPTH * BATCH * NMOD; i += nthreads) { const int j = i % NMOD, l = i / (BATCH * NMOD);
        mod[i] = ((part[i] + part[MOD_PART + i]) + (part[2 * (size_t)MOD_PART + i] + part[3 * (size_t)MOD_PART + i])) + in[I_BMOD][l * NMOD + j]; }
}
__device__ __forceinline__ void p0_prologue(const float* const* in, unsigned char* ws, LAS unsigned char* lds, int tid, int wave, int lane, int vcu, int G) {
    LAS float* condL = (LAS float*)lds;
    LAS float* scr = (LAS float*)(lds + 65536 + wave * 8448);
    for (int idx = tid; idx < BATCH * DM; idx += NWAVES * 64) { const int b = idx & 7, k = idx >> 3; const float cv = in[I_C][b * DM + k]; condL[idx] = cv / (1.0f + __expf(-cv)); }
    __syncthreads();
    const int gw2 = wave * G + vcu, NGW = G * NWAVES;
    for (int q = gw2; q < MOD_ITEMS; q += NGW) p0_mod_item(in, (float*)(ws + WS_MODP), condL, q, lane);
    convert_items(in, ws, scr, gw2, TI_LAYER, NGW, lane);
}

__device__ __forceinline__ void convert_layer_share(const float* const* in, unsigned char* ws, LAS float* scr, int l, int gw2, int NGW, int lane) {
    convert_items(in, ws, scr, l * TI_LAYER + gw2, (l + 1) * TI_LAYER, NGW, lane);
}

template <bool POST, bool XI_BF>
__device__ __forceinline__ void norm_load(const void* xi_, const bf16* y, int m, int lane, f32x4 (&xr)[4][2], v4u (&yr)[4]) {
#pragma unroll
    for (int j = 0; j < 4; ++j) { const int col = 8 * (lane + 64 * j);
        if (XI_BF) { const v4u w = *(const GAS v4u*)((const bf16*)xi_ + (size_t)m * DM + col); xr[j][0] = __builtin_bit_cast(f32x4, w); }
        else { const float* xi = (const float*)xi_; xr[j][0] = *(const GAS f32x4*)(xi + (size_t)m * DM + col); xr[j][1] = *(const GAS f32x4*)(xi + (size_t)m * DM + col + 4); }
        if (POST) yr[j] = *(const GAS v4u*)(y + (size_t)m * DM + col); }
}
template <bool POST, bool PRE, bool XI_BF, bool XO_BF>
__device__ __forceinline__ void norm_rows(const void* xi_, void* xo_, const bf16* y, const float* gpost, const float* gt, const float* gpre, const float* sc, const float* sh, bf16* h, int gw, int NGW, int lane) {
    constexpr int RPW = 8;
    for (int m0 = gw * RPW; m0 < M; m0 += NGW * RPW) {
        const int b = m0 / SEQ;
        f32x4 xr[4][2], xn[4][2]; v4u yr[4], yn[4];
        norm_load<POST, XI_BF>(xi_, y, m0, lane, xr, yr);
        for (int m = m0; m < m0 + RPW; ++m) {
            if (m + 1 < m0 + RPW) norm_load<POST, XI_BF>(xi_, y, m + 1, lane, xn, yn);
            float xv[4][8];
#pragma unroll
            for (int j = 0; j < 4; ++j) {
                if (XI_BF) unpack8(__builtin_bit_cast(v4u, xr[j][0]), xv[j]);
                else { xv[j][0] = xr[j][0][0]; xv[j][1] = xr[j][0][1]; xv[j][2] = xr[j][0][2]; xv[j][3] = xr[j][0][3]; xv[j][4] = xr[j][1][0]; xv[j][5] = xr[j][1][1]; xv[j][6] = xr[j][1][2]; xv[j][7] = xr[j][1][3]; } }
            if (POST) {
                float yv[4][8]; float ss = 0.f;
#pragma unroll
                for (int j = 0; j < 4; ++j) { unpack8(yr[j], yv[j]);
#pragma unroll
                    for (int e = 0; e < 8; ++e) ss += yv[j][e] * yv[j][e]; }
                const float rs = rsqrtf(wave_sum(ss) * (1.0f / DM) + RMS_EPS);
#pragma unroll
                for (int j = 0; j < 4; ++j) { const int col = 8 * (lane + 64 * j);
                    const f32x4 g0 = *(const GAS f32x4*)(gpost + col), g1 = *(const GAS f32x4*)(gpost + col + 4), t0 = *(const GAS f32x4*)(gt + (size_t)b * NMOD + col), t1 = *(const GAS f32x4*)(gt + (size_t)b * NMOD + col + 4);
#pragma unroll
                    for (int e = 0; e < 4; ++e) { xv[j][e] += t0[e] * (yv[j][e] * rs * g0[e]); xv[j][e + 4] += t1[e] * (yv[j][e + 4] * rs * g1[e]); }
                    if (XO_BF) { *(GAS v4u*)((bf16*)xo_ + (size_t)m * DM + col) = pack8f(xv[j]);
                        if (PRE) { float r[8]; unpack8(pack8f(xv[j]), r);
#pragma unroll
                            for (int e = 0; e < 8; ++e) xv[j][e] = r[e]; } }
                    else { float* xo = (float*)xo_; *(GAS f32x4*)(xo + (size_t)m * DM + col) = (f32x4){xv[j][0], xv[j][1], xv[j][2], xv[j][3]}; *(GAS f32x4*)(xo + (size_t)m * DM + col + 4) = (f32x4){xv[j][4], xv[j][5], xv[j][6], xv[j][7]}; } }
            }
            if (PRE) {
                float ss = 0.f;
#pragma unroll
                for (int j = 0; j < 4; ++j)
#pragma unroll
                    for (int e = 0; e < 8; ++e) ss += xv[j][e] * xv[j][e];
                const float rs = rsqrtf(wave_sum(ss) * (1.0f / DM) + RMS_EPS);
#pragma unroll
                for (int j = 0; j < 4; ++j) { const int col = 8 * (lane + 64 * j); float o[8];
                    const f32x4 g0 = *(const GAS f32x4*)(gpre + col), g1 = *(const GAS f32x4*)(gpre + col + 4), s0 = *(const GAS f32x4*)(sc + (size_t)b * NMOD + col), s1 = *(const GAS f32x4*)(sc + (size_t)b * NMOD + col + 4),
                                h0 = *(const GAS f32x4*)(sh + (size_t)b * NMOD + col), h1 = *(const GAS f32x4*)(sh + (size_t)b * NMOD + col + 4);
#pragma unroll
                    for (int e = 0; e < 4; ++e) { o[e] = xv[j][e] * rs * g0[e] * (1.0f + s0[e]) + h0[e]; o[e + 4] = xv[j][e + 4] * rs * g1[e] * (1.0f + s1[e]) + h1[e]; }
                    *(GAS v4u*)(h + (size_t)m * DM + col) = pack8f(o); }
            }
#pragma unroll
            for (int j = 0; j < 4; ++j) { xr[j][0] = xn[j][0]; xr[j][1] = xn[j][1]; yr[j] = yn[j]; }
        }
    }
}
__device__ __forceinline__ void ffn_fix_phase(const bf16* halo, bf16* act, const float* cw  , int gw, int NGW, int lane) {
    constexpr int NCH = DFF / 512, NBLK = M / 128;
    for (int it = gw; it < NCH * NBLK; it += NGW) {
        const int blk = it / NCH, ch = it % NCH, t0 = blk * 128, col = ch * 512 + lane * 8;
        float wa[3][8], wb[3][8];
#pragma unroll
        for (int k = 0; k < 3; ++k) { const f32x4 a0 = *(const GAS f32x4*)(cw + k * NUP + col), a1 = *(const GAS f32x4*)(cw + k * NUP + col + 4), b0 = *(const GAS f32x4*)(cw + k * NUP + DFF + col), b1 = *(const GAS f32x4*)(cw + k * NUP + DFF + col + 4);
#pragma unroll
            for (int e = 0; e < 4; ++e) { wa[k][e] = a0[e]; wa[k][e + 4] = a1[e]; wb[k][e] = b0[e]; wb[k][e + 4] = b1[e]; } }
        float am1[8], am2[8], bm1[8], bm2[8], a0[8], a1[8], b0[8], b1[8];
        if ((t0 % SEQ) == 0) {
#pragma unroll
            for (int e = 0; e < 8; ++e) { am1[e] = 0.f; am2[e] = 0.f; bm1[e] = 0.f; bm2[e] = 0.f; }
        } else { const bf16* hp = halo + (size_t)(blk - 1) * 4 * NUP;
            unpack8(*(const GAS v4u*)(hp + 3 * NUP + col), am1); unpack8(*(const GAS v4u*)(hp + 2 * NUP + col), am2);
            unpack8(*(const GAS v4u*)(hp + 3 * NUP + DFF + col), bm1); unpack8(*(const GAS v4u*)(hp + 2 * NUP + DFF + col), bm2); }
        { const bf16* hp = halo + (size_t)blk * 4 * NUP;
          unpack8(*(const GAS v4u*)(hp + col), a0); unpack8(*(const GAS v4u*)(hp + NUP + col), a1);
          unpack8(*(const GAS v4u*)(hp + DFF + col), b0); unpack8(*(const GAS v4u*)(hp + NUP + DFF + col), b1); }
        float o0[8], o1[8];
#pragma unroll
        for (int e = 0; e < 8; ++e) {
            const float ca0 = wa[0][e] * a0[e] + wa[1][e] * am1[e] + wa[2][e] * am2[e], cb0 = wb[0][e] * b0[e] + wb[1][e] * bm1[e] + wb[2][e] * bm2[e];
            const float ca1 = wa[0][e] * a1[e] + wa[1][e] * a0[e] + wa[2][e] * am1[e], cb1 = wb[0][e] * b1[e] + wb[1][e] * b0[e] + wb[2][e] * bm1[e];
            o0[e] = ca0 * __builtin_amdgcn_rcpf(1.0f + __expf(-ca0)) * cb0; o1[e] = ca1 * __builtin_amdgcn_rcpf(1.0f + __expf(-ca1)) * cb1; }
        *(GAS v4u*)(act + (size_t)t0 * DFF + col) = pack8f(o0); *(GAS v4u*)(act + (size_t)(t0 + 1) * DFF + col) = pack8f(o1);
    }
}
constexpr int CONV_RUN = 16;
__device__ __forceinline__ void conv_mix_items(const bf16* proj, bf16* outc, const float* cw  , int first, int step, int lane) {
    for (int run = first; run < M / CONV_RUN; run += step) {
        const int m0 = run * CONV_RUN, col = lane * 8;
        float w[3][8];
#pragma unroll
        for (int k = 0; k < 3; ++k) { const f32x4 a0 = *(const GAS f32x4*)(cw + k * 512 + col), a1 = *(const GAS f32x4*)(cw + k * 512 + col + 4);
#pragma unroll
            for (int e = 0; e < 4; ++e) { w[k][e] = a0[e]; w[k][e + 4] = a1[e]; } }
        float z1[8], z2[8];
        if ((m0 % SEQ) == 0) {
#pragma unroll
            for (int e = 0; e < 8; ++e) { z1[e] = 0.f; z2[e] = 0.f; }
        } else {
            float p[8], q[8];
            unpack8(*(const GAS v4u*)(proj + (size_t)(m0 - 1) * N_IN + OFF_CC + col), p); unpack8(*(const GAS v4u*)(proj + (size_t)(m0 - 1) * N_IN + OFF_CH + col), q);
#pragma unroll
            for (int e = 0; e < 8; ++e) z1[e] = p[e] * q[e];
            unpack8(*(const GAS v4u*)(proj + (size_t)(m0 - 2) * N_IN + OFF_CC + col), p); unpack8(*(const GAS v4u*)(proj + (size_t)(m0 - 2) * N_IN + OFF_CH + col), q);
#pragma unroll
            for (int e = 0; e < 8; ++e) z2[e] = p[e] * q[e];
        }
#pragma unroll 4
        for (int t = 0; t < CONV_RUN; ++t) {
            float p[8], q[8], bb[8], o[8];
            const bf16* rp = proj + (size_t)(m0 + t) * N_IN;
            unpack8(*(const GAS v4u*)(rp + OFF_CC + col), p); unpack8(*(const GAS v4u*)(rp + OFF_CH + col), q); unpack8(*(const GAS v4u*)(rp + OFF_CB + col), bb);
#pragma unroll
            for (int e = 0; e < 8; ++e) { const float z0 = p[e] * q[e]; o[e] = bb[e] * (w[0][e] * z0 + w[1][e] * z1[e] + w[2][e] * z2[e]); z2[e] = z1[e]; z1[e] = z0; }
            *(GAS v4u*)(outc + (size_t)(m0 + t) * 512 + col) = pack8f(o);
        }
    }
}
constexpr int SSM_XS = 0, SSM_XS_W = 10240, SSM_HS = 8 * SSM_XS_W, SSM_E = SSM_HS + 8 * 4608, SSM_BB = SSM_E + 4096, SSM_LDS_END = SSM_BB + 4096;
constexpr int ATT_NP = 2, ATT_VLDS = 0;
static_assert(SSM_LDS_END <= RING_BYTES && ATT_VLDS + 8 * ATT_NP * 4608 <= 73728 && 73728 + 8 * 8448 <= MISC_OFF, "mixer LDS map");
__device__ __forceinline__ float gelu_tanh(float y) { const float z = 0.7978845608028654f * (y + 0.044715f * y * y * y); const float e = __expf(2.0f * z); const float th = 1.0f - 2.0f * __builtin_amdgcn_rcpf(1.0f + e); return 0.5f * y * (1.0f + th); }
__device__ __forceinline__ void ssm_unit(const float* const* in, int l, int b, int g, const bf16* proj, bf16* gbuf, LAS unsigned char* lds, int wave, int lane) {
    const int n = lane, lg = l * NGRP + g, gn = lg * NST + n;
    const int cc = lane & 15, kq = lane >> 4;
    LAS float* Xre = (LAS float*)(lds + SSM_XS + wave * SSM_XS_W);
    LAS float* Xim = Xre + 64 * 20;
    LAS bf16* Hs = (LAS bf16*)(lds + SSM_HS + wave * 4608);
    LAS float* E = (LAS float*)(lds + SSM_E);
    LAS bf16* BBre = (LAS bf16*)(lds + SSM_BB); LAS bf16* BBim = BBre + 64 * 16;
    float lr, li;
    { const float dt = expf(in[I_LOGDT][lg]);
      const float ar = in[I_ARE][gn], ai = in[I_AIM][gn];
      const float mag = expf(ar * dt), ang = ai * dt;
      const float kq2 = rintf(ang * 0.15915494309189535f); float red = fmaf(-kq2, 6.2831854820251465f, ang); red = fmaf(-kq2, -1.7484555e-7f, red);
      lr = mag * cosf(red); li = mag * sinf(red);
      const float den = ar * ar + ai * ai, fre = ((lr - 1.0f) * ar + li * ai) / den, fim = (li * ar - (lr - 1.0f) * ai) / den;
      const float* bre = in[I_BRE] + (size_t)gn * 16; const float* bim = in[I_BIM] + (size_t)gn * 16;
      if (wave == 0) {
#pragma unroll
          for (int q = 0; q < 4; ++q) { const f32x4 r4 = *(const GAS f32x4*)(bre + 4 * q), i4 = *(const GAS f32x4*)(bim + 4 * q);
              v2u wr2, wi2; wr2.x = pk2(fre * r4[0] - fim * i4[0], fre * r4[1] - fim * i4[1]); wr2.y = pk2(fre * r4[2] - fim * i4[2], fre * r4[3] - fim * i4[3]);
              wi2.x = pk2(fre * i4[0] + fim * r4[0], fre * i4[1] + fim * r4[1]); wi2.y = pk2(fre * i4[2] + fim * r4[2], fre * i4[3] + fim * r4[3]);
              *(LAS v2u*)(BBre + n * 16 + 4 * q) = wr2; *(LAS v2u*)(BBim + n * 16 + 4 * q) = wi2; } } }
    bf16x8 Cf[4];
#pragma unroll
    for (int kb = 0; kb < 4; ++kb) { const float* src = (kb < 2 ? in[I_CRE] : in[I_CIM]) + (size_t)(lg * 16 + cc) * NST + (kb & 1) * 32 + 8 * kq; const float sg = kb < 2 ? 1.0f : -1.0f;
        const f32x4 a = *(const GAS f32x4*)src, c4 = *(const GAS f32x4*)(src + 4);
        Cf[kb] = __builtin_bit_cast(bf16x8, (v4u){pk2(sg * a[0], sg * a[1]), pk2(sg * a[2], sg * a[3]), pk2(sg * c4[0], sg * c4[1]), pk2(sg * c4[2], sg * c4[3])}); }
    const float dsk = in[I_SSMD][l * SSMW + g * 16 + cc];
    __syncthreads();
    bf16x8 Bre[4], Bim[4];
    const bf16x8 zf = (bf16x8){0, 0, 0, 0, 0, 0, 0, 0};
#pragma unroll
    for (int nb = 0; nb < 4; ++nb) { Bre[nb] = (kq < 2) ? *(const LAS bf16x8*)(BBre + (nb * 16 + cc) * 16 + kq * 8) : zf; Bim[nb] = (kq < 2) ? *(const LAS bf16x8*)(BBim + (nb * 16 + cc) * 16 + kq * 8) : zf; }
    const bf16* urow = proj + (size_t)(b * SEQ + 256 * wave + cc) * N_IN + g * 16 + (kq & 1) * 8;
    const f32x4 z4 = (f32x4){0.f, 0.f, 0.f, 0.f};
    float hr = 0.f, hi = 0.f;
    { bf16x8 an = *(const GAS bf16x8*)urow;
      for (int bt = 0; bt < 16; ++bt) {
          const bf16x8 a = (kq < 2) ? an : zf;
          if (bt + 1 < 16) an = *(const GAS bf16x8*)(urow + (size_t)(bt + 1) * 16 * N_IN);
#pragma unroll
          for (int nb = 0; nb < 4; ++nb) { const f32x4 dr = __builtin_amdgcn_mfma_f32_16x16x32_bf16(a, Bre[nb], z4, 0, 0, 0), di = __builtin_amdgcn_mfma_f32_16x16x32_bf16(a, Bim[nb], z4, 0, 0, 0);
              *(LAS f32x4*)(Xre + (nb * 16 + cc) * 20 + 4 * kq) = dr; *(LAS f32x4*)(Xim + (nb * 16 + cc) * 20 + 4 * kq) = di; }
          LDS_WAIT();
#pragma unroll
          for (int q4 = 0; q4 < 4; ++q4) { const f32x4 xr = *(const LAS f32x4*)(Xre + n * 20 + 4 * q4), xi = *(const LAS f32x4*)(Xim + n * 20 + 4 * q4);
#pragma unroll
              for (int i = 0; i < 4; ++i) { const float nr = lr * hr - li * hi + xr[i], ni = lr * hi + li * hr + xi[i]; hr = nr; hi = ni; } }
          LDS_WAIT(); asm volatile("" ::: "memory");
      } }
    E[(wave * 64 + n) * 2] = hr; E[(wave * 64 + n) * 2 + 1] = hi;
    float pr = lr, pi = li;
#pragma unroll
    for (int q = 0; q < 8; ++q) { const float t = pr * pr - pi * pi; pi = 2.0f * pr * pi; pr = t; }
    __syncthreads();
    hr = 0.f; hi = 0.f;
    for (int j = 0; j < wave; ++j) { const float er = E[(j * 64 + n) * 2], ei = E[(j * 64 + n) * 2 + 1]; const float nr = pr * hr - pi * hi + er, ni = pr * hi + pi * hr + ei; hr = nr; hi = ni; }
    { bf16x8 an = *(const GAS bf16x8*)urow;
      for (int bt = 0; bt < 16; ++bt) {
          const bf16x8 a = (kq < 2) ? an : zf;
          if (bt + 1 < 16) an = *(const GAS bf16x8*)(urow + (size_t)(bt + 1) * 16 * N_IN);
#pragma unroll
          for (int nb = 0; nb < 4; ++nb) { const f32x4 dr = __builtin_amdgcn_mfma_f32_16x16x32_bf16(a, Bre[nb], z4, 0, 0, 0), di = __builtin_amdgcn_mfma_f32_16x16x32_bf16(a, Bim[nb], z4, 0, 0, 0);
              *(LAS f32x4*)(Xre + (nb * 16 + cc) * 20 + 4 * kq) = dr; *(LAS f32x4*)(Xim + (nb * 16 + cc) * 20 + 4 * kq) = di; }
          LDS_WAIT();
#pragma unroll
          for (int q4 = 0; q4 < 4; ++q4) { const f32x4 xr = *(const LAS f32x4*)(Xre + n * 20 + 4 * q4), xi = *(const LAS f32x4*)(Xim + n * 20 + 4 * q4);
#pragma unroll
              for (int i = 0; i < 4; ++i) { const float nr = lr * hr - li * hi + xr[i], ni = lr * hi + li * hr + xi[i]; hr = nr; hi = ni;
                  const unsigned hp = pk2(hr, hi); Hs[(4 * q4 + i) * 136 + n] = (bf16)(hp & 0xffffu); Hs[(4 * q4 + i) * 136 + 64 + n] = (bf16)(hp >> 16); } }
          LDS_WAIT();
          f32x4 Y = z4;
#pragma unroll
          for (int kb = 0; kb < 4; ++kb) { const bf16x8 ha = *(const LAS bf16x8*)(Hs + cc * 136 + kb * 32 + kq * 8); Y = __builtin_amdgcn_mfma_f32_16x16x32_bf16(ha, Cf[kb], Y, 0, 0, 0); }
          const int tb = 256 * wave + 16 * bt + 4 * kq;
#pragma unroll
          for (int i = 0; i < 4; ++i) { const size_t row = (size_t)(b * SEQ + tb + i); const float uval = __uint_as_float(((unsigned)proj[row * N_IN + g * 16 + cc]) << 16);
              gbuf[row * SSMW + g * 16 + cc] = (bf16)f2bf(gelu_tanh(Y[i] + dsk * uval)); }
          LDS_WAIT(); asm volatile("" ::: "memory");
      } }
}

__device__ __forceinline__ s16x4 vtr(const LAS unsigned char* p) { return __builtin_bit_cast(s16x4, __builtin_amdgcn_ds_read_tr16_b64_v4i16((LAS s16x4*)p)); }
__device__ __forceinline__ float xmax16(float v) { const unsigned u = __float_as_uint(v); auto r = __builtin_amdgcn_permlane16_swap(u, u, false, false); return fmaxf(__uint_as_float(r[0]), __uint_as_float(r[1])); }
__device__ __forceinline__ float xmax32(float v) { const unsigned u = __float_as_uint(v); auto r = __builtin_amdgcn_permlane32_swap(u, u, false, false); return fmaxf(__uint_as_float(r[0]), __uint_as_float(r[1])); }
__device__ __forceinline__ float xsum16(float v) { const unsigned u = __float_as_uint(v); auto r = __builtin_amdgcn_permlane16_swap(u, u, false, false); return __uint_as_float(r[0]) + __uint_as_float(r[1]); }
__device__ __forceinline__ float xsum32(float v) { const unsigned u = __float_as_uint(v); auto r = __builtin_amdgcn_permlane32_swap(u, u, false, false); return __uint_as_float(r[0]) + __uint_as_float(r[1]); }
struct AttnKV { bf16x8 k[2][2]; v4u v[4]; };
__device__ __forceinline__ void attn_load(AttnKV& t, const bf16* kbase, const bf16* vbase, int kt0, int rg, int sh, int lane) {
    const int col = lane & 15;
#pragma unroll
    for (int half = 0; half < 2; ++half) { int kp = kt0 + 16 * half + col; kp = kp < 0 ? 0 : kp; const bf16* kr = kbase + (size_t)(rg + (kp << sh)) * N_IN;
        t.k[half][0] = *(const GAS bf16x8*)kr; t.k[half][1] = *(const GAS bf16x8*)(kr + 32); }
#pragma unroll
    for (int i = 0; i < 4; ++i) { const int chunk = lane + 64 * i, row = chunk >> 3, c16 = chunk & 7; int kp = kt0 + row; kp = kp < 0 ? 0 : kp;
        t.v[i] = *(const GAS v4u*)(vbase + (size_t)(rg + (kp << sh)) * N_IN + c16 * 8); }
}
template <int NP, int MODE>
__device__ __forceinline__ void attn_tile(const bf16* proj, bf16* aout, float* part, float* part_ml, LAS unsigned char* vlds0, int b, int h, int r0, int i0, int lane) {
    const int col = lane & 15, grp = lane >> 4;
    const size_t rowb = (size_t)b * SEQ;
    constexpr int GLO = MODE == 0 ? 1 : 0, GHI = MODE == 0 ? 3 : 1;
    int tq[NP]; bf16x8 Qf[NP][3][2]; f32x4 acc[NP][4]; float mrun[NP], lrun[NP];
#pragma unroll
    for (int p = 0; p < NP; ++p) { tq[p] = (MODE == 0) ? (r0 + 8 * p + 16 * (i0 + col)) : (16 * i0 + r0 + 16 * p + col);
        const bf16* qrow = proj + (rowb + tq[p]) * N_IN + OFF_Q + h * 64 + grp * 8;
#pragma unroll
        for (int g = GLO; g < GHI; ++g)
#pragma unroll
            for (int dh = 0; dh < 2; ++dh) Qf[p][g][dh] = *(const GAS bf16x8*)(qrow + g * 512 + dh * 32);
        if (MODE == 0) {
#pragma unroll
            for (int d = 0; d < 4; ++d) acc[p][d] = (f32x4){0.f, 0.f, 0.f, 0.f};
            mrun[p] = -1e30f; lrun[p] = 0.f;
        } else { const size_t pr = ((rowb + tq[p]) * 8 + h);
#pragma unroll
            for (int d = 0; d < 4; ++d) acc[p][d] = *(const GAS f32x4*)(part + pr * 64 + d * 16 + 4 * grp);
            mrun[p] = part_ml[pr * 2]; lrun[p] = part_ml[pr * 2 + 1]; } }
    const float L2E = 1.4426950408889634f;
    const int tq4 = (lane & 15) >> 2, tp4 = lane & 3;
    const int vrd_off = (4 * grp + tq4) * 144 + tp4 * 8, vwr_off = (lane >> 3) * 144 + (lane & 7) * 16;
#pragma unroll
    for (int g = GLO; g < GHI; ++g) {
        const int sh = 2 * g, dil = 1 << sh;
        const int kstart = (g == 0) ? (16 * i0 + r0 - 128) : (g == 1 ? 4 * i0 - 128 : i0 - 144), ntile = (g == 0) ? 5 : (g == 1 ? 6 : 5);
        const float c_qk = 0.125f * L2E, c_b = exp2f(-(float)(g * 8 + h + 1) * (1.0f / 3.0f)) * (float)dil * L2E;
        const bf16* kbase = proj + rowb * N_IN + OFF_K + g * 512 + h * 64 + grp * 8;
        const bf16* vbase = proj + rowb * N_IN + OFF_V + g * 512 + h * 64;
        int rg[NP], qp[NP];
#pragma unroll
        for (int p = 0; p < NP; ++p) { rg[p] = (g == 0) ? 0 : ((r0 + 8 * p) & (dil - 1)); qp[p] = (tq[p] - rg[p]) >> sh; }
        int ti = 0;
        while (kstart + 32 * ti + 32 <= 0) ++ti;
        const int NL = (g < 2) ? 1 : NP;
        AttnKV cur[NP], nxt[NP];
#pragma unroll
        for (int p = 0; p < NP; ++p) if (p < NL) attn_load(cur[p], kbase, vbase, kstart + 32 * ti, rg[p], sh, lane);
        for (; ti < ntile; ++ti) {
            const int kt0 = kstart + 32 * ti;
            if (ti + 1 < ntile) {
#pragma unroll
                for (int p = 0; p < NP; ++p) if (p < NL) attn_load(nxt[p], kbase, vbase, kt0 + 32, rg[p], sh, lane); }
            f32x4 S[NP][2]; bf16x8 Pf[NP];
#pragma unroll
            for (int p = 0; p < NP; ++p) {
                LAS unsigned char* vlds = vlds0 + p * 4608;
#pragma unroll
                for (int half = 0; half < 2; ++half) {
                    S[p][half] = __builtin_amdgcn_mfma_f32_16x16x32_bf16(cur[p < NL ? p : 0].k[half][0], Qf[p][g][0], (f32x4){0.f, 0.f, 0.f, 0.f}, 0, 0, 0);
                    S[p][half] = __builtin_amdgcn_mfma_f32_16x16x32_bf16(cur[p < NL ? p : 0].k[half][1], Qf[p][g][1], S[p][half], 0, 0, 0); }
                if (p < NL) {
#pragma unroll
                    for (int i = 0; i < 4; ++i) *(LAS v4u*)(vlds + vwr_off + i * 8 * 144) = cur[p].v[i]; } }
#pragma unroll
            for (int p = 0; p < NP; ++p) {
                const int D0 = qp[p] - kt0 - 4 * grp; const unsigned W = (unsigned)(qp[p] < 128 ? qp[p] : 128); const float nb0 = -c_b * (float)D0;
                float sc[8]; float mx = -3.0e38f;
#pragma unroll
                for (int half = 0; half < 2; ++half)
#pragma unroll
                    for (int i = 0; i < 4; ++i) { const bool valid = (unsigned)(D0 - (16 * half + i)) <= W;
                        const float sv = valid ? fmaf(S[p][half][i], c_qk, nb0 + c_b * (float)(16 * half + i)) : -3.0e38f; sc[half * 4 + i] = sv; mx = fmaxf(mx, sv); }
                mx = xmax32(xmax16(mx));
                const float mnew = fmaxf(mrun[p], mx), alpha = __builtin_amdgcn_exp2f(mrun[p] - mnew);
                float pv[8], psum = 0.f;
#pragma unroll
                for (int j = 0; j < 8; ++j) { pv[j] = __builtin_amdgcn_exp2f(sc[j] - mnew); psum += pv[j]; }
                psum = xsum32(xsum16(psum));
                lrun[p] = lrun[p] * alpha + psum; mrun[p] = mnew;
#pragma unroll
                for (int d = 0; d < 4; ++d) acc[p][d] = acc[p][d] * alpha;
                Pf[p] = __builtin_bit_cast(bf16x8, (v4u){pk2(pv[0], pv[1]), pk2(pv[2], pv[3]), pk2(pv[4], pv[5]), pk2(pv[6], pv[7])}); }
            LDS_WAIT();
#pragma unroll
            for (int p = 0; p < NP; ++p) {
                const LAS unsigned char* vlds = vlds0 + (p < NL ? p : 0) * 4608;
#pragma unroll
                for (int d = 0; d < 4; ++d) { const s16x4 lo = vtr(vlds + vrd_off + d * 32), hi = vtr(vlds + vrd_off + 16 * 144 + d * 32);
                    const bf16x8 Vf = (bf16x8){lo[0], lo[1], lo[2], lo[3], hi[0], hi[1], hi[2], hi[3]};
                    acc[p][d] = __builtin_amdgcn_mfma_f32_16x16x32_bf16(Vf, Pf[p], acc[p][d], 0, 0, 0); } }
            LDS_WAIT(); asm volatile("" ::: "memory");
#pragma unroll
            for (int p = 0; p < NP; ++p) if (p < NL) cur[p] = nxt[p];
        }
    }
#pragma unroll
    for (int p = 0; p < NP; ++p) {
        if (MODE == 0) { const size_t pr = ((rowb + tq[p]) * 8 + h);
#pragma unroll
            for (int d = 0; d < 4; ++d) *(GAS f32x4*)(part + pr * 64 + d * 16 + 4 * grp) = acc[p][d];
            if (grp == 0) { part_ml[pr * 2] = mrun[p]; part_ml[pr * 2 + 1] = lrun[p]; }
        } else { const float inv = 1.0f / lrun[p];
            bf16* orow = aout + (rowb + tq[p]) * SSMW + h * 64 + 4 * grp;
#pragma unroll
            for (int d = 0; d < 4; ++d) { v2u w; w.x = pk2(acc[p][d][0] * inv, acc[p][d][1] * inv); w.y = pk2(acc[p][d][2] * inv, acc[p][d][3] * inv); *(GAS v2u*)(orow + d * 16) = w; } }
    }
}
__device__ __forceinline__ void attn_item(const bf16* proj, bf16* aout, float* part, float* part_ml, LAS unsigned char* vl, int b, int h, int blk, int wave, int lane) {
    attn_tile<2, 0>(proj, aout, part, part_ml, vl, b, h, wave, 16 * blk, lane);
    VM_WAIT(); __syncthreads();
    attn_tile<2, 1>(proj, aout, part, part_ml, vl, b, h, 32 * wave, 16 * blk, lane);
}
#ifndef STAGGER_PB
#define STAGGER_PB 0
#endif
#ifndef UPACT_ALIGN
#define UPACT_ALIGN true
#endif
#ifndef MK_PER_PHASE
#define MK_PER_PHASE 0
#endif
__device__ __forceinline__ int launder(int v) { asm volatile("" : "+v"(v)); return v; }
#define PH_LOCALS const int tid = launder((int)threadIdx.x), lane = tid & 63, wave = __builtin_amdgcn_readfirstlane(tid >> 6), gw = vcu * NWAVES + wave; (void)tid; (void)lane; (void)wave; (void)gw;
constexpr int PH_PER_LAYER = 11, N_PHASES = 1 + DEPTH * PH_PER_LAYER;
struct Args { const float* in[N_INPUTS]; float* out; unsigned char* ws; int ph_lo, ph_hi; };
static_assert(sizeof(Args) == N_INPUTS * 8 + 8 + 8 + 8, "Args has no padding");
__global__ void __launch_bounds__(NWAVES * 64, 2) trunk_fwd(Args args) {
    extern __shared__ __attribute__((aligned(16))) unsigned char lds_raw[];
    LAS unsigned char* lds = (LAS unsigned char*)lds_raw;
    volatile LAS unsigned* MISC = (volatile LAS unsigned*)(lds + MISC_OFF);
    const int G = gridDim.x, bx = blockIdx.x, vcu = (G % 8 == 0) ? (bx % 8) * (G / 8) + bx / 8 : bx;
    const int NGW = G * NWAVES;
    unsigned char* ws = args.ws;
    const float* const* in = args.in;
    for (int u = threadIdx.x; u < (LDS_BYTES - MISC_OFF) / 4; u += NWAVES * 64) MISC[u] = 0u;
    __syncthreads();
    unsigned* barw = (unsigned*)(ws + WS_CTL) + CW_BAR;
    XcdBarrier bar; bar.bar = barw; bar.x = 0; bar.st = nullptr;
    if (!MK_PER_PHASE) bar = xcd_barrier_post(barw, MISC + 8);
    const int lo = args.ph_lo, hi = args.ph_hi;
#ifndef PH_MASK
#define PH_MASK 0xFFFF
#endif
#define EN(k) (((PH_MASK) >> (k)) & 1)
#ifndef REP_MASK
#define REP_MASK 0
#endif
#define NREP(k) (1 + (((REP_MASK) >> (k)) & 1))
#define PH_IN(id) (lo <= (id) && (id) < hi)
#define PH_SEAM(id) do { if ((id) + 1 < hi) { if (!MK_PER_PHASE) xcd_barrier(bar); } } while (0)
    float* mod = (float*)(ws + WS_MOD);
    bf16* Hb = (bf16*)(ws + WS_H); bf16* PJ = (bf16*)(ws + WS_PROJ); bf16* UP = (bf16*)(ws + WS_PROJ); bf16* ACT = (bf16*)(ws + WS_ACT);
    bf16* GB = (bf16*)(ws + WS_G); bf16* A3 = (bf16*)(ws + WS_A3); bf16* MG = (bf16*)(ws + WS_MG); bf16* YB = (bf16*)(ws + WS_Y);
    float* xout = args.out; bf16* XB = (bf16*)(ws + WS_XB);

    if (EN(0) && PH_IN(0)) for (int rp = 0; rp < NREP(0); ++rp) { PH_LOCALS; p0_prologue(in, ws, lds, tid, wave, lane, vcu, G); PH_SEAM(0); }

    for (int l = 0; l < DEPTH; ++l) {
        const int pb = 1 + l * PH_PER_LAYER;
        const unsigned char* wl = ws + WS_W + (size_t)l * WB_LAYER;
        const float* modl = mod + (size_t)l * BATCH * NMOD;
        if (l == 0 && PH_IN(pb + 0) && EN(1)) { PH_LOCALS;
            p0_mod_reduce(in, (const float*)(ws + WS_MODP), mod, bx * (NWAVES * 64) + tid, G * NWAVES * 64);
            if (!MK_PER_PHASE) xcd_barrier(bar); else {   }
            norm_rows<false, true, false, false>(in[I_X], nullptr, nullptr, nullptr, nullptr, in[I_GPRE_MIX] + l * DM, modl + DM, modl, Hb, gw, NGW, lane);
            PH_SEAM(pb + 0);
        }
        if (PH_IN(pb + 1) && EN(2)) for (int rp = 0; rp < NREP(2); ++rp) { PH_LOCALS;
#if STAGGER_PB
            if (bx >= G / 2) { for (int s = 0; s < STAGGER_PB; ++s) __builtin_amdgcn_s_sleep(127); }
#endif
            pg8::Gemm g{Hb, (const bf16*)(wl + WB_IN), M, N_IN, DM}; pg8::StaticOrder S; S.init(M, N_IN, G, bx);
            pg8::EpiIn E{PJ, N_IN, in[I_BGATE] + (size_t)l * 3 * DM, OFF_GATE / 256};
            pg8::gemm_phase<pg8::EpiIn, pg8::StaticOrder, false, true>(lds, g, S, E);
            if (l + 1 < DEPTH && 2 * bx >= G) { LAS float* cscr = (LAS float*)(lds + wave * 8448); const int nidle = G - (G + 1) / 2;
                convert_layer_share(in, ws, cscr, l + 1, wave * nidle + (bx - (G + 1) / 2), nidle * NWAVES, lane); }
            PH_SEAM(pb + 1);
        }
        if (PH_IN(pb + 2) && EN(3)) { PH_LOCALS;
            for (int rep = 0; rep < NREP(12); ++rep)
            for (int uidx = vcu; uidx < BATCH * NGRP; uidx += G) { ssm_unit(in, l, uidx / NGRP, uidx % NGRP, PJ, GB, lds, wave, lane); __syncthreads(); }
            LAS float* cscr = (LAS float*)(lds + 73728 + wave * 8448);
            for (int rep = 0; rep < NREP(13); ++rep)
            { LAS unsigned char* vl = lds + ATT_VLDS + wave * (ATT_NP * 4608);
              for (int T = vcu; T < BATCH * 8 * 8; T += G) attn_item(PJ, A3 + (size_t)M * SSMW, (float*)(ws + WS_PART), (float*)(ws + WS_PARTML), vl, T >> 6, (T >> 3) & 7, (T + (T >> 3)) & 7, wave, lane); }
            (void)cscr;
            for (int rep = 0; rep < NREP(14); ++rep)
            conv_mix_items(PJ, A3 + (size_t)2 * M * SSMW, in[I_CONVW] + (size_t)l * 3 * SSMW, gw, NGW, lane);
            PH_SEAM(pb + 2);
        }
        if (PH_IN(pb + 3) && EN(4)) for (int rp = 0; rp < NREP(4); ++rp) { PH_LOCALS;
            pg8::Gemm g{GB, (const bf16*)(wl + WB_GLU), M, SSMW, SSMW}; pg8::StaticOrder S; S.init(M, SSMW, G, bx);
            pg8::EpiGlu E{GB, A3, SSMW, in[I_BGLU] + (size_t)l * SSMW};
            pg8::gemm_phase<pg8::EpiGlu, pg8::StaticOrder, true, true>(lds, g, S, E);
            PH_SEAM(pb + 3);
        }
        if (PH_IN(pb + 4) && EN(5)) for (int rp = 0; rp < NREP(5); ++rp) { PH_LOCALS;
            pg8::Gemm g{A3, (const bf16*)(wl + WB_BR), M, DM, SSMW}; pg8::BrTripleOrder S; S.init(M, DM, G, bx);
            pg8::EpiBr E{PJ + OFF_GATE, N_IN, MG, DM};
            pg8::gemm_phase<pg8::EpiBr, pg8::BrTripleOrder, true, true>(lds, g, S, E);
            PH_SEAM(pb + 4);
        }
        if (PH_IN(pb + 5) && EN(6)) for (int rp = 0; rp < NREP(6); ++rp) { PH_LOCALS;
            pg8::Gemm g{MG, (const bf16*)(wl + WB_O), M, DM, DM}; pg8::StaticOrder S; S.init(M, DM, G, bx);
            pg8::EpiStore E{YB, DM};
            pg8::gemm_phase<pg8::EpiStore, pg8::StaticOrder, false, true>(lds, g, S, E);
            PH_SEAM(pb + 5);
        }
        if (PH_IN(pb + 6) && EN(7)) { PH_LOCALS;
            if (l == 0) norm_rows<true, true, false, true>(in[I_X], XB, YB, in[I_GPOST_MIX] + l * DM, modl + 2 * DM, in[I_GPRE_FFN] + l * DM, modl + 4 * DM, modl + 3 * DM, Hb, gw, NGW, lane);
            else norm_rows<true, true, true, true>(XB, XB, YB, in[I_GPOST_MIX] + l * DM, modl + 2 * DM, in[I_GPRE_FFN] + l * DM, modl + 4 * DM, modl + 3 * DM, Hb, gw, NGW, lane);
            PH_SEAM(pb + 6);
        }
        if (PH_IN(pb + 7) && EN(8)) for (int rp = 0; rp < NREP(8); ++rp) { PH_LOCALS;
            pg8::Gemm g{Hb, (const bf16*)(wl + WB_UP), M, NUP, DM}; pg8::StaticOrder S; S.init(M, NUP, G, bx);
            pg8::EpiUpAct E{ACT, DFF, in[I_FCONVW] + (size_t)l * 3 * NUP, UP  };
            pg8::gemm_phase<pg8::EpiUpAct, pg8::StaticOrder, UPACT_ALIGN, true>(lds, g, S, E);
            PH_SEAM(pb + 7);
        }
        if (PH_IN(pb + 8) && EN(9)) for (int rp = 0; rp < NREP(9); ++rp) { PH_LOCALS; ffn_fix_phase(UP, ACT, in[I_FCONVW] + (size_t)l * 3 * NUP, gw, NGW, lane); PH_SEAM(pb + 8); }
        if (PH_IN(pb + 9) && EN(10)) for (int rp = 0; rp < NREP(10); ++rp) { PH_LOCALS;
            pg8::Gemm g{ACT, (const bf16*)(wl + WB_DN), M, DM, DFF}; pg8::StaticOrder S; S.init(M, DM, G, bx);
            pg8::EpiStore E{YB, DM};
            pg8::gemm_phase<pg8::EpiStore, pg8::StaticOrder, false, true>(lds, g, S, E);
            PH_SEAM(pb + 9);
        }
        if (PH_IN(pb + 10) && EN(11)) { PH_LOCALS;
            if (l + 1 < DEPTH) norm_rows<true, true, true, true>(XB, XB, YB, in[I_GPOST_FFN] + l * DM, modl + 5 * DM, in[I_GPRE_MIX] + (l + 1) * DM, modl + BATCH * NMOD + DM, modl + BATCH * NMOD, Hb, gw, NGW, lane);
            else norm_rows<true, false, true, false>(XB, xout, YB, in[I_GPOST_FFN] + l * DM, modl + 5 * DM, nullptr, nullptr, nullptr, nullptr, gw, NGW, lane);
            PH_SEAM(pb + 10);
        }
    }
#undef PH_IN
#undef PH_SEAM
}


#ifndef DBG_STOP
#define DBG_STOP -1
#endif
#ifndef DBG_BUF
#define DBG_BUF 0
#endif
__global__ void __launch_bounds__(256) dbg_dump(const bf16* src, int ld, int col0, int ncol, int outc0, float* out) {
    for (size_t i = (size_t)blockIdx.x * 256 + threadIdx.x; i < (size_t)M * ncol; i += (size_t)gridDim.x * 256) { const size_t m = i / ncol; const int c = (int)(i % ncol);
        out[m * DM + outc0 + c] = __uint_as_float(((unsigned)src[m * ld + col0 + c]) << 16); }
}
extern "C" void kernel_launch(void* const* d_in, const int* in_sizes, int n_in, void* d_out, int out_size, void* d_ws, size_t ws_size, hipStream_t stream) {
    static int grid = 0;
    if (grid == 0) {
        if (n_in != N_INPUTS || in_sizes[0] != M * DM || out_size != M * DM || ws_size < WS_END) { fprintf(stderr, "kernel_launch: unexpected shapes (n_in %d, in0 %d, out %d, ws %zu < %zu); nothing launched\n", n_in, n_in > 0 ? in_sizes[0] : -1, out_size, ws_size, (size_t)WS_END); grid = -1; return; }
        int dev = 0, cus = 0, per_cu = 0;
        if (hipGetDevice(&dev) != hipSuccess || hipDeviceGetAttribute(&cus, hipDeviceAttributeMultiprocessorCount, dev) != hipSuccess) { fprintf(stderr, "kernel_launch: device query failed\n"); grid = -1; return; }
        if (hipFuncSetAttribute((const void*)trunk_fwd, hipFuncAttributeMaxDynamicSharedMemorySize, LDS_BYTES) != hipSuccess) { fprintf(stderr, "kernel_launch: hipFuncSetAttribute failed\n"); grid = -1; return; }
        if (hipOccupancyMaxActiveBlocksPerMultiprocessor(&per_cu, (const void*)trunk_fwd, NWAVES * 64, LDS_BYTES) != hipSuccess || per_cu < 1) { fprintf(stderr, "kernel_launch: occupancy query reports %d blocks per CU\n", per_cu); }
        (void)hipGetLastError();
        grid = cus;
    }
    if (grid < 0) return;
    if (hipMemsetAsync((char*)d_ws + WS_CTL, 0, CTL_ZERO_BYTES, stream) != hipSuccess) { fprintf(stderr, "kernel_launch: memset failed\n"); return; }
    Args a{};
    for (int i = 0; i < N_INPUTS; ++i) a.in[i] = (const float*)d_in[i];
    a.out = (float*)d_out; a.ws = (unsigned char*)d_ws;
#if MK_PER_PHASE
    for (int p = 0; p < N_PHASES; ++p) {
        if (p > 0 && ((p - 1) % PH_PER_LAYER) == 0 && p != 1) continue;
        a.ph_lo = p; a.ph_hi = p + 1;
        hipLaunchKernelGGL(trunk_fwd, dim3(grid), dim3(NWAVES * 64), LDS_BYTES, stream, a);
        if (p == DBG_STOP) {
            unsigned char* w = (unsigned char*)d_ws; float* o = (float*)d_out;
            if (DBG_BUF == 0) hipLaunchKernelGGL(dbg_dump, dim3(2048), dim3(256), 0, stream, (const bf16*)(w + WS_H), DM, 0, DM, 0, o);
            if (DBG_BUF == 1) hipLaunchKernelGGL(dbg_dump, dim3(2048), dim3(256), 0, stream, (const bf16*)(w + WS_PROJ), N_IN, 0, DM, 0, o);
            if (DBG_BUF == 2) hipLaunchKernelGGL(dbg_dump, dim3(2048), dim3(256), 0, stream, (const bf16*)(w + WS_PROJ), N_IN, N_IN - DM, DM, 0, o);
            if (DBG_BUF == 3) { hipLaunchKernelGGL(dbg_dump, dim3(2048), dim3(256), 0, stream, (const bf16*)(w + WS_G), SSMW, 0, SSMW, 0, o);
                                hipLaunchKernelGGL(dbg_dump, dim3(2048), dim3(256), 0, stream, (const bf16*)(w + WS_A3), SSMW, 0, SSMW, 512, o);
                                hipLaunchKernelGGL(dbg_dump, dim3(2048), dim3(256), 0, stream, (const bf16*)(w + WS_A3) + (size_t)M * SSMW, SSMW, 0, SSMW, 1024, o);
                                hipLaunchKernelGGL(dbg_dump, dim3(2048), dim3(256), 0, stream, (const bf16*)(w + WS_A3) + (size_t)2 * M * SSMW, SSMW, 0, SSMW, 1536, o); }
            if (DBG_BUF == 4) hipLaunchKernelGGL(dbg_dump, dim3(2048), dim3(256), 0, stream, (const bf16*)(w + WS_MG), DM, 0, DM, 0, o);
            if (DBG_BUF == 5) hipLaunchKernelGGL(dbg_dump, dim3(2048), dim3(256), 0, stream, (const bf16*)(w + WS_Y), DM, 0, DM, 0, o);
            if (DBG_BUF == 6) hipLaunchKernelGGL(dbg_dump, dim3(2048), dim3(256), 0, stream, (const bf16*)(w + WS_ACT), DFF, 0, DM, 0, o);
            break;
        }
    }
#else
    a.ph_lo = 0; a.ph_hi = N_PHASES;
    hipLaunchKernelGGL(trunk_fwd, dim3(grid), dim3(NWAVES * 64), LDS_BYTES, stream, a);
#endif
    const hipError_t le = hipPeekAtLastError();
    if (le != hipSuccess) fprintf(stderr, "kernel_launch: launch failed: %s\n", hipGetErrorName(le));
}
```
